# Optimizing an MI355X kernel written in HIP

```python
import math
import jax, jax.numpy as jnp
from jax import lax
import numpy as np

D_MODEL = 4096
BATCH = 4
SEQ = 4096
DEPTH = 1

CHUNK = 64
Q_BLOCK = 128
HEAD_DIM = 128
MIX_WIDTH = D_MODEL
H_FOX = (MIX_WIDTH // 2) // HEAD_DIM
H_DIFF = (MIX_WIDTH // 2) // (2 * HEAD_DIM)
N_BUCKETS = 32
MAX_DISTANCE = 128
N_MEM = 256
H_MEM = 4
MEM_HEAD_DIM = D_MODEL // H_MEM
D_FF = 4 * D_MODEL
NORM_EPS = 1e-6
SUBLN_EPS = 1e-5
NEG_INF = -1e30

W_FOX_Q = H_FOX * HEAD_DIM
W_FOX_K = H_FOX * HEAD_DIM
W_FOX_V = H_FOX * HEAD_DIM
W_FOX_F = H_FOX
W_DIFF_Q = H_DIFF * 2 * HEAD_DIM
W_DIFF_K = H_DIFF * 2 * HEAD_DIM
W_DIFF_V = H_DIFF * 2 * HEAD_DIM
IN_WIDTH = W_FOX_Q + W_FOX_K + W_FOX_V + W_FOX_F + W_DIFF_Q + W_DIFF_K + W_DIFF_V

kernel_name = "hybrid_fox_diffattn_stream_encoder"


def rms_norm(x, g, eps=NORM_EPS):
    xf = x.astype(jnp.float32)
    y = xf * lax.rsqrt(jnp.mean(xf * xf, axis=-1, keepdims=True) + eps)
    return (y * g.astype(jnp.float32)).astype(x.dtype)


def split_offsets():
    widths = [W_FOX_Q, W_FOX_K, W_FOX_V, W_FOX_F, W_DIFF_Q, W_DIFF_K, W_DIFF_V]
    offs, acc = [], 0
    for w in widths[:-1]:
        acc += w
        offs.append(acc)
    return offs


def t5_bucket(rel):
    half = N_BUCKETS // 2
    max_exact = half // 2
    ret = jnp.where(rel > 0, half, 0)
    n = jnp.abs(rel)
    nf = jnp.maximum(n, 1).astype(jnp.float32)
    large = max_exact + (jnp.log(nf / max_exact) / math.log(MAX_DISTANCE / max_exact)
                         * (half - max_exact)).astype(jnp.int32)
    large = jnp.minimum(large, half - 1)
    return ret + jnp.where(n < max_exact, n, large)


def forgetting_attention(q, k, v, log_f):
    B, S, H, Dh = q.shape
    nb = S // Q_BLOCK
    cum = jnp.cumsum(log_f, axis=1).transpose(0, 2, 1)
    cum_b = cum.reshape(B, H, nb, Q_BLOCK).transpose(2, 0, 1, 3)
    q_b = q.reshape(B, nb, Q_BLOCK, H, Dh).transpose(1, 0, 2, 3, 4)
    kf = k.astype(jnp.float32)
    kpos = jnp.arange(S)
    scale = Dh ** -0.5

    def block(args):
        i, qi, ci = args
        qpos = i * Q_BLOCK + jnp.arange(Q_BLOCK)
        logits = jnp.einsum('bqhd,bkhd->bhqk', qi.astype(jnp.float32), kf) * scale
        logits = logits + (ci[..., :, None] - cum[:, :, None, :])
        mask = kpos[None, :] <= qpos[:, None]
        logits = jnp.where(mask, logits, NEG_INF)
        p = jax.nn.softmax(logits, axis=-1).astype(v.dtype)
        return jnp.einsum('bhqk,bkhd->bqhd', p, v)

    out = lax.map(block, (jnp.arange(nb), q_b, cum_b))
    return out.transpose(1, 0, 2, 3, 4).reshape(B, S, H, Dh)


def differential_attention(q, k, v, lam, rel_bias, g_subln, lambda_init):
    B, S, H, _, Dh = q.shape
    nb = S // Q_BLOCK
    q_b = q.reshape(B, nb, Q_BLOCK, H, 2, Dh).transpose(1, 0, 2, 3, 4, 5)
    kf = k.astype(jnp.float32)
    kpos = jnp.arange(S)
    scale = Dh ** -0.5

    def block(args):
        i, qi = args
        qpos = i * Q_BLOCK + jnp.arange(Q_BLOCK)
        bias = rel_bias[t5_bucket(kpos[None, :] - qpos[:, None])]
        bias = bias.transpose(2, 0, 1).astype(jnp.float32)
        logits = jnp.einsum('bqhcd,bkhcd->bchqk', qi.astype(jnp.float32), kf) * scale + bias
        mask = (kpos // CHUNK)[None, :] <= (qpos // CHUNK)[:, None]
        logits = jnp.where(mask, logits, NEG_INF)
        p = jax.nn.softmax(logits, axis=-1)
        a = p[:, 0] - lam * p[:, 1]
        return jnp.einsum('bhqk,bkhe->bqhe', a.astype(v.dtype), v)

    out = lax.map(block, (jnp.arange(nb), q_b))
    out = out.transpose(1, 0, 2, 3, 4).reshape(B, S, H, 2 * Dh)
    out = rms_norm(out, g_subln, eps=SUBLN_EPS)
    return out * (1.0 - lambda_init)


def memory_cross_attention(c, m, wq, wk, wv, wo):
    B, S, _ = c.shape
    M = m.shape[1]
    q = (c @ wq).reshape(B, S, H_MEM, MEM_HEAD_DIM)
    k = (m @ wk).reshape(B, M, H_MEM, MEM_HEAD_DIM)
    v = (m @ wv).reshape(B, M, H_MEM, MEM_HEAD_DIM)
    logits = jnp.einsum('bqhd,bmhd->bhqm', q.astype(jnp.float32), k.astype(jnp.float32)) * MEM_HEAD_DIM ** -0.5
    p = jax.nn.softmax(logits, axis=-1).astype(v.dtype)
    o = jnp.einsum('bhqm,bmhd->bqhd', p, v).reshape(B, S, H_MEM * MEM_HEAD_DIM)
    return o @ wo


def setup_inputs(seed: int = 0) -> dict:
    key = jax.random.key(seed)
    ks = jax.random.split(key, 24)
    D, L = D_MODEL, DEPTH

    def nrm(k, shape, scale):
        return jax.random.normal(k, shape, jnp.float32) * scale

    def gain(k, shape):
        return 1.0 + 0.02 * jax.random.normal(k, shape, jnp.float32)

    return {
        "x": nrm(ks[0], (BATCH, SEQ, D), 1.0),
        "mem": nrm(ks[1], (BATCH, N_MEM, D), 1.0),
        "g_mix": gain(ks[2], (L, D)),
        "w_in": nrm(ks[3], (L, D, IN_WIDTH), D ** -0.5),
        "b_forget": 2.0 + 0.1 * jax.random.normal(ks[4], (L, H_FOX), jnp.float32),
        "lambda_q1": nrm(ks[5], (L, HEAD_DIM), 0.1),
        "lambda_k1": nrm(ks[6], (L, HEAD_DIM), 0.1),
        "lambda_q2": nrm(ks[7], (L, HEAD_DIM), 0.1),
        "lambda_k2": nrm(ks[8], (L, HEAD_DIM), 0.1),
        "g_subln": gain(ks[9], (L, 2 * HEAD_DIM)),
        "rel_bias": nrm(ks[10], (N_BUCKETS, H_DIFF), 0.5),
        "w_out": nrm(ks[11], (L, MIX_WIDTH, D), MIX_WIDTH ** -0.5),
        "g_cross": gain(ks[12], (L, D)),
        "g_mem": gain(ks[13], (L, D)),
        "wq_mem": nrm(ks[14], (L, D, H_MEM * MEM_HEAD_DIM), D ** -0.5),
        "wk_mem": nrm(ks[15], (L, D, H_MEM * MEM_HEAD_DIM), D ** -0.5),
        "wv_mem": nrm(ks[16], (L, D, H_MEM * MEM_HEAD_DIM), D ** -0.5),
        "wo_mem": nrm(ks[17], (L, H_MEM * MEM_HEAD_DIM, D), (H_MEM * MEM_HEAD_DIM) ** -0.5),
        "g_mlp": gain(ks[18], (L, D)),
        "w_up": nrm(ks[19], (L, D, D_FF), D ** -0.5),
        "w_down": nrm(ks[20], (L, D_FF, D), D_FF ** -0.5),
        "g_final": gain(ks[21], (D,)),
    }


def reference(x, mem, g_mix, w_in, b_forget, lambda_q1, lambda_k1, lambda_q2, lambda_k2,
              g_subln, rel_bias, w_out, g_cross, g_mem, wq_mem, wk_mem, wv_mem, wo_mem,
              g_mlp, w_up, w_down, g_final):
    B, S, _ = x.shape
    offs = split_offsets()
    h = x
    for l in range(DEPTH):
        a = rms_norm(h, g_mix[l])
        proj = a @ w_in[l]
        q_f, k_f, v_f, f_logit, q_d, k_d, v_d = jnp.split(proj, offs, axis=-1)

        log_f = jax.nn.log_sigmoid((f_logit + b_forget[l]).astype(jnp.float32))
        fox = forgetting_attention(q_f.reshape(B, S, H_FOX, HEAD_DIM),
                                   k_f.reshape(B, S, H_FOX, HEAD_DIM),
                                   v_f.reshape(B, S, H_FOX, HEAD_DIM), log_f)

        lambda_init = 0.8 - 0.6 * math.exp(-0.3 * l)
        lam = (jnp.exp(jnp.sum(lambda_q1[l].astype(jnp.float32) * lambda_k1[l].astype(jnp.float32)))
               - jnp.exp(jnp.sum(lambda_q2[l].astype(jnp.float32) * lambda_k2[l].astype(jnp.float32)))
               + lambda_init)
        diff = differential_attention(q_d.reshape(B, S, H_DIFF, 2, HEAD_DIM),
                                      k_d.reshape(B, S, H_DIFF, 2, HEAD_DIM),
                                      v_d.reshape(B, S, H_DIFF, 2 * HEAD_DIM),
                                      lam, rel_bias, g_subln[l], lambda_init)

        mixed = jnp.concatenate([fox.reshape(B, S, W_FOX_V), diff.reshape(B, S, W_DIFF_V)], axis=-1)
        h = h + mixed @ w_out[l]

        h = h + memory_cross_attention(rms_norm(h, g_cross[l]), rms_norm(mem, g_mem[l]),
                                       wq_mem[l], wk_mem[l], wv_mem[l], wo_mem[l])

        u = rms_norm(h, g_mlp[l]) @ w_up[l]
        h = h + jnp.square(jax.nn.relu(u)) @ w_down[l]
    return rms_norm(h, g_final)
```

```cpp
#include <hip/hip_runtime.h>
#include <cstdio>
#include <cstdint>

#ifndef PROBE_DUP_MASK
#define PROBE_DUP_MASK 0
#endif
#ifndef MK_PER_PHASE
#define MK_PER_PHASE 0
#endif

namespace pg8 {
#define PG8_LAS __attribute__((address_space(3)))
typedef unsigned short bf16_t;
typedef short bf16x8 __attribute__((ext_vector_type(8)));
typedef float f32x4 __attribute__((ext_vector_type(4)));
typedef float f32x2 __attribute__((ext_vector_type(2)));
typedef unsigned u32x4 __attribute__((ext_vector_type(4)));
typedef unsigned u32x2 __attribute__((ext_vector_type(2)));
constexpr int BM = 256, BK = 64, HALF = 128, HTB = HALF * BK * 2, STAGE_BYTES = 8 * HTB, NXCD = 8, WGM = 8;

__host__ __device__ __forceinline__ int lds_byte(int r, int c) { const int st = (r >> 4) * 2 + (c >> 5), rr = r & 15, cc = c & 31, ob = rr * 64 + cc * 2; return st * 1024 + (ob ^ (((ob >> 9) & 1) << 5)); }
__host__ __device__ __forceinline__ void stage_rc(int b, int& R, int& C) { const int st = b / 1024, sb = b % 1024, swz = sb ^ (((sb >> 9) & 1) << 5); R = (st >> 1) * 16 + swz / 64; C = (st & 1) * 32 + (swz % 64) / 2; }
__host__ __device__ __forceinline__ int perm32(int rho) { const int n = rho >> 4, i = rho & 15; return 8 * (i >> 2) + 4 * n + (i & 3); }

struct Unit { int pm, pn; };

struct StaticOrder {
    int nM, nN, nwg, G, c;
    __host__ __device__ __forceinline__ void init(int M, int N, int G_, int c_) { nM = M / BM; nN = N / BM; nwg = nM * nN; G = G_; c = c_; }
    __host__ __device__ __forceinline__ bool next(int i, Unit& u) const {
        const long L = (long)i * G + c; if (L >= nwg) return false;
        int wgid = (int)L; { const int q = nwg / NXCD, r = nwg % NXCD, xcd = wgid % NXCD, off = wgid / NXCD; wgid = (xcd < r ? xcd * (q + 1) : r * (q + 1) + (xcd - r) * q) + off; }
        const int nig = WGM * nN, gid = wgid / nig, fm = gid * WGM, gsz = (nM - fm) < WGM ? (nM - fm) : WGM;
        u.pm = fm + ((wgid % nig) % gsz); u.pn = (wgid % nig) / gsz; return true;
    }
};

__device__ __forceinline__ unsigned cvt_pk_bf16(float lo, float hi) { unsigned r; asm volatile("v_cvt_pk_bf16_f32 %0, %1, %2" : "=v"(r) : "v"(lo), "v"(hi)); return r; }
__device__ __forceinline__ int hw_lane() { unsigned l; asm volatile("v_mbcnt_lo_u32_b32 %0, -1, 0\n\tv_mbcnt_hi_u32_b32 %0, -1, %0" : "=v"(l)); return (int)(l & 63u); }

template <bool ABLK, bool BBLK> struct MapPlainT {
    const char* A; const char* Bt; int lda, ldb, K;
    __device__ __forceinline__ unsigned blk(int R, int C) const { return (unsigned)(((R >> 4) * (K / 32) + (C >> 5)) * 1024 + ((R & 15) * 32 + (C & 31)) * 2); }
    __device__ __forceinline__ unsigned voffA(int R, int C) const { return ABLK ? blk(R, C) : (unsigned)(R * lda + C) * 2u; }
    __device__ __forceinline__ size_t kstepA() const { return ABLK ? (size_t)2048 : (size_t)(BK * 2); }
    __device__ __forceinline__ size_t hstepA() const { return ABLK ? (size_t)8 * (K / 32) * 1024 : (size_t)HALF * lda * 2; }
    __device__ __forceinline__ unsigned voffB(int R, int C) const { return BBLK ? blk(R, C) : (unsigned)(R * ldb + C) * 2u; }
    __device__ __forceinline__ size_t kstepB() const { return BBLK ? (size_t)2048 : (size_t)(BK * 2); }
    __device__ __forceinline__ size_t hstepB() const { return BBLK ? (size_t)8 * (K / 32) * 1024 : (size_t)HALF * ldb * 2; }
    __device__ __forceinline__ const char* a_base(const Unit& u) const { return A + (ABLK ? (size_t)u.pm * 16 * (K / 32) * 1024 : (size_t)u.pm * 256 * lda * 2); }
    __device__ __forceinline__ const char* b_base(const Unit& u) const { return Bt + (BBLK ? (size_t)u.pn * 16 * (K / 32) * 1024 : (size_t)u.pn * 256 * ldb * 2); }
};
typedef MapPlainT<false, false> MapPlain;
typedef MapPlainT<false, true> MapPlainB;
typedef MapPlainT<true, true> MapPlainAB;
struct MapBlkA {
    const char* A0; const char* A1; const char* Bt; int ldb, K;
    __device__ __forceinline__ const char* a_base(const Unit& u) const { const size_t pstride = (size_t)16 * (K / 32) * 1024; return (u.pm < 32 ? A0 + (size_t)u.pm * pstride : A1 + (size_t)(u.pm - 32) * pstride); }
    __device__ __forceinline__ const char* b_base(const Unit& u) const { return Bt + (size_t)u.pn * 16 * (K / 32) * 1024; }
    __device__ __forceinline__ unsigned voffA(int R, int C) const { return (unsigned)(((R >> 4) * (K / 32) + (C >> 5)) * 1024 + ((R & 15) * 32 + (C & 31)) * 2); }
    __device__ __forceinline__ size_t kstepA() const { return (size_t)2048; }
    __device__ __forceinline__ size_t hstepA() const { return (size_t)8 * (K / 32) * 1024; }
    __device__ __forceinline__ unsigned voffB(int R, int C) const { return voffA(R, C); }
    __device__ __forceinline__ size_t kstepB() const { return (size_t)2048; }
    __device__ __forceinline__ size_t hstepB() const { return hstepA(); }
};
template <bool ABLK> struct MapBatchBT {
    const char* A; const char* Bt; int lda, ldb, K; size_t bstride;
    __device__ __forceinline__ unsigned voffA(int R, int C) const { return ABLK ? (unsigned)(((R >> 4) * (K / 32) + (C >> 5)) * 1024 + ((R & 15) * 32 + (C & 31)) * 2) : (unsigned)(R * lda + C) * 2u; }
    __device__ __forceinline__ size_t kstepA() const { return ABLK ? (size_t)2048 : (size_t)(BK * 2); }
    __device__ __forceinline__ size_t hstepA() const { return ABLK ? (size_t)8 * (K / 32) * 1024 : (size_t)HALF * lda * 2; }
    __device__ __forceinline__ unsigned voffB(int R, int C) const { return (unsigned)(R * ldb + C) * 2u; }
    __device__ __forceinline__ size_t kstepB() const { return (size_t)(BK * 2); }
    __device__ __forceinline__ size_t hstepB() const { return (size_t)HALF * ldb * 2; }
    __device__ __forceinline__ const char* a_base(const Unit& u) const { return A + (ABLK ? (size_t)u.pm * 16 * (K / 32) * 1024 : (size_t)u.pm * 256 * lda * 2); }
    __device__ __forceinline__ const char* b_base(const Unit& u) const { return Bt + (size_t)(u.pm >> 4) * bstride + (size_t)u.pn * 256 * ldb * 2; }
};
typedef MapBatchBT<false> MapBatchB;
typedef MapBatchBT<true> MapBatchBA;
struct MapAbsorb {
    const char* kvm; const char* W2; int lda, ldb, K;
    __device__ __forceinline__ unsigned voffB(int R, int C) const { return (unsigned)(R * ldb + C) * 2u; }
    __device__ __forceinline__ size_t kstepB() const { return (size_t)(BK * 2); }
    __device__ __forceinline__ size_t hstepB() const { return (size_t)HALF * ldb * 2; }
    __device__ __forceinline__ unsigned voffA(int R, int C) const { return (unsigned)(R * lda + C) * 2u; }
    __device__ __forceinline__ size_t kstepA() const { return (size_t)(BK * 2); }
    __device__ __forceinline__ size_t hstepA() const { return (size_t)HALF * lda * 2; }
    __device__ __forceinline__ const char* a_base(const Unit& u) const {
        if (u.pm < 16) return kvm + ((size_t)(u.pm >> 2) * 256 * 8192 + (size_t)(u.pm & 3) * 1024) * 2;
        return W2 + ((size_t)(u.pm - 16) * 256 * 8192 + 4096 + (size_t)(u.pn & 3) * 1024) * 2; }
    __device__ __forceinline__ const char* b_base(const Unit& u) const {
        if (u.pm < 16) return W2 + ((size_t)u.pn * 256 * 8192 + (size_t)(u.pm & 3) * 1024) * 2;
        return kvm + ((size_t)(u.pn >> 2) * 256 * 8192 + 4096 + (size_t)(u.pn & 3) * 1024) * 2; }
};


__device__ __forceinline__ float row_rstd(const float* part, int row, int fq, float eps) {
    const f32x4* p = (const f32x4*)(part + (size_t)row * 64 + fq * 16);
    const f32x4 a = p[0], b = p[1], c = p[2], d = p[3];
    float s = ((a[0] + a[1]) + (a[2] + a[3])) + ((b[0] + b[1]) + (b[2] + b[3])) + ((c[0] + c[1]) + (c[2] + c[3])) + ((d[0] + d[1]) + (d[2] + d[3]));
    s += __shfl_xor(s, 16); s += __shfl_xor(s, 32);
    return __builtin_amdgcn_rsqf(s * (1.0f / 4096.0f) + eps);
}

struct EpiQKV {
    static constexpr bool PERM = true, AFTER_DRAIN = false;
    bf16_t* O; const float* rx; const PG8_LAS float* tab; int tab_pm;
    unsigned* kn;
    __device__ __forceinline__ void operator()(const f32x4 (&acc)[2][2][4][2], const Unit& u, int wr, int wc, int fr, int fq) const {
        const int row0 = u.pm * BM + wr * 64 + fr, d0 = wc * 32 + 8 * fq; const bool tb = (u.pm == tab_pm);
#pragma unroll
        for (int ai = 0; ai < 2; ++ai)
#pragma unroll
            for (int m = 0; m < 4; ++m) { const int row = row0 + ai * HALF + m * 16; const float r = tb ? tab[ai * HALF + wr * 64 + m * 16 + fr] : rx[row]; const int b = row >> 12, s = row & 4095;
#pragma unroll
                for (int bj = 0; bj < 2; ++bj) { const int head = u.pn * 2 + bj;
                    const f32x4 v0 = acc[ai][bj][m][0] * r, v1 = acc[ai][bj][m][1] * r;
                    u32x4 w; w.x = cvt_pk_bf16(v0[0], v0[1]); w.y = cvt_pk_bf16(v0[2], v0[3]); w.z = cvt_pk_bf16(v1[0], v1[1]); w.w = cvt_pk_bf16(v1[2], v1[3]);
                    *(u32x4*)(O + (((size_t)(b * 96 + head) * 4096 + s) * 128 + d0)) = w; } }
        if (u.pn >= 8 && u.pn < 16) {
#pragma unroll
            for (int bj = 0; bj < 2; ++bj) { float mx = 0.f;
#pragma unroll
                for (int ai = 0; ai < 2; ++ai)
#pragma unroll
                    for (int m = 0; m < 4; ++m) { const int row = row0 + ai * HALF + m * 16; const float r = tb ? tab[ai * HALF + wr * 64 + m * 16 + fr] : rx[row];
                        const f32x4 v0 = acc[ai][bj][m][0] * r, v1 = acc[ai][bj][m][1] * r;
                        float q = ((v0[0] * v0[0] + v0[1] * v0[1]) + (v0[2] * v0[2] + v0[3] * v0[3])) + ((v1[0] * v1[0] + v1[1] * v1[1]) + (v1[2] * v1[2] + v1[3] * v1[3]));
                        q += __shfl_xor(q, 16); q += __shfl_xor(q, 32); mx = fmaxf(mx, q); }
                mx = fmaxf(mx, __shfl_xor(mx, 1)); mx = fmaxf(mx, __shfl_xor(mx, 2)); mx = fmaxf(mx, __shfl_xor(mx, 4)); mx = fmaxf(mx, __shfl_xor(mx, 8));
                if (fr == 0 && fq == 0) atomicMax(kn + ((size_t)((u.pm >> 4) * 16 + (u.pn * 2 + bj - 16)) * 4 + wc), __float_as_uint(mx)); } }
    }
};
struct EpiBf16 {
    static constexpr bool PERM = true, AFTER_DRAIN = false;
    bf16_t* O; int ldc; float s0; int pm_split;
    __device__ __forceinline__ void operator()(const f32x4 (&acc)[2][2][4][2], const Unit& u, int wr, int wc, int fr, int fq) const {
        const int row0 = u.pm * BM + wr * 64 + fr, col0 = u.pn * BM + wc * 32 + 8 * fq; const float sc = (u.pm < pm_split) ? s0 : 1.0f;
#pragma unroll
        for (int ai = 0; ai < 2; ++ai)
#pragma unroll
            for (int m = 0; m < 4; ++m) { bf16_t* rowp = O + (size_t)(row0 + ai * HALF + m * 16) * ldc + col0;
#pragma unroll
                for (int bj = 0; bj < 2; ++bj) { const f32x4 v0 = acc[ai][bj][m][0] * sc, v1 = acc[ai][bj][m][1] * sc;
                    u32x4 w; w.x = cvt_pk_bf16(v0[0], v0[1]); w.y = cvt_pk_bf16(v0[2], v0[3]); w.z = cvt_pk_bf16(v1[0], v1[1]); w.w = cvt_pk_bf16(v1[2], v1[3]);
                    *(u32x4*)(rowp + bj * HALF) = w; } }
    }
};
struct EpiRelu2 {
    static constexpr bool PERM = true, AFTER_DRAIN = false;
    bf16_t* O; bf16_t* O1; int ldc; const float* part; int row_off; float eps; const PG8_LAS float* tab; int tab_pm;
    __device__ __forceinline__ void operator()(const f32x4 (&acc)[2][2][4][2], const Unit& u, int wr, int wc, int fr, int fq) const {
        const int row0 = u.pm * BM + wr * 64 + fr, col0 = u.pn * BM + wc * 32 + 8 * fq;
        float rs[2][4];
        if (u.pm == tab_pm) {
#pragma unroll
            for (int ai = 0; ai < 2; ++ai)
#pragma unroll
                for (int m = 0; m < 4; ++m) rs[ai][m] = tab[ai * HALF + wr * 64 + m * 16 + fr];
        } else {
#pragma unroll
            for (int ai = 0; ai < 2; ++ai) {
                f32x4 pp[4][4];
#pragma unroll
                for (int m = 0; m < 4; ++m) { const f32x4* p = (const f32x4*)(part + (size_t)(row_off + row0 + ai * HALF + m * 16) * 64 + fq * 16);
#pragma unroll
                    for (int q = 0; q < 4; ++q) pp[m][q] = p[q]; }
#pragma unroll
                for (int m = 0; m < 4; ++m) { float s = 0.f;
#pragma unroll
                    for (int q = 0; q < 4; ++q) s += (pp[m][q][0] + pp[m][q][1]) + (pp[m][q][2] + pp[m][q][3]);
                    s += __shfl_xor(s, 16); s += __shfl_xor(s, 32); rs[ai][m] = __builtin_amdgcn_rsqf(s * (1.0f / 4096.0f) + eps); }
                asm volatile("" ::: "memory"); } }
#pragma unroll
        for (int ai = 0; ai < 2; ++ai)
#pragma unroll
            for (int m = 0; m < 4; ++m) { const int row = row0 + ai * HALF + m * 16; const float r = rs[ai][m];
                const int rb = (u.pm & 31) * 16 + ai * 8 + wr * 4 + m, cb = u.pn * 8 + wc;
                bf16_t* rowp = (u.pm < 32 ? O : O1) + ((size_t)rb * (ldc / 32) + cb) * 512 + fr * 32 + 8 * fq;
#pragma unroll
                for (int bj = 0; bj < 2; ++bj) { f32x4 v0 = acc[ai][bj][m][0] * r, v1 = acc[ai][bj][m][1] * r;
#pragma unroll
                    for (int j = 0; j < 4; ++j) { v0[j] = fmaxf(v0[j], 0.f); v0[j] *= v0[j]; v1[j] = fmaxf(v1[j], 0.f); v1[j] *= v1[j]; }
                    u32x4 w; w.x = cvt_pk_bf16(v0[0], v0[1]); w.y = cvt_pk_bf16(v0[2], v0[3]); w.z = cvt_pk_bf16(v1[0], v1[1]); w.w = cvt_pk_bf16(v1[2], v1[3]);
                    *(u32x4*)(rowp + bj * 4 * 512) = w; } }
    }
};
__device__ __forceinline__ void row_rstd_table(PG8_LAS float* tab, const float* part, int grow0, float eps, int tid) {
    const int row = tid >> 1, hf = tid & 1; const f32x4* p = (const f32x4*)(part + (size_t)(grow0 + row) * 64 + hf * 32); float s = 0.f;
#pragma unroll
    for (int i = 0; i < 8; ++i) { const f32x4 a = p[i]; s += (a[0] + a[1]) + (a[2] + a[3]); }
    s += __shfl_xor(s, 1);
    if (hf == 0) tab[row] = __builtin_amdgcn_rsqf(s * (1.0f / 4096.0f) + eps);
    __syncthreads();
}
template <bool BASE_BF16, bool OUT_BF16, bool BASE_BLK = false, bool OUT_BLK = false> struct EpiRes {
    static constexpr bool PERM = true, AFTER_DRAIN = false;
    const void* base; void* out; int ldc; float* part; int row_off;
    __device__ __forceinline__ void operator()(const f32x4 (&acc)[2][2][4][2], const Unit& u, int wr, int wc, int fr, int fq) const {
        const int row0 = row_off + u.pm * BM + wr * 64 + fr, col0 = u.pn * BM + wc * 32 + 8 * fq;
        const int rb0 = (row_off >> 4) + u.pm * 16 + wr * 4, cb0 = u.pn * 8 + wc;
#pragma unroll
        for (int ai = 0; ai < 2; ++ai) {
            f32x4 b0[4][2], b1[4][2];
#pragma unroll
            for (int m = 0; m < 4; ++m)
#pragma unroll
                for (int bj = 0; bj < 2; ++bj) { const size_t off = BASE_BLK ? ((size_t)(rb0 + ai * 8 + m) * (ldc / 32) + cb0 + bj * 4) * 512 + fr * 32 + 8 * fq : (size_t)(row0 + ai * HALF + m * 16) * ldc + col0 + bj * HALF;
                    if constexpr (BASE_BF16) { const u32x4 w = *(const u32x4*)((const bf16_t*)base + off);
                        b0[m][bj] = (f32x4){__uint_as_float(w.x << 16), __uint_as_float(w.x & 0xffff0000u), __uint_as_float(w.y << 16), __uint_as_float(w.y & 0xffff0000u)};
                        b1[m][bj] = (f32x4){__uint_as_float(w.z << 16), __uint_as_float(w.z & 0xffff0000u), __uint_as_float(w.w << 16), __uint_as_float(w.w & 0xffff0000u)}; }
                    else { b0[m][bj] = *(const f32x4*)((const float*)base + off); b1[m][bj] = *(const f32x4*)((const float*)base + off + 4); } }
#pragma unroll
            for (int m = 0; m < 4; ++m) { const int row = row0 + ai * HALF + m * 16; float ss = 0.f;
#pragma unroll
                for (int bj = 0; bj < 2; ++bj) { const size_t off = OUT_BLK ? ((size_t)(rb0 + ai * 8 + m) * (ldc / 32) + cb0 + bj * 4) * 512 + fr * 32 + 8 * fq : (size_t)row * ldc + col0 + bj * HALF;
                    const f32x4 o0 = b0[m][bj] + acc[ai][bj][m][0], o1 = b1[m][bj] + acc[ai][bj][m][1];
                    ss += ((o0[0] * o0[0] + o0[1] * o0[1]) + (o0[2] * o0[2] + o0[3] * o0[3])) + ((o1[0] * o1[0] + o1[1] * o1[1]) + (o1[2] * o1[2] + o1[3] * o1[3]));
                    if constexpr (OUT_BF16) { u32x4 w; w.x = cvt_pk_bf16(o0[0], o0[1]); w.y = cvt_pk_bf16(o0[2], o0[3]); w.z = cvt_pk_bf16(o1[0], o1[1]); w.w = cvt_pk_bf16(o1[2], o1[3]);
                        *(u32x4*)((bf16_t*)out + off) = w; }
                    else { *(f32x4*)((float*)out + off) = o0; *(f32x4*)((float*)out + off + 4) = o1; } }
                ss += __shfl_xor(ss, 16); ss += __shfl_xor(ss, 32);
                if (fq == 0) part[(size_t)row * 64 + u.pn * 4 + wc] = ss; }
            asm volatile("" ::: "memory"); }
    }
};
struct EpiSoftmax {
    static constexpr bool PERM = true, AFTER_DRAIN = true;
    bf16_t* O; int ldc; const float* part; float eps;
    __device__ __forceinline__ void fused(f32x4 (&acc)[2][2][4][2], const Unit& u, int wr, int wc, int fr, int fq, PG8_LAS unsigned char* lds, int wid, int lane) const {
        PG8_LAS float* R = (PG8_LAS float*)lds;
        PG8_LAS f32x2* X = (PG8_LAS f32x2*)(lds + 1024);
        const int tid = wid * 64 + lane;
        {   const int row = tid >> 1, hf = tid & 1; const f32x4* p = (const f32x4*)(part + (size_t)(u.pm * BM + row) * 64 + hf * 32); float s = 0.f;
#pragma unroll
            for (int i = 0; i < 8; ++i) { const f32x4 a = p[i]; s += (a[0] + a[1]) + (a[2] + a[3]); }
            s += __shfl_xor(s, 1);
            if (hf == 0) R[row] = __builtin_amdgcn_rsqf(s * (1.0f / 4096.0f) + eps) * 1.4426950408889634f; }
        asm volatile("s_waitcnt lgkmcnt(0)" ::: "memory"); __builtin_amdgcn_s_barrier(); asm volatile("" ::: "memory");
        float mw[2][4];
#pragma unroll
        for (int ai = 0; ai < 2; ++ai)
#pragma unroll
            for (int m = 0; m < 4; ++m) { const int r = ai * HALF + wr * 64 + m * 16 + fr; const float rs = R[r]; float mx = -3.0e38f;
#pragma unroll
                for (int bj = 0; bj < 2; ++bj)
#pragma unroll
                    for (int n = 0; n < 2; ++n) { acc[ai][bj][m][n] = acc[ai][bj][m][n] * rs; const f32x4 x = acc[ai][bj][m][n]; mx = fmaxf(mx, fmaxf(fmaxf(x[0], x[1]), fmaxf(x[2], x[3]))); }
                mx = fmaxf(mx, __shfl_xor(mx, 16)); mx = fmaxf(mx, __shfl_xor(mx, 32)); mw[ai][m] = mx; float s = 0.f;
#pragma unroll
                for (int bj = 0; bj < 2; ++bj)
#pragma unroll
                    for (int n = 0; n < 2; ++n) { f32x4 x = acc[ai][bj][m][n];
#pragma unroll
                        for (int j = 0; j < 4; ++j) { x[j] = __builtin_amdgcn_exp2f(x[j] - mx); s += x[j]; }
                        acc[ai][bj][m][n] = x; }
                s += __shfl_xor(s, 16); s += __shfl_xor(s, 32);
                if (fq == 0) X[r * 4 + wc] = (f32x2){mx, s}; }
        asm volatile("s_waitcnt lgkmcnt(0)" ::: "memory"); __builtin_amdgcn_s_barrier(); asm volatile("" ::: "memory");
        const int row0 = u.pm * BM + wr * 64 + fr, col0 = u.pn * BM + wc * 32 + 8 * fq;
#pragma unroll
        for (int ai = 0; ai < 2; ++ai)
#pragma unroll
            for (int m = 0; m < 4; ++m) { const int r = ai * HALF + wr * 64 + m * 16 + fr;
                const f32x2 a = X[r * 4 + 0], b = X[r * 4 + 1], c = X[r * 4 + 2], d = X[r * 4 + 3];
                const float M = fmaxf(fmaxf(a.x, b.x), fmaxf(c.x, d.x));
                const float S = a.y * __builtin_amdgcn_exp2f(a.x - M) + b.y * __builtin_amdgcn_exp2f(b.x - M) + c.y * __builtin_amdgcn_exp2f(c.x - M) + d.y * __builtin_amdgcn_exp2f(d.x - M);
                const float f = __builtin_amdgcn_exp2f(mw[ai][m] - M) / S;
                bf16_t* rowp = O + (size_t)(row0 + ai * HALF + m * 16) * ldc + col0;
#pragma unroll
                for (int bj = 0; bj < 2; ++bj) { const f32x4 v0 = acc[ai][bj][m][0] * f, v1 = acc[ai][bj][m][1] * f;
                    u32x4 w; w.x = cvt_pk_bf16(v0[0], v0[1]); w.y = cvt_pk_bf16(v0[2], v0[3]); w.z = cvt_pk_bf16(v1[0], v1[1]); w.w = cvt_pk_bf16(v1[2], v1[3]);
                    *(u32x4*)(rowp + bj * HALF) = w; } }
    }
};

template <class Map, class Epi, class Sched, bool ALIGN_EPI = false, bool SP2 = false>
__device__ __forceinline__ void gemm_phase(PG8_LAS unsigned char* lds, const Map G, const Sched& S, const Epi& E, const int wid_) {
    const int wid = wid_ & 7, lane = hw_lane(), tid = wid * 64 + lane, wr = wid >> 2, wc = wid & 3, fr = lane & 15, fq = lane >> 4;
    const int nt = G.K / BK;
    unsigned voffA[2], voffB[2];
#pragma unroll
    for (int i = 0; i < 2; ++i) { int R, C; stage_rc(tid * 16 + i * 8192, R, C); const int Rb = Epi::PERM ? ((R & ~31) + perm32(R & 31)) : R;
        voffA[i] = G.voffA(R, C); voffB[i] = G.voffB(Rb, C); }
    const size_t kstepA = G.kstepA(), kstepB = G.kstepB();
    const size_t hstepA = G.hstepA(), hstepB = G.hstepB();
    const unsigned ldsw = (unsigned)wid * 1024u;
    const int aoff = lds_byte(wr * 64 + fr, fq * 8), boff = lds_byte(wc * 32 + fr, fq * 8);
#define PG8_SA(b, h) (((b) * 2 + (h)) * HTB)
#define PG8_SB(b, h) ((4 + (b) * 2 + (h)) * HTB)
#define PG8_STAGE(bufoff, gbase, voff) do { _Pragma("unroll") for (int _i = 0; _i < 2; ++_i) \
        __builtin_amdgcn_global_load_lds((const unsigned*)((const char*)(gbase) + (voff)[_i]), (PG8_LAS unsigned*)(lds + (bufoff) + ldsw + _i * 8192), 16, 0, 0); } while (0)
#define PG8_LDA(dst, b, h) do { _Pragma("unroll") for (int m = 0; m < 4; ++m) _Pragma("unroll") for (int k = 0; k < 2; ++k) dst[m][k] = *(const PG8_LAS bf16x8*)(lds + PG8_SA(b, h) + aoff + m * 2048 + k * 1024); } while (0)
#define PG8_LDB(dst, b, h) do { _Pragma("unroll") for (int n = 0; n < 2; ++n) _Pragma("unroll") for (int k = 0; k < 2; ++k) dst[n][k] = *(const PG8_LAS bf16x8*)(lds + PG8_SB(b, h) + boff + n * 2048 + k * 1024); } while (0)
#define PG8_MMA(ai, bj, At, Bt) do { __builtin_amdgcn_s_setprio(1); _Pragma("unroll") for (int m = 0; m < 4; ++m) _Pragma("unroll") for (int n = 0; n < 2; ++n) _Pragma("unroll") for (int k = 0; k < 2; ++k) \
        acc[ai][bj][m][n] = __builtin_amdgcn_mfma_f32_16x16x32_bf16(Bt[n][k], At[m][k], acc[ai][bj][m][n], 0, 0, 0); __builtin_amdgcn_s_setprio(0); } while (0)
#define PG8_WAIT_V(n) asm volatile("s_waitcnt vmcnt(" #n ")" ::: "memory")
#define PG8_WAIT_L(n) asm volatile("s_waitcnt lgkmcnt(" #n ")" ::: "memory")
#define PG8_BAR __builtin_amdgcn_s_barrier()
#define PG8_SCHED __builtin_amdgcn_sched_barrier(0)
    Unit cur, nxt; int ui = 0;
    if (!S.next(0, cur)) return;
    f32x4 acc[2][2][4][2];
#pragma unroll
    for (int a = 0; a < 2; ++a)
#pragma unroll
        for (int b = 0; b < 2; ++b)
#pragma unroll
            for (int m = 0; m < 4; ++m)
#pragma unroll
                for (int n = 0; n < 2; ++n) acc[a][b][m][n] = (f32x4){0.f, 0.f, 0.f, 0.f};
    bf16x8 At[4][2], B0[2][2], B1[2][2];
    const char* cA = G.a_base(cur); const char* cB = G.b_base(cur);
    if constexpr (SP2) {
        PG8_STAGE(PG8_SB(0, 0), cB, voffB); PG8_STAGE(PG8_SB(0, 1), cB + hstepB, voffB); PG8_STAGE(PG8_SA(0, 0), cA, voffA); PG8_STAGE(PG8_SA(0, 1), cA + hstepA, voffA);
        if (wr == 1) PG8_BAR;
        PG8_WAIT_V(2); PG8_BAR;
        PG8_STAGE(PG8_SB(1, 0), cB + kstepB, voffB); PG8_STAGE(PG8_SA(1, 0), cA + kstepA, voffA); PG8_STAGE(PG8_SB(1, 1), cB + hstepB + kstepB, voffB);
        PG8_WAIT_V(6); PG8_BAR;
    } else {
        PG8_STAGE(PG8_SB(0, 0), cB, voffB); PG8_STAGE(PG8_SA(0, 0), cA, voffA); PG8_STAGE(PG8_SB(0, 1), cB + hstepB, voffB); PG8_STAGE(PG8_SA(0, 1), cA + hstepA, voffA);
        if (wr == 1) PG8_BAR;
        PG8_WAIT_V(4); PG8_BAR;
        PG8_STAGE(PG8_SB(1, 0), cB + kstepB, voffB); PG8_STAGE(PG8_SA(1, 0), cA + kstepA, voffA); PG8_STAGE(PG8_SB(1, 1), cB + hstepB + kstepB, voffB);
        PG8_WAIT_V(6); PG8_BAR;
    }
    for (;;) {
        const bool has_next = S.next(ui + 1, nxt);
        const char* nA = has_next ? G.a_base(nxt) : cA; const char* nB = has_next ? G.b_base(nxt) : cB;
        for (int t = 0; t < nt; t += 2) {
            const bool last = (t == nt - 2);
            const char* a1 = cA + (size_t)(t + 1) * kstepA;
            const char* a2 = last ? nA : cA + (size_t)(t + 2) * kstepA; const char* b2 = last ? nB : cB + (size_t)(t + 2) * kstepB;
            const char* a3 = a2 + kstepA; const char* b3 = b2 + kstepB;
            if constexpr (SP2) {
            PG8_LDB(B0, 0, 0); PG8_LDB(B1, 0, 1); PG8_SCHED; PG8_LDA(At, 0, 0); PG8_STAGE(PG8_SA(1, 1), a1 + hstepA, voffA);
            PG8_WAIT_V(8); PG8_WAIT_L(0); PG8_BAR; PG8_MMA(0, 0, At, B0); PG8_MMA(0, 1, At, B1); PG8_BAR; PG8_SCHED;
            PG8_LDA(At, 0, 1); PG8_STAGE(PG8_SB(0, 0), b2, voffB); PG8_STAGE(PG8_SB(0, 1), b2 + hstepB, voffB); PG8_STAGE(PG8_SA(0, 0), a2, voffA);
            PG8_WAIT_V(8); PG8_WAIT_L(0); PG8_BAR; PG8_MMA(1, 0, At, B0); PG8_MMA(1, 1, At, B1); PG8_BAR; PG8_SCHED;
            PG8_LDB(B0, 1, 0); PG8_LDB(B1, 1, 1); PG8_SCHED; PG8_LDA(At, 1, 0); PG8_STAGE(PG8_SA(0, 1), a2 + hstepA, voffA);
            PG8_WAIT_V(8); PG8_WAIT_L(0); PG8_BAR; PG8_MMA(0, 0, At, B0); PG8_MMA(0, 1, At, B1); PG8_BAR; PG8_SCHED;
            PG8_LDA(At, 1, 1); PG8_STAGE(PG8_SB(1, 0), b3, voffB); PG8_STAGE(PG8_SB(1, 1), b3 + hstepB, voffB); PG8_STAGE(PG8_SA(1, 0), a3, voffA);
            PG8_WAIT_V(8); PG8_WAIT_L(0); PG8_BAR; PG8_MMA(1, 0, At, B0); PG8_MMA(1, 1, At, B1); PG8_BAR; PG8_SCHED;
            } else {
            PG8_LDB(B0, 0, 0); PG8_SCHED; PG8_LDA(At, 0, 0); PG8_STAGE(PG8_SA(1, 1), a1 + hstepA, voffA);
            PG8_WAIT_L(8); PG8_BAR; PG8_WAIT_L(0); PG8_MMA(0, 0, At, B0); PG8_BAR; PG8_SCHED;
            PG8_LDB(B1, 0, 1); PG8_STAGE(PG8_SB(0, 0), b2, voffB);
            PG8_BAR; PG8_WAIT_L(0); PG8_MMA(0, 1, At, B1); PG8_BAR;
            PG8_LDA(At, 0, 1); PG8_STAGE(PG8_SA(0, 0), a2, voffA);
            PG8_BAR; PG8_WAIT_L(0); PG8_MMA(1, 0, At, B0); PG8_BAR; PG8_SCHED;
            PG8_STAGE(PG8_SB(0, 1), b2 + hstepB, voffB);
            PG8_WAIT_V(6); PG8_BAR; PG8_MMA(1, 1, At, B1); PG8_BAR;
            PG8_LDB(B0, 1, 0); PG8_SCHED; PG8_LDA(At, 1, 0); PG8_STAGE(PG8_SA(0, 1), a2 + hstepA, voffA);
            PG8_WAIT_L(8); PG8_BAR; PG8_WAIT_L(0); PG8_MMA(0, 0, At, B0); PG8_BAR; PG8_SCHED;
            PG8_LDB(B1, 1, 1); PG8_STAGE(PG8_SB(1, 0), b3, voffB);
            PG8_BAR; PG8_WAIT_L(0); PG8_MMA(0, 1, At, B1); PG8_BAR;
            PG8_LDA(At, 1, 1); PG8_STAGE(PG8_SA(1, 0), a3, voffA);
            PG8_BAR; PG8_WAIT_L(0); PG8_MMA(1, 0, At, B0); PG8_BAR; PG8_SCHED;
            PG8_STAGE(PG8_SB(1, 1), b3 + hstepB, voffB);
            PG8_WAIT_V(6); PG8_BAR; PG8_MMA(1, 1, At, B1); PG8_BAR;
            }
        }
        if constexpr (ALIGN_EPI) { if (wr == 0) PG8_BAR; }
        if constexpr (!Epi::AFTER_DRAIN) { E(acc, cur, wr, wc, fr, fq); }
        if (!has_next) break;
#pragma unroll
        for (int a = 0; a < 2; ++a)
#pragma unroll
            for (int b = 0; b < 2; ++b)
#pragma unroll
                for (int m = 0; m < 4; ++m)
#pragma unroll
                    for (int n = 0; n < 2; ++n) acc[a][b][m][n] = (f32x4){0.f, 0.f, 0.f, 0.f};
        cur = nxt; cA = nA; cB = nB; ++ui;
        if constexpr (ALIGN_EPI) { if (wr == 1) PG8_BAR; }
    }
    PG8_WAIT_V(0);
    if constexpr (!ALIGN_EPI) { if (wr == 0) PG8_BAR; }
    PG8_BAR;
    if constexpr (Epi::AFTER_DRAIN) { E.fused(acc, cur, wr, wc, fr, fq, lds, wid, lane); }
#undef PG8_SA
#undef PG8_SB
#undef PG8_STAGE
#undef PG8_LDA
#undef PG8_LDB
#undef PG8_MMA
#undef PG8_WAIT_V
#undef PG8_WAIT_L
#undef PG8_BAR
#undef PG8_SCHED
}
}

namespace att {
typedef unsigned short bf16;
typedef short bf16x8 __attribute__((ext_vector_type(8)));
typedef short s16x4 __attribute__((ext_vector_type(4)));
typedef float f32x16 __attribute__((ext_vector_type(16)));
typedef float f32x4 __attribute__((ext_vector_type(4)));
typedef unsigned u32x4 __attribute__((ext_vector_type(4)));
constexpr int D = 128, NW = 8, QBLK = 32, KVBLK = 64, QB = NW * QBLK;
constexpr float SCALE = 0.08838834764831845f;
constexpr float THR = 8.f;
constexpr int SHM_V = KVBLK * D * 2, SHM_K = KVBLK * D * 2;
constexpr int OFF_SCR = 2 * SHM_V + 2 * SHM_K, OFF_TAB = OFF_SCR + NW * 64 * 4, OFF_Q = OFF_TAB + 2 * 16384, LDS_BYTES = OFF_Q + NW * 4096;

#define KSWZ(row, colB) ((row) * 256 + ((colB) ^ (((row) & 7) << 4)))
#define SBAR() __builtin_amdgcn_sched_barrier(0)
__device__ __forceinline__ int v_st(int k, int c) { const int kk = (k & ~0xC) | ((k & 4) << 1) | ((k & 8) >> 1); return ((kk >> 3) * 4 + (c >> 5)) * 512 + ((kk & 7) * 32 + (c & 31)) * 2; }
__device__ __forceinline__ int v_rd_base(int lane) { return ((lane & 3) << 3) | (((lane >> 2) & 3) << 6) | (((lane >> 4) & 1) << 5) | (((lane >> 5) & 1) << 8); }
constexpr int v_rd_off(int d0, int ks, int half) { return d0 * 512 + ks * 4096 + half * 2048; }
__device__ __forceinline__ int crow(int r, int hi) { return (r & 3) + 8 * (r >> 2) + 4 * hi; }
__device__ __forceinline__ unsigned cvtpk(float lo, float hi) { unsigned r; asm volatile("v_cvt_pk_bf16_f32 %0, %1, %2" : "=v"(r) : "v"(lo), "v"(hi)); return r; }
__device__ __forceinline__ bf16x8 ld8(const bf16* p) { return *reinterpret_cast<const bf16x8*>(p); }

__device__ __forceinline__ void mask_tile(f32x16& p0, f32x16& p1, int dq) {
    const float NEG = -__builtin_inff();
#pragma unroll
    for (int r = 0; r < 16; ++r) {
        const int c = (r & 3) + 8 * (r >> 2);
        if (dq - c < 0) p0[r] = NEG;
        if (dq - c - 32 < 0) p1[r] = NEG;
    }
}
__device__ __forceinline__ void diff_bias(f32x16& p0, f32x16& p1, const float* tl, int kb) {
    const float* t = tl + kb;
#pragma unroll
    for (int g = 0; g < 4; ++g) {
#pragma unroll
        for (int j = 0; j < 4; ++j) { const int c = j + 8 * g; p0[4 * g + j] += t[c]; p1[4 * g + j] += t[c + 32]; }
        asm volatile("" ::: "memory"); }
}
__device__ __forceinline__ void partialSM(f32x16& p0, f32x16& p1, float& m_reg, float& mn, float& alpha) {
    float pmax = fmaxf(p0[0], p1[0]);
#pragma unroll
    for (int r = 1; r < 16; ++r) pmax = __builtin_fmaxf(__builtin_fmaxf(pmax, p0[r]), p1[r]);
    { auto rr = __builtin_amdgcn_permlane32_swap(__float_as_uint(pmax), __float_as_uint(pmax), false, false);
      pmax = fmaxf(__uint_as_float(rr[0]), __uint_as_float(rr[1])); }
    constexpr float C2 = 1.4426950408889634f * SCALE;
    if (__builtin_expect(__all((pmax - m_reg) * SCALE <= THR), 1)) { mn = m_reg; alpha = 1.f; }
    else { mn = fmaxf(m_reg, pmax); alpha = __builtin_amdgcn_exp2f((m_reg - mn) * C2); m_reg = mn; }
    const float mnL = -mn * C2;
    for (int r = 0; r < 16; ++r) p0[r] = fmaf(p0[r], C2, mnL); for (int r = 0; r < 16; ++r) p1[r] = fmaf(p1[r], C2, mnL);
    for (int r = 0; r < 16; ++r) p0[r] = __builtin_amdgcn_exp2f(p0[r]);
}
__device__ __forceinline__ void finishSM(f32x16& p0, f32x16& p1, float alpha, float& l_reg, bf16x8& pa0, bf16x8& pa1, bf16x8& pa2, bf16x8& pa3) {
    for (int r = 0; r < 16; ++r) p1[r] = __builtin_amdgcn_exp2f(p1[r]);
    float ps = 0; for (int r = 0; r < 16; ++r) ps += p0[r]; for (int r = 0; r < 16; ++r) ps += p1[r];
    { auto rr = __builtin_amdgcn_permlane32_swap(__float_as_uint(ps), __float_as_uint(ps), false, false);
      ps = __uint_as_float(rr[0]) + __uint_as_float(rr[1]); }
    l_reg = l_reg * alpha + ps;
#define PK4(P, B_, OUT) do { unsigned a0 = cvtpk(P[B_+0], P[B_+1]), a1 = cvtpk(P[B_+2], P[B_+3]);                          \
        unsigned b0 = cvtpk(P[B_+4], P[B_+5]), b1 = cvtpk(P[B_+6], P[B_+7]);                                             \
        auto r0 = __builtin_amdgcn_permlane32_swap(a0, b0, false, false); auto r1 = __builtin_amdgcn_permlane32_swap(a1, b1, false, false); \
        u32x4 w = {r0[0], r1[0], r0[1], r1[1]}; OUT = *reinterpret_cast<bf16x8*>(&w); } while (0)
    PK4(p0, 0, pa0); PK4(p0, 8, pa1); PK4(p1, 0, pa2); PK4(p1, 8, pa3);
#undef PK4
}
template <int KB, int MODE, int QR = 4>
__device__ __forceinline__ void qkt(f32x16& p0, f32x16& p1, const char* K_lds, int r32, int hi, const bf16x8* qr, const char* qsl, const float* tabk) {
    p0 = f32x16{}; p1 = f32x16{};
    float x0 = 0.f, x1 = 0.f;
    if (MODE == 0) { x0 = tabk[0]; x1 = tabk[32]; }
    const char* kb[4];
#pragma unroll
    for (int dd = 0; dd < 4; ++dd) kb[dd] = K_lds + KB * SHM_K + KSWZ(r32, (dd * 16 + hi * 8) * 2);
#pragma unroll
    for (int d0 = 0; d0 < 8; ++d0) { const char* a = kb[d0 & 3] + (d0 >> 2) * 128;
        bf16x8 b0 = *reinterpret_cast<const bf16x8*>(a);
        bf16x8 b1 = *reinterpret_cast<const bf16x8*>(a + 32 * 256);
        const bf16x8 qv = (d0 < QR) ? qr[d0 < QR ? d0 : 0] : *reinterpret_cast<const bf16x8*>(qsl + (d0 - QR) * 1024);
        p0 = __builtin_amdgcn_mfma_f32_32x32x16_bf16(b0, qv, p0, 0, 0, 0);
        p1 = __builtin_amdgcn_mfma_f32_32x32x16_bf16(b1, qv, p1, 0, 0, 0); }
    if (MODE == 0) {
        const unsigned ua = __float_as_uint(x0), a1 = ua & 0xffff0000u; const float ra = x0 - __uint_as_float(a1); const unsigned a2 = __float_as_uint(ra) & 0xffff0000u; const float rb = ra - __uint_as_float(a2);
        const unsigned ub = __float_as_uint(x1), b1 = ub & 0xffff0000u; const float rc = x1 - __uint_as_float(b1); const unsigned b2 = __float_as_uint(rc) & 0xffff0000u; const float rd = rc - __uint_as_float(b2);
        u32x4 ka = {hi ? 0u : ((a1 >> 16) | a2), hi ? 0u : (__float_as_uint(rb) >> 16), 0u, 0u};
        u32x4 kb2 = {hi ? 0u : ((b1 >> 16) | b2), hi ? 0u : (__float_as_uint(rd) >> 16), 0u, 0u};
        const u32x4 qx = {0x3f803f80u, 0x00003f80u, 0u, 0u};
        p0 = __builtin_amdgcn_mfma_f32_32x32x16_bf16(*reinterpret_cast<bf16x8*>(&ka), *reinterpret_cast<const bf16x8*>(&qx), p0, 0, 0, 0);
        p1 = __builtin_amdgcn_mfma_f32_32x32x16_bf16(*reinterpret_cast<bf16x8*>(&kb2), *reinterpret_cast<const bf16x8*>(&qx), p1, 0, 0, 0);
    }
}
template <int VB>
__device__ __forceinline__ void pv_tile(f32x16* o, int vb0, bf16x8 pa0, bf16x8 pa1, bf16x8 pa2, bf16x8 pa3) {
#define TRRD(dst, off) asm volatile("ds_read_b64_tr_b16 %0, %1 offset:%2" : "=&v"(dst) : "v"(vb0), "i"(off) : "memory")
#define PV_D0(d0) do { s16x4 l0, l1, l2, l3, h0, h1, h2, h3; constexpr int b_ = VB * SHM_V + v_rd_off(d0, 0, 0); \
        TRRD(l0, b_); TRRD(h0, b_ + 2048); TRRD(l1, b_ + 4096); TRRD(h1, b_ + 6144); TRRD(l2, b_ + 8192); TRRD(h2, b_ + 10240); TRRD(l3, b_ + 12288); TRRD(h3, b_ + 14336); \
        asm volatile("s_waitcnt lgkmcnt(0)" ::: "memory"); SBAR();   \
        o[d0] = __builtin_amdgcn_mfma_f32_32x32x16_bf16(pa0, (bf16x8){l0[0], l0[1], l0[2], l0[3], h0[0], h0[1], h0[2], h0[3]}, o[d0], 0, 0, 0);   \
        o[d0] = __builtin_amdgcn_mfma_f32_32x32x16_bf16(pa1, (bf16x8){l1[0], l1[1], l1[2], l1[3], h1[0], h1[1], h1[2], h1[3]}, o[d0], 0, 0, 0);   \
        o[d0] = __builtin_amdgcn_mfma_f32_32x32x16_bf16(pa2, (bf16x8){l2[0], l2[1], l2[2], l2[3], h2[0], h2[1], h2[2], h2[3]}, o[d0], 0, 0, 0);   \
        o[d0] = __builtin_amdgcn_mfma_f32_32x32x16_bf16(pa3, (bf16x8){l3[0], l3[1], l3[2], l3[3], h3[0], h3[1], h3[2], h3[3]}, o[d0], 0, 0, 0); } while (0)
    PV_D0(0); PV_D0(1); PV_D0(2); PV_D0(3);
#undef PV_D0
#undef TRRD
}

struct BlockRef { const bf16* Q; const bf16* K; const bf16* V; void* O; const float* tab; int P0; int kb0; float kmax2; int tabn; int c; float lam; const float* gs; float* scr; };
struct Seam { bf16x8 qr[8]; bf16x8 st_v0, st_v1, st_k0, st_k1; int tb; };
#define ROW(p, k0, rr) ((p) + (size_t)((k0) + (rr)) * D + sc)
#define VMW() asm volatile("s_waitcnt vmcnt(0)" ::: "memory")
#define VMWN(n) asm volatile("s_waitcnt vmcnt(%0)" :: "i"(n) : "memory")
#define SLOAD_H(Kp, Vp, k0) do { S.st_v0 = ld8(ROW(Vp, k0, sr)); S.st_v1 = ld8(ROW(Vp, k0, 32 + sr));              \
                         S.st_k0 = ld8(ROW(Kp, k0, sr)); S.st_k1 = ld8(ROW(Kp, k0, 32 + sr)); } while (0)
#define SWRITE_HK(bf) do { *(bf16x8*)(K_lds + (bf) * SHM_K + kws) = S.st_k0; *(bf16x8*)(K_lds + (bf) * SHM_K + kws + 32 * 256) = S.st_k1; } while (0)
#define SWRITE_HV(bf) do { *(bf16x8*)(V_lds + (bf) * SHM_V + vst0) = S.st_v0; *(bf16x8*)(V_lds + (bf) * SHM_V + vst1) = S.st_v1; } while (0)
#define SWRITE_H(bf) do { SWRITE_HV(bf); SWRITE_HK(bf); } while (0)
__device__ __forceinline__ void attn_prime(const BlockRef& cur, char* lds, Seam& S, const int wid_) {
    const int wid = wid_ & 7, lane = pg8::hw_lane(), tid = wid * 64 + lane, r32 = lane & 31, hi = lane >> 5;
    const int sr = tid >> 4, sc = (tid & 15) * 8, kws = KSWZ(sr, sc * 2); char* K_lds = lds + 2 * SHM_V;
#pragma unroll
    for (int d0 = 0; d0 < 8; ++d0) S.qr[d0] = ld8(cur.Q + (size_t)(wid * QBLK + r32) * D + d0 * 16 + hi * 8);
    SLOAD_H(cur.K, cur.V, cur.kb0); VMW(); SWRITE_HK(0);
    S.tb = 0; { float* tabL = (float*)(lds + OFF_TAB); for (int i = tid * 4; i < cur.tabn; i += 2048) *(f32x4*)(tabL + i) = *(const f32x4*)(cur.tab + i); }
    __syncthreads();
}
template <int MODE>
__device__ __forceinline__ void attn_block(const BlockRef& cur, const BlockRef& nxt, char* lds, Seam& S, const int wid_) {
    const int wid = wid_ & 7, lane = pg8::hw_lane(), tid = wid * 64 + lane, r32 = lane & 31, hi = lane >> 5;
    constexpr int ldo = MODE ? 2048 : 4096;
    int NT = cur.P0 / KVBLK + 4;
    const int jtop = NT - 1;
    const int qlo = cur.P0 + wid * QBLK, row = qlo + r32;
    const int qlo_m = MODE ? (qlo | 63) : qlo;
    const int qm = (MODE ? (row | 63) : row) - 4 * hi;
    char* V_lds = lds; char* K_lds = lds + 2 * SHM_V;
    float* ws = (float*)(lds + OFF_SCR) + wid * 64; float* li_l = ws, * al_l = ws + 32;
    float* tabL = (float*)(lds + OFF_TAB + S.tb * 16384);
    float qn2 = 0.f;
    if (MODE == 0) {
#pragma unroll
        for (int d0 = 0; d0 < 8; ++d0)
#pragma unroll
            for (int e = 0; e < 8; ++e) { const float f = __uint_as_float((unsigned)(unsigned short)S.qr[d0][e] << 16); qn2 += f * f; }
        auto rr = __builtin_amdgcn_permlane32_swap(__float_as_uint(qn2), __float_as_uint(qn2), false, false); qn2 = __uint_as_float(rr[0]) + __uint_as_float(rr[1]); }
    char* qsl = lds + OFF_Q + wid * 4096 + lane * 16;
#pragma unroll
    for (int j = 0; j < 4; ++j) *(bf16x8*)(qsl + j * 1024) = S.qr[4 + j];
    if (MODE == 0) {
        const float X = 2.0f * sqrtf(qn2 * cur.kmax2) - tabL[row];
        float xm = X;
#pragma unroll
        for (int o_ = 1; o_ < 64; o_ <<= 1) xm = fmaxf(xm, __shfl_xor(xm, o_));
        if (lane == 0) li_l[0] = xm;
        __syncthreads();
        float xb = -3.0e38f;
#pragma unroll
        for (int w = 0; w < NW; ++w) xb = fmaxf(xb, ((float*)(lds + OFF_SCR))[w * 64]);
        const float thr = -164.0f / (1.4426950408889634f * SCALE) - xb;
        int lo = 0, hi_ = jtop;
        while (lo < hi_) { const int mid = (lo + hi_) >> 1; if (tabL[64 * mid + 63] < thr) lo = mid + 1; else hi_ = mid; }
        NT = jtop - lo + 1;
        __syncthreads();
    }
    const float* tl = MODE ? (tabL + (192 + 4 * hi - row)) : (tabL + r32);
    float m_reg = -1e30f, l_reg = 0; f32x16 o[4] = {};
    const int sr = tid >> 4, sc = (tid & 15) * 8, vst0 = v_st(sr, sc), vst1 = v_st(32 + sr, sc), kws = KSWZ(sr, sc * 2);
    const int vb0 = (int)(uintptr_t)V_lds + v_rd_base(lane);
    const bf16* Kh = cur.K; const bf16* Vh = cur.V;
#define RESC(a) do { if (__any((a) < 1.f)) { if (hi == 0) al_l[r32] = (a); asm volatile("s_waitcnt lgkmcnt(0)" ::: "memory");              \
                     for (int d_ = 0; d_ < 4; ++d_) for (int r = 0; r < 16; ++r) o[d_][r] *= al_l[crow(r, hi)]; } } while (0)
#define KBASE(t) (MODE == 0 ? (jtop - (t)) * KVBLK : (t) * KVBLK)
#define MASKT(P0_, P1_, t) do { const int kb_ = KBASE(t);                                                                    \
        if (MODE == 1) { if (kb_ >= qlo - 153 && kb_ <= qlo_m) diff_bias(P0_, P1_, tl, kb_); }                              \
        if (kb_ + KVBLK - 1 > qlo_m) mask_tile(P0_, P1_, qm - kb_); } while (0)
    constexpr int NQL = 8;
#define SEAM_K0() do { VMWN(NQL); SWRITE_HK(0); SBAR(); } while (0)
    f32x16 pA0, pA1, pB0, pB1; float mnA, mnB, alA, alB; bf16x8 pa0, pa1, pa2, pa3;
    SWRITE_HV(0); SBAR();
    if (NT > 1) { SLOAD_H(Kh, Vh, KBASE(1)); }
    SBAR(); qkt<0, MODE>(pA0, pA1, K_lds, r32, hi, S.qr, qsl, tl + KBASE(0));
    MASKT(pA0, pA1, 0); partialSM(pA0, pA1, m_reg, mnA, alA);
    if (NT > 1) { VMW(); SWRITE_HK(1); }
    __syncthreads();
#define HALF_STEP(PX0, PX1, mnX, alX, PY0, PY1, alY, t, KB, VB, SB) do {                                                      \
        SWRITE_HV(KB);                                                                                                        \
        if ((t) + 1 < NT) { SLOAD_H(Kh, Vh, KBASE((t) + 1)); }                                                                \
        SBAR(); qkt<KB, MODE>(PX0, PX1, K_lds, r32, hi, S.qr, qsl, tl + KBASE(t));                                           \
        finishSM(PY0, PY1, alY, l_reg, pa0, pa1, pa2, pa3); SBAR();                                                           \
        pv_tile<VB>(o, vb0, pa0, pa1, pa2, pa3); MASKT(PX0, PX1, (t)); partialSM(PX0, PX1, m_reg, mnX, alX);                  \
        if ((t) + 1 < NT) { VMW(); SWRITE_HK(SB); }                                                                           \
        RESC(alX); __syncthreads(); } while (0)
    for (int t = 1; t + 1 < NT; t += 2) {
        HALF_STEP(pB0, pB1, mnB, alB, pA0, pA1, alA, t, 1, 0, 0);
        HALF_STEP(pA0, pA1, mnA, alA, pB0, pB1, alB, t + 1, 0, 1, 1);
    }
    const bool even = (NT & 1) == 0;
    if (even) { SWRITE_HV(1); SBAR(); qkt<1, MODE>(pB0, pB1, K_lds, r32, hi, S.qr, qsl, tl + KBASE(NT - 1)); SBAR(); }
    SLOAD_H(nxt.K, nxt.V, nxt.kb0); SBAR();
#pragma unroll
    for (int d0 = 0; d0 < 4; ++d0) S.qr[d0] = ld8(nxt.Q + (size_t)(wid * QBLK + r32) * D + d0 * 16 + hi * 8);
    SBAR();
    finishSM(pA0, pA1, alA, l_reg, pa0, pa1, pa2, pa3); SBAR();
    pv_tile<0>(o, vb0, pa0, pa1, pa2, pa3);
    if (even) { MASKT(pB0, pB1, NT - 1); partialSM(pB0, pB1, m_reg, mnB, alB); __syncthreads(); RESC(alB);
        finishSM(pB0, pB1, alB, l_reg, pa0, pa1, pa2, pa3); SBAR(); pv_tile<1>(o, vb0, pa0, pa1, pa2, pa3); }
    SBAR();
#pragma unroll
    for (int d0 = 4; d0 < 8; ++d0) S.qr[d0] = ld8(nxt.Q + (size_t)(wid * QBLK + r32) * D + d0 * 16 + hi * 8);
    SBAR(); SEAM_K0();
    f32x4 tn0 = {0.f, 0.f, 0.f, 0.f}, tn1 = {0.f, 0.f, 0.f, 0.f};
    if (tid * 4 < nxt.tabn) tn0 = *(const f32x4*)(nxt.tab + tid * 4);
    if (tid * 4 + 2048 < nxt.tabn) tn1 = *(const f32x4*)(nxt.tab + tid * 4 + 2048);
    SBAR();
    if (hi == 0) li_l[r32] = l_reg; asm volatile("s_waitcnt lgkmcnt(0)" ::: "memory");
    float rli[16];
#pragma unroll
    for (int r = 0; r < 16; ++r) rli[r] = __builtin_amdgcn_rcpf(li_l[crow(r, hi)]);
    if (MODE == 0) { bf16* Ow = (bf16*)cur.O + (size_t)(wid * QBLK) * ldo;
#pragma unroll
        for (int r = 0; r < 16; ++r) { const int orow = crow(r, hi);
#pragma unroll
            for (int d0 = 0; d0 < 4; ++d0) { const float v = o[d0][r] * rli[r]; const float vn = __shfl_xor(v, 1);
                if ((r32 & 1) == 0) *(unsigned*)(Ow + (size_t)orow * ldo + d0 * 32 + r32) = cvtpk(v, vn); } } }
    else { bf16* Ow = (bf16*)cur.O + (size_t)(wid * QBLK) * ldo;
#pragma unroll
        for (int r = 0; r < 16; ++r) { const int orow = crow(r, hi);
#pragma unroll
            for (int d0 = 0; d0 < 4; ++d0) { const float v = o[d0][r] * rli[r]; const float vn = __shfl_xor(v, 1);
                if ((r32 & 1) == 0) *(unsigned*)(Ow + (size_t)orow * ldo + d0 * 32 + r32) = cvtpk(v, vn); } } }
    { float* tabN = (float*)(lds + OFF_TAB + (S.tb ^ 1) * 16384);
      if (tid * 4 < nxt.tabn) *(f32x4*)(tabN + tid * 4) = tn0;
      if (tid * 4 + 2048 < nxt.tabn) *(f32x4*)(tabN + tid * 4 + 2048) = tn1; }
    S.tb ^= 1;
    __syncthreads();
#undef RESC
#undef KBASE
#undef MASKT
#undef SEAM_K0
#undef HALF_STEP
}

constexpr int DQR = 4;
constexpr int D_OFF_V1 = OFF_TAB + 2048, D_OFF_Q = D_OFF_V1 + 2 * SHM_V, D_LDS_BYTES = D_OFF_Q + NW * (8 - DQR) * 1024;
constexpr int VHALF_B = 4096 * 128 * 2;
struct DSeam { bf16x8 qr[DQR]; int tb; };
#define DMA16(g, l) __builtin_amdgcn_global_load_lds((const unsigned*)(g), (PG8_LAS unsigned*)(l), 16, 0, 0)
#define D_LANE_OFFS()                                                                                                                  \
    const int grp = wid >> 2, wa_ = wid & 3;                    \
    const int krow_ = 4 * wa_ + (lane >> 4);                                                                                           \
    const unsigned koff = (unsigned)(krow_ * 256 + (((lane & 15) ^ (krow_ & 7)) << 4));                                                \
    const int vs_ = 2 * wa_ + (lane >> 5), vkk_ = (vs_ >> 2) * 8 + ((lane >> 2) & 7), vk_ = (vkk_ & ~0xC) | ((vkk_ & 4) << 1) | ((vkk_ & 8) >> 1); \
    const unsigned voff = (unsigned)(vk_ * 256 + ((vs_ & 3) * 32 + (lane & 3) * 8) * 2);                                               \
    PG8_LAS unsigned char* const kdst = ldsL + 2 * SHM_V + wa_ * 1024; PG8_LAS unsigned char* const vdst0 = ldsL + wa_ * 1024; PG8_LAS unsigned char* const vdst1 = ldsL + D_OFF_V1 + wa_ * 1024
#define DMA_K(Kp, key0, KB_) do { const char* g_ = (const char*)(Kp) + (size_t)(key0) * 256;                                           \
        _Pragma("unroll") for (int j_ = 0; j_ < 4; ++j_) DMA16(g_ + j_ * 4096 + koff, kdst + (KB_) * SHM_K + j_ * 4096); } while (0)
#define DMA_V(Vp, key0, VB_) do { const char* g_ = (const char*)(Vp) + (size_t)(key0) * 256;                                           \
        _Pragma("unroll") for (int j_ = 0; j_ < 4; ++j_) DMA16(g_ + j_ * 4096 + voff, vdst0 + (VB_) * SHM_V + j_ * 4096);                 \
        _Pragma("unroll") for (int j_ = 0; j_ < 4; ++j_) DMA16(g_ + (VHALF_B + j_ * 4096) + voff, vdst1 + (VB_) * SHM_V + j_ * 4096); } while (0)
__device__ __forceinline__ float dpp_xor1(float v) { return __int_as_float(__builtin_amdgcn_mov_dpp(__float_as_int(v), 0xB1, 0xF, 0xF, true)); }
__device__ __forceinline__ float half_sum32(float v) {
    v += __int_as_float(__builtin_amdgcn_mov_dpp(__float_as_int(v), 0xB1, 0xF, 0xF, true));
    v += __int_as_float(__builtin_amdgcn_mov_dpp(__float_as_int(v), 0x4E, 0xF, 0xF, true));
    v += __int_as_float(__builtin_amdgcn_mov_dpp(__float_as_int(v), 0x141, 0xF, 0xF, true));
    v += __int_as_float(__builtin_amdgcn_mov_dpp(__float_as_int(v), 0x140, 0xF, 0xF, true));
    { auto rr = __builtin_amdgcn_permlane16_swap(__float_as_uint(v), __float_as_uint(v), false, false); v = __uint_as_float(rr[0]) + __uint_as_float(rr[1]); }
    return v;
}
__device__ __forceinline__ void dattn_prime(const BlockRef& cur, char* lds, PG8_LAS unsigned char* ldsL, DSeam& S, const int wid_) {
    const int wid = wid_ & 7, lane = pg8::hw_lane(), tid = wid * 64 + lane, r32 = lane & 31, hi = lane >> 5;
    D_LANE_OFFS(); (void)voff; (void)vdst0; (void)vdst1;
    char* qsl = lds + D_OFF_Q + wid * ((8 - DQR) * 1024) + lane * 16;
#pragma unroll
    for (int d0 = 0; d0 < DQR; ++d0) S.qr[d0] = ld8(cur.Q + (size_t)(wid * QBLK + r32) * D + d0 * 16 + hi * 8);
#pragma unroll
    for (int d0 = DQR; d0 < 8; ++d0) { const bf16x8 t = ld8(cur.Q + (size_t)(wid * QBLK + r32) * D + d0 * 16 + hi * 8); *(bf16x8*)(qsl + (d0 - DQR) * 1024) = t; }
    if (grp == 0) DMA_K(cur.K, cur.kb0, 0);
    S.tb = 0; if (tid < 64) *(f32x4*)((float*)(lds + OFF_TAB) + tid * 4) = *(const f32x4*)(cur.tab + tid * 4);
    VMW(); __syncthreads();
    if (grp == 1) __syncthreads();
}
constexpr int D_OFF_CV = D_LDS_BYTES;
constexpr int CV_N = 4096, CV_KBLK = 512;
struct CvState { const float* src; bf16* dst; int next, end, hist; };
#define CV_DMA(h, par) do { const int it_ = (h) >> 1, kh_ = (h) & 1, nbk_ = CV_N >> 6, kb_ = it_ / nbk_, nb_ = it_ - kb_ * nbk_, wv_ = wid & 3;                   \
        const char* g_ = (const char*)(cv.src + (size_t)(64 * kb_ + 32 * kh_ + 8 * wv_) * CV_N + 64 * nb_);                                             \
        const unsigned off_ = (unsigned)(((lane >> 4) * CV_N + 4 * ((lane & 15) ^ (4 * wv_))) * 4);       \
        PG8_LAS unsigned char* l_ = ldsL + D_OFF_CV + (par) * 8192 + wv_ * 2048;                                                                         \
        __builtin_amdgcn_global_load_lds((const unsigned*)(g_ + off_), (PG8_LAS unsigned*)l_, 16, 0, 0);                                                 \
        __builtin_amdgcn_global_load_lds((const unsigned*)(g_ + (size_t)CV_N * 16 + off_), (PG8_LAS unsigned*)(l_ + 1024), 16, 0, 0); } while (0)
#define CV_CONVERT(h, par) do { const int it_ = (h) >> 1, kh_ = (h) & 1, nbk_ = CV_N >> 6, kb_ = it_ / nbk_, nb_ = it_ - kb_ * nbk_, wv_ = wid & 3;               \
        const int nl_ = lane >> 2, kg_ = lane & 3, ch_ = ((16 * wv_ + nl_) >> 2) ^ (4 * kg_);                                                            \
        const float* s_ = (const float*)(lds + D_OFF_CV + (par) * 8192 + kg_ * 2048 + ch_ * 16 + (nl_ & 3) * 4);         \
        float v_[8]; _Pragma("unroll") for (int j_ = 0; j_ < 8; ++j_) v_[j_] = s_[j_ * 64];                                                              \
        u32x4 o_; o_[0] = cvtpk(v_[0], v_[1]); o_[1] = cvtpk(v_[2], v_[3]); o_[2] = cvtpk(v_[4], v_[5]); o_[3] = cvtpk(v_[6], v_[7]);                     \
        *(u32x4*)(cv.dst + ((size_t)(4 * nb_ + wv_) * CV_KBLK + 2 * kb_ + kh_) * 512 + lane * 8) = o_; } while (0)
__device__ __forceinline__ void cv_finish(CvState& cv, char* lds, PG8_LAS unsigned char* ldsL, const int wid_) {
    const int wid = wid_ & 7, lane = pg8::hw_lane(), grp = wid >> 2;
    if (cv.hist & 1) { const int h_ = cv.next - 1; if (grp == 1) VMW(); __syncthreads(); if (grp == 1) CV_CONVERT(h_, h_ & 1); __syncthreads(); cv.hist = 0; }
    while (cv.next < cv.end) { const int h_ = cv.next++; if (grp == 1) { CV_DMA(h_, 0); VMW(); } __syncthreads(); if (grp == 1) CV_CONVERT(h_, 0); __syncthreads(); }
}
__device__ __forceinline__ void dattn_finish(const int wid_) { if (((wid_ & 7) >> 2) == 0) __syncthreads(); }
#define KRD(dst, a, off) asm volatile("ds_read_b128 %0, %1 offset:%2" : "=v"(dst) : "v"(a), "i"(off) : "memory")
#define TRD(dst, a, off) asm volatile("ds_read_b64_tr_b16 %0, %1 offset:%2" : "=v"(dst) : "v"(a), "i"(off) : "memory")
#define LGKW1(n, x) asm volatile("s_waitcnt lgkmcnt(%1)" : "+v"(x) : "i"(n) : "memory")
#define LGKW2(n, x, y) asm volatile("s_waitcnt lgkmcnt(%2)" : "+v"(x), "+v"(y) : "i"(n) : "memory")
#define MFMA(a, b, c) __builtin_amdgcn_mfma_f32_32x32x16_bf16(a, b, c, 0, 0, 0)
#define VCAT(l, h) ((bf16x8){l[0], l[1], l[2], l[3], h[0], h[1], h[2], h[3]})
#define ZERO16 ((f32x16){0.f, 0.f, 0.f, 0.f, 0.f, 0.f, 0.f, 0.f, 0.f, 0.f, 0.f, 0.f, 0.f, 0.f, 0.f, 0.f})
#define DM_QKPV(KB_, VB_) do { \
        KRD(ks0, ka0, (KB_) * SHM_K + 0); \
        KRD(ks1, ka0, (KB_) * SHM_K + 8192); \
        KRD(ks2, ka1, (KB_) * SHM_K + 0); \
        KRD(ks3, ka1, (KB_) * SHM_K + 8192); \
        KRD(ks4, ka2, (KB_) * SHM_K + 0); \
        KRD(ks5, ka2, (KB_) * SHM_K + 8192); \
        KRD(qs0, qa, 0); \
        KRD(qs1, qa, 1024); \
        LGKW1(7, ks0); pX0 = MFMA(ks0, S.qr[0], ZERO16); SBAR(); \
        KRD(ks0, ka3, (KB_) * SHM_K + 0); \
        LGKW1(7, ks1); pX1 = MFMA(ks1, S.qr[0], ZERO16); SBAR(); \
        KRD(ks1, ka3, (KB_) * SHM_K + 8192); \
        LGKW1(7, ks2); pX0 = MFMA(ks2, S.qr[1], pX0); SBAR(); \
        KRD(ks2, ka0, (KB_) * SHM_K + 128); \
        LGKW1(7, ks3); pX1 = MFMA(ks3, S.qr[1], pX1); SBAR(); \
        KRD(ks3, ka0, (KB_) * SHM_K + 8320); \
        LGKW1(7, ks4); pX0 = MFMA(ks4, S.qr[2], pX0); SBAR(); \
        KRD(ks4, ka1, (KB_) * SHM_K + 128); \
        LGKW1(7, ks5); pX1 = MFMA(ks5, S.qr[2], pX1); SBAR(); \
        KRD(ks5, ka1, (KB_) * SHM_K + 8320); \
        LGKW1(5, ks0); pX0 = MFMA(ks0, S.qr[3], pX0); SBAR(); \
        KRD(ks0, ka2, (KB_) * SHM_K + 128); \
        LGKW1(5, ks1); pX1 = MFMA(ks1, S.qr[3], pX1); SBAR(); \
        KRD(ks1, ka2, (KB_) * SHM_K + 8320); \
        LGKW2(5, ks2, qs0); pX0 = MFMA(ks2, qs0, pX0); SBAR(); \
        KRD(ks2, ka3, (KB_) * SHM_K + 128); \
        LGKW2(5, ks3, qs0); pX1 = MFMA(ks3, qs0, pX1); SBAR(); \
        KRD(ks3, ka3, (KB_) * SHM_K + 8320); \
        KRD(qs0, qa, 2048); \
        LGKW2(6, ks4, qs1); pX0 = MFMA(ks4, qs1, pX0); SBAR(); \
        TRD(vl4, vb0, (VB_) * SHM_V + 0); TRD(vh4, vb0, (VB_) * SHM_V + 2048); \
        LGKW2(7, ks5, qs1); pX1 = MFMA(ks5, qs1, pX1); SBAR(); \
        TRD(vl5, vb0, (VB_) * SHM_V + 4096); TRD(vh5, vb0, (VB_) * SHM_V + 6144); \
        KRD(qs1, qa, 3072); \
        LGKW2(5, ks0, qs0); pX0 = MFMA(ks0, qs0, pX0); SBAR(); \
        TRD(vl0, vb0, (VB_) * SHM_V + 8192); TRD(vh0, vb0, (VB_) * SHM_V + 10240); \
        LGKW2(7, ks1, qs0); pX1 = MFMA(ks1, qs0, pX1); SBAR(); \
        TRD(vl1, vb0, (VB_) * SHM_V + 12288); TRD(vh1, vb0, (VB_) * SHM_V + 14336); \
        LGKW2(4, ks2, qs1); pX0 = MFMA(ks2, qs1, pX0); SBAR(); \
        TRD(vl2, vb0, (VB_) * SHM_V + 512); TRD(vh2, vb0, (VB_) * SHM_V + 2560); \
        LGKW2(6, ks3, qs1); pX1 = MFMA(ks3, qs1, pX1); SBAR(); \
        TRD(vl3, vb0, (VB_) * SHM_V + 4608); TRD(vh3, vb0, (VB_) * SHM_V + 6656); \
        LGKW2(11, vl4, vh4); o[0] = MFMA(pa0, VCAT(vl4, vh4), o[0]); SBAR(); \
        TRD(vl4, vb0, (VB_) * SHM_V + 8704); TRD(vh4, vb0, (VB_) * SHM_V + 10752); \
        LGKW2(11, vl5, vh5); o[0] = MFMA(pa1, VCAT(vl5, vh5), o[0]); SBAR(); \
        TRD(vl5, vb0, (VB_) * SHM_V + 12800); TRD(vh5, vb0, (VB_) * SHM_V + 14848); \
        LGKW2(10, vl0, vh0); o[0] = MFMA(pa2, VCAT(vl0, vh0), o[0]); SBAR(); \
        TRD(vl0, vb0, (VB_) * SHM_V + 1024); TRD(vh0, vb0, (VB_) * SHM_V + 3072); \
        LGKW2(10, vl1, vh1); o[0] = MFMA(pa3, VCAT(vl1, vh1), o[0]); SBAR(); \
        TRD(vl1, vb0, (VB_) * SHM_V + 5120); TRD(vh1, vb0, (VB_) * SHM_V + 7168); \
        LGKW2(10, vl2, vh2); o[1] = MFMA(pa0, VCAT(vl2, vh2), o[1]); SBAR(); \
        TRD(vl2, vb0, (VB_) * SHM_V + 9216); TRD(vh2, vb0, (VB_) * SHM_V + 11264); \
        LGKW2(10, vl3, vh3); o[1] = MFMA(pa1, VCAT(vl3, vh3), o[1]); SBAR(); \
        TRD(vl3, vb0, (VB_) * SHM_V + 13312); TRD(vh3, vb0, (VB_) * SHM_V + 15360); \
        LGKW2(10, vl4, vh4); o[1] = MFMA(pa2, VCAT(vl4, vh4), o[1]); SBAR(); \
        TRD(vl4, vb0, (VB_) * SHM_V + 1536); TRD(vh4, vb0, (VB_) * SHM_V + 3584); \
        LGKW2(10, vl5, vh5); o[1] = MFMA(pa3, VCAT(vl5, vh5), o[1]); SBAR(); \
        TRD(vl5, vb0, (VB_) * SHM_V + 5632); TRD(vh5, vb0, (VB_) * SHM_V + 7680); \
        LGKW2(10, vl0, vh0); o[2] = MFMA(pa0, VCAT(vl0, vh0), o[2]); SBAR(); \
        TRD(vl0, vb0, (VB_) * SHM_V + 9728); TRD(vh0, vb0, (VB_) * SHM_V + 11776); \
        LGKW2(10, vl1, vh1); o[2] = MFMA(pa1, VCAT(vl1, vh1), o[2]); SBAR(); \
        TRD(vl1, vb0, (VB_) * SHM_V + 13824); TRD(vh1, vb0, (VB_) * SHM_V + 15872); \
        LGKW2(10, vl2, vh2); o[2] = MFMA(pa2, VCAT(vl2, vh2), o[2]); SBAR(); \
        TRD(vl2, vb1, (VB_) * SHM_V + 0); TRD(vh2, vb1, (VB_) * SHM_V + 2048); \
        LGKW2(10, vl3, vh3); o[2] = MFMA(pa3, VCAT(vl3, vh3), o[2]); SBAR(); \
        TRD(vl3, vb1, (VB_) * SHM_V + 4096); TRD(vh3, vb1, (VB_) * SHM_V + 6144); \
        LGKW2(10, vl4, vh4); o[3] = MFMA(pa0, VCAT(vl4, vh4), o[3]); SBAR(); \
        TRD(vl4, vb1, (VB_) * SHM_V + 8192); TRD(vh4, vb1, (VB_) * SHM_V + 10240); \
        LGKW2(10, vl5, vh5); o[3] = MFMA(pa1, VCAT(vl5, vh5), o[3]); SBAR(); \
        TRD(vl5, vb1, (VB_) * SHM_V + 12288); TRD(vh5, vb1, (VB_) * SHM_V + 14336); \
        LGKW2(10, vl0, vh0); o[3] = MFMA(pa2, VCAT(vl0, vh0), o[3]); SBAR(); \
        TRD(vl0, vb1, (VB_) * SHM_V + 512); TRD(vh0, vb1, (VB_) * SHM_V + 2560); \
        LGKW2(10, vl1, vh1); o[3] = MFMA(pa3, VCAT(vl1, vh1), o[3]); SBAR(); \
        TRD(vl1, vb1, (VB_) * SHM_V + 4608); TRD(vh1, vb1, (VB_) * SHM_V + 6656); \
        LGKW2(10, vl2, vh2); o[4] = MFMA(pa0, VCAT(vl2, vh2), o[4]); SBAR(); \
        TRD(vl2, vb1, (VB_) * SHM_V + 8704); TRD(vh2, vb1, (VB_) * SHM_V + 10752); \
        LGKW2(10, vl3, vh3); o[4] = MFMA(pa1, VCAT(vl3, vh3), o[4]); SBAR(); \
        TRD(vl3, vb1, (VB_) * SHM_V + 12800); TRD(vh3, vb1, (VB_) * SHM_V + 14848); \
        LGKW2(10, vl4, vh4); o[4] = MFMA(pa2, VCAT(vl4, vh4), o[4]); SBAR(); \
        TRD(vl4, vb1, (VB_) * SHM_V + 1024); TRD(vh4, vb1, (VB_) * SHM_V + 3072); \
        LGKW2(10, vl5, vh5); o[4] = MFMA(pa3, VCAT(vl5, vh5), o[4]); SBAR(); \
        TRD(vl5, vb1, (VB_) * SHM_V + 5120); TRD(vh5, vb1, (VB_) * SHM_V + 7168); \
        LGKW2(10, vl0, vh0); o[5] = MFMA(pa0, VCAT(vl0, vh0), o[5]); SBAR(); \
        TRD(vl0, vb1, (VB_) * SHM_V + 9216); TRD(vh0, vb1, (VB_) * SHM_V + 11264); \
        LGKW2(10, vl1, vh1); o[5] = MFMA(pa1, VCAT(vl1, vh1), o[5]); SBAR(); \
        TRD(vl1, vb1, (VB_) * SHM_V + 13312); TRD(vh1, vb1, (VB_) * SHM_V + 15360); \
        LGKW2(10, vl2, vh2); o[5] = MFMA(pa2, VCAT(vl2, vh2), o[5]); SBAR(); \
        TRD(vl2, vb1, (VB_) * SHM_V + 1536); TRD(vh2, vb1, (VB_) * SHM_V + 3584); \
        LGKW2(10, vl3, vh3); o[5] = MFMA(pa3, VCAT(vl3, vh3), o[5]); SBAR(); \
        TRD(vl3, vb1, (VB_) * SHM_V + 5632); TRD(vh3, vb1, (VB_) * SHM_V + 7680); \
        LGKW2(10, vl4, vh4); o[6] = MFMA(pa0, VCAT(vl4, vh4), o[6]); SBAR(); \
        TRD(vl4, vb1, (VB_) * SHM_V + 9728); TRD(vh4, vb1, (VB_) * SHM_V + 11776); \
        LGKW2(10, vl5, vh5); o[6] = MFMA(pa1, VCAT(vl5, vh5), o[6]); SBAR(); \
        TRD(vl5, vb1, (VB_) * SHM_V + 13824); TRD(vh5, vb1, (VB_) * SHM_V + 15872); \
        LGKW2(10, vl0, vh0); o[6] = MFMA(pa2, VCAT(vl0, vh0), o[6]); SBAR(); \
        LGKW2(8, vl1, vh1); o[6] = MFMA(pa3, VCAT(vl1, vh1), o[6]); SBAR(); \
        LGKW2(6, vl2, vh2); o[7] = MFMA(pa0, VCAT(vl2, vh2), o[7]); SBAR(); \
        LGKW2(4, vl3, vh3); o[7] = MFMA(pa1, VCAT(vl3, vh3), o[7]); SBAR(); \
        LGKW2(2, vl4, vh4); o[7] = MFMA(pa2, VCAT(vl4, vh4), o[7]); SBAR(); \
        LGKW2(0, vl5, vh5); o[7] = MFMA(pa3, VCAT(vl5, vh5), o[7]); SBAR(); } while (0)
#define DM_QK(KB_) do { \
        KRD(ks0, ka0, (KB_) * SHM_K + 0); \
        KRD(ks1, ka0, (KB_) * SHM_K + 8192); \
        KRD(ks2, ka1, (KB_) * SHM_K + 0); \
        KRD(ks3, ka1, (KB_) * SHM_K + 8192); \
        KRD(ks4, ka2, (KB_) * SHM_K + 0); \
        KRD(ks5, ka2, (KB_) * SHM_K + 8192); \
        KRD(qs0, qa, 0); \
        KRD(qs1, qa, 1024); \
        LGKW1(7, ks0); pX0 = MFMA(ks0, S.qr[0], ZERO16); SBAR(); \
        KRD(ks0, ka3, (KB_) * SHM_K + 0); \
        LGKW1(7, ks1); pX1 = MFMA(ks1, S.qr[0], ZERO16); SBAR(); \
        KRD(ks1, ka3, (KB_) * SHM_K + 8192); \
        LGKW1(7, ks2); pX0 = MFMA(ks2, S.qr[1], pX0); SBAR(); \
        KRD(ks2, ka0, (KB_) * SHM_K + 128); \
        LGKW1(7, ks3); pX1 = MFMA(ks3, S.qr[1], pX1); SBAR(); \
        KRD(ks3, ka0, (KB_) * SHM_K + 8320); \
        LGKW1(7, ks4); pX0 = MFMA(ks4, S.qr[2], pX0); SBAR(); \
        KRD(ks4, ka1, (KB_) * SHM_K + 128); \
        LGKW1(7, ks5); pX1 = MFMA(ks5, S.qr[2], pX1); SBAR(); \
        KRD(ks5, ka1, (KB_) * SHM_K + 8320); \
        LGKW1(5, ks0); pX0 = MFMA(ks0, S.qr[3], pX0); SBAR(); \
        KRD(ks0, ka2, (KB_) * SHM_K + 128); \
        LGKW1(5, ks1); pX1 = MFMA(ks1, S.qr[3], pX1); SBAR(); \
        KRD(ks1, ka2, (KB_) * SHM_K + 8320); \
        LGKW2(5, ks2, qs0); pX0 = MFMA(ks2, qs0, pX0); SBAR(); \
        KRD(ks2, ka3, (KB_) * SHM_K + 128); \
        LGKW2(5, ks3, qs0); pX1 = MFMA(ks3, qs0, pX1); SBAR(); \
        KRD(ks3, ka3, (KB_) * SHM_K + 8320); \
        KRD(qs0, qa, 2048); \
        LGKW2(6, ks4, qs1); pX0 = MFMA(ks4, qs1, pX0); SBAR(); \
        LGKW2(5, ks5, qs1); pX1 = MFMA(ks5, qs1, pX1); SBAR(); \
        KRD(qs1, qa, 3072); \
        LGKW2(1, ks0, qs0); pX0 = MFMA(ks0, qs0, pX0); SBAR(); \
        LGKW2(1, ks1, qs0); pX1 = MFMA(ks1, qs0, pX1); SBAR(); \
        LGKW2(0, ks2, qs1); pX0 = MFMA(ks2, qs1, pX0); SBAR(); \
        LGKW2(0, ks3, qs1); pX1 = MFMA(ks3, qs1, pX1); SBAR(); } while (0)
#define DM_PV(VB_) do { \
        TRD(vl0, vb0, (VB_) * SHM_V + 0); TRD(vh0, vb0, (VB_) * SHM_V + 2048); \
        TRD(vl1, vb0, (VB_) * SHM_V + 4096); TRD(vh1, vb0, (VB_) * SHM_V + 6144); \
        TRD(vl2, vb0, (VB_) * SHM_V + 8192); TRD(vh2, vb0, (VB_) * SHM_V + 10240); \
        TRD(vl3, vb0, (VB_) * SHM_V + 12288); TRD(vh3, vb0, (VB_) * SHM_V + 14336); \
        TRD(vl4, vb0, (VB_) * SHM_V + 512); TRD(vh4, vb0, (VB_) * SHM_V + 2560); \
        TRD(vl5, vb0, (VB_) * SHM_V + 4608); TRD(vh5, vb0, (VB_) * SHM_V + 6656); \
        LGKW2(10, vl0, vh0); o[0] = MFMA(pa0, VCAT(vl0, vh0), o[0]); SBAR(); \
        TRD(vl0, vb0, (VB_) * SHM_V + 8704); TRD(vh0, vb0, (VB_) * SHM_V + 10752); \
        LGKW2(10, vl1, vh1); o[0] = MFMA(pa1, VCAT(vl1, vh1), o[0]); SBAR(); \
        TRD(vl1, vb0, (VB_) * SHM_V + 12800); TRD(vh1, vb0, (VB_) * SHM_V + 14848); \
        LGKW2(10, vl2, vh2); o[0] = MFMA(pa2, VCAT(vl2, vh2), o[0]); SBAR(); \
        TRD(vl2, vb0, (VB_) * SHM_V + 1024); TRD(vh2, vb0, (VB_) * SHM_V + 3072); \
        LGKW2(10, vl3, vh3); o[0] = MFMA(pa3, VCAT(vl3, vh3), o[0]); SBAR(); \
        TRD(vl3, vb0, (VB_) * SHM_V + 5120); TRD(vh3, vb0, (VB_) * SHM_V + 7168); \
        LGKW2(10, vl4, vh4); o[1] = MFMA(pa0, VCAT(vl4, vh4), o[1]); SBAR(); \
        TRD(vl4, vb0, (VB_) * SHM_V + 9216); TRD(vh4, vb0, (VB_) * SHM_V + 11264); \
        LGKW2(10, vl5, vh5); o[1] = MFMA(pa1, VCAT(vl5, vh5), o[1]); SBAR(); \
        TRD(vl5, vb0, (VB_) * SHM_V + 13312); TRD(vh5, vb0, (VB_) * SHM_V + 15360); \
        LGKW2(10, vl0, vh0); o[1] = MFMA(pa2, VCAT(vl0, vh0), o[1]); SBAR(); \
        TRD(vl0, vb0, (VB_) * SHM_V + 1536); TRD(vh0, vb0, (VB_) * SHM_V + 3584); \
        LGKW2(10, vl1, vh1); o[1] = MFMA(pa3, VCAT(vl1, vh1), o[1]); SBAR(); \
        TRD(vl1, vb0, (VB_) * SHM_V + 5632); TRD(vh1, vb0, (VB_) * SHM_V + 7680); \
        LGKW2(10, vl2, vh2); o[2] = MFMA(pa0, VCAT(vl2, vh2), o[2]); SBAR(); \
        TRD(vl2, vb0, (VB_) * SHM_V + 9728); TRD(vh2, vb0, (VB_) * SHM_V + 11776); \
        LGKW2(10, vl3, vh3); o[2] = MFMA(pa1, VCAT(vl3, vh3), o[2]); SBAR(); \
        TRD(vl3, vb0, (VB_) * SHM_V + 13824); TRD(vh3, vb0, (VB_) * SHM_V + 15872); \
        LGKW2(10, vl4, vh4); o[2] = MFMA(pa2, VCAT(vl4, vh4), o[2]); SBAR(); \
        TRD(vl4, vb1, (VB_) * SHM_V + 0); TRD(vh4, vb1, (VB_) * SHM_V + 2048); \
        LGKW2(10, vl5, vh5); o[2] = MFMA(pa3, VCAT(vl5, vh5), o[2]); SBAR(); \
        TRD(vl5, vb1, (VB_) * SHM_V + 4096); TRD(vh5, vb1, (VB_) * SHM_V + 6144); \
        LGKW2(10, vl0, vh0); o[3] = MFMA(pa0, VCAT(vl0, vh0), o[3]); SBAR(); \
        TRD(vl0, vb1, (VB_) * SHM_V + 8192); TRD(vh0, vb1, (VB_) * SHM_V + 10240); \
        LGKW2(10, vl1, vh1); o[3] = MFMA(pa1, VCAT(vl1, vh1), o[3]); SBAR(); \
        TRD(vl1, vb1, (VB_) * SHM_V + 12288); TRD(vh1, vb1, (VB_) * SHM_V + 14336); \
        LGKW2(10, vl2, vh2); o[3] = MFMA(pa2, VCAT(vl2, vh2), o[3]); SBAR(); \
        TRD(vl2, vb1, (VB_) * SHM_V + 512); TRD(vh2, vb1, (VB_) * SHM_V + 2560); \
        LGKW2(10, vl3, vh3); o[3] = MFMA(pa3, VCAT(vl3, vh3), o[3]); SBAR(); \
        TRD(vl3, vb1, (VB_) * SHM_V + 4608); TRD(vh3, vb1, (VB_) * SHM_V + 6656); \
        LGKW2(10, vl4, vh4); o[4] = MFMA(pa0, VCAT(vl4, vh4), o[4]); SBAR(); \
        TRD(vl4, vb1, (VB_) * SHM_V + 8704); TRD(vh4, vb1, (VB_) * SHM_V + 10752); \
        LGKW2(10, vl5, vh5); o[4] = MFMA(pa1, VCAT(vl5, vh5), o[4]); SBAR(); \
        TRD(vl5, vb1, (VB_) * SHM_V + 12800); TRD(vh5, vb1, (VB_) * SHM_V + 14848); \
        LGKW2(10, vl0, vh0); o[4] = MFMA(pa2, VCAT(vl0, vh0), o[4]); SBAR(); \
        TRD(vl0, vb1, (VB_) * SHM_V + 1024); TRD(vh0, vb1, (VB_) * SHM_V + 3072); \
        LGKW2(10, vl1, vh1); o[4] = MFMA(pa3, VCAT(vl1, vh1), o[4]); SBAR(); \
        TRD(vl1, vb1, (VB_) * SHM_V + 5120); TRD(vh1, vb1, (VB_) * SHM_V + 7168); \
        LGKW2(10, vl2, vh2); o[5] = MFMA(pa0, VCAT(vl2, vh2), o[5]); SBAR(); \
        TRD(vl2, vb1, (VB_) * SHM_V + 9216); TRD(vh2, vb1, (VB_) * SHM_V + 11264); \
        LGKW2(10, vl3, vh3); o[5] = MFMA(pa1, VCAT(vl3, vh3), o[5]); SBAR(); \
        TRD(vl3, vb1, (VB_) * SHM_V + 13312); TRD(vh3, vb1, (VB_) * SHM_V + 15360); \
        LGKW2(10, vl4, vh4); o[5] = MFMA(pa2, VCAT(vl4, vh4), o[5]); SBAR(); \
        TRD(vl4, vb1, (VB_) * SHM_V + 1536); TRD(vh4, vb1, (VB_) * SHM_V + 3584); \
        LGKW2(10, vl5, vh5); o[5] = MFMA(pa3, VCAT(vl5, vh5), o[5]); SBAR(); \
        TRD(vl5, vb1, (VB_) * SHM_V + 5632); TRD(vh5, vb1, (VB_) * SHM_V + 7680); \
        LGKW2(10, vl0, vh0); o[6] = MFMA(pa0, VCAT(vl0, vh0), o[6]); SBAR(); \
        TRD(vl0, vb1, (VB_) * SHM_V + 9728); TRD(vh0, vb1, (VB_) * SHM_V + 11776); \
        LGKW2(10, vl1, vh1); o[6] = MFMA(pa1, VCAT(vl1, vh1), o[6]); SBAR(); \
        TRD(vl1, vb1, (VB_) * SHM_V + 13824); TRD(vh1, vb1, (VB_) * SHM_V + 15872); \
        LGKW2(10, vl2, vh2); o[6] = MFMA(pa2, VCAT(vl2, vh2), o[6]); SBAR(); \
        LGKW2(8, vl3, vh3); o[6] = MFMA(pa3, VCAT(vl3, vh3), o[6]); SBAR(); \
        LGKW2(6, vl4, vh4); o[7] = MFMA(pa0, VCAT(vl4, vh4), o[7]); SBAR(); \
        LGKW2(4, vl5, vh5); o[7] = MFMA(pa1, VCAT(vl5, vh5), o[7]); SBAR(); \
        LGKW2(2, vl0, vh0); o[7] = MFMA(pa2, VCAT(vl0, vh0), o[7]); SBAR(); \
        LGKW2(0, vl1, vh1); o[7] = MFMA(pa3, VCAT(vl1, vh1), o[7]); SBAR(); } while (0)
__device__ __forceinline__ void dattn_block(const BlockRef& cur, const BlockRef& nxt, char* lds, PG8_LAS unsigned char* ldsL, DSeam& S, CvState& cv, const int wid_) {
    const int wid = wid_ & 7, lane = pg8::hw_lane(), tid = wid * 64 + lane, r32 = lane & 31, hi = lane >> 5;
    constexpr int ldo = 2048;
    const int NT = cur.P0 / KVBLK + 4;
    const int qlo = cur.P0 + wid * QBLK, row = qlo + r32, qlo_m = qlo | 63, qm = (row | 63) - 4 * hi;
    char* K_lds = lds + 2 * SHM_V;
    float* ws = (float*)(lds + OFF_SCR) + wid * 64; float* li_l = ws, * al_l = ws + 32;
    const float* tl = (const float*)(lds + OFF_TAB + S.tb * 1024) + (192 + 4 * hi - row);
    const char* qsl = lds + D_OFF_Q + wid * ((8 - DQR) * 1024) + lane * 16;
    D_LANE_OFFS();
    float m_reg = -1e30f, l_reg = 0; f32x16 o[8] = {};
    const int vb0 = (int)(uintptr_t)lds + v_rd_base(lane), vb1 = vb0 + D_OFF_V1;
    const bf16* Kh = cur.K; const bf16* Vh = cur.V;
    f32x16 pX0, pX1; bf16x8 pa0, pa1, pa2, pa3;
    bf16x8 ks0, ks1, ks2, ks3, ks4, ks5, qs0, qs1; s16x4 vl0, vl1, vl2, vl3, vl4, vl5, vh0, vh1, vh2, vh3, vh4, vh5;
    const int ka0 = (int)(uintptr_t)K_lds + KSWZ(r32, (0 * 16 + hi * 8) * 2), ka1 = (int)(uintptr_t)K_lds + KSWZ(r32, (1 * 16 + hi * 8) * 2), ka2 = (int)(uintptr_t)K_lds + KSWZ(r32, (2 * 16 + hi * 8) * 2), ka3 = (int)(uintptr_t)K_lds + KSWZ(r32, (3 * 16 + hi * 8) * 2);
    const int qa = (int)(uintptr_t)qsl;
#define RESC(a) do { if (__any((a) < 1.f)) { if (hi == 0) al_l[r32] = (a); asm volatile("s_waitcnt lgkmcnt(0)" ::: "memory");              \
                     for (int d_ = 0; d_ < 8; ++d_) for (int r = 0; r < 16; ++r) o[d_][r] *= al_l[crow(r, hi)]; } } while (0)
#define DSOFT(t) do { const int kb_ = (t) * KVBLK;                                                                           \
        if (kb_ >= qlo - 153 && kb_ <= qlo_m) diff_bias(pX0, pX1, tl, kb_);                                                  \
        if (kb_ + KVBLK - 1 > qlo_m) mask_tile(pX0, pX1, qm - kb_);                                                          \
        float mn_, al_; partialSM(pX0, pX1, m_reg, mn_, al_); RESC(al_); finishSM(pX0, pX1, al_, l_reg, pa0, pa1, pa2, pa3); } while (0)
#define DSTEP(t, KB) do {                                                                                                     \
        const bool cvi_ = cv.next < cv.end, cvl_ = (cv.hist & 1) != 0; const int cvh_ = cv.next;     \
        if (grp == 0) { if ((t) + 1 < NT) DMA_K(Kh, ((t) + 1) * KVBLK, (KB) ^ 1);                                             \
                        DMA_V(Vh, (t) * KVBLK, KB); }                                                                         \
        else if (cvi_) CV_DMA(cvh_, cvh_ & 1);                                                                                \
        SBAR(); DM_QKPV(KB, (KB) ^ 1);                                                                                        \
        SBAR(); if (grp == 1 && cvl_) { const int n_ = ((cv.hist >> 1) & 1) + (cvi_ ? 2 : 0);     \
                    if (n_ == 3) VMWN(3); else if (n_ == 2) VMWN(2); else if (n_ == 1) VMWN(1); else VMW(); }                 \
        asm volatile("s_waitcnt lgkmcnt(0)" ::: "memory"); __builtin_amdgcn_s_barrier(); SBAR();                              \
        DSOFT(t);                                                                                                             \
        if (grp == 1 && cvl_) CV_CONVERT(cvh_ - 1, (cvh_ - 1) & 1);                                                           \
        cv.hist = (cvi_ ? 1 : 0) | (cvl_ ? 2 : 0); if (cvi_) ++cv.next;                                                       \
        if (grp == 0) VMW();                                                                                                  \
        __syncthreads(); } while (0)
    if (grp == 0) { DMA_K(Kh, KVBLK, 1); DMA_V(Vh, 0, 0); }
    SBAR(); DM_QK(0);
    SBAR(); asm volatile("s_waitcnt lgkmcnt(0)" ::: "memory"); __builtin_amdgcn_s_barrier(); SBAR();
    DSOFT(0);
    if (grp == 0) VMW();
    __syncthreads();
    for (int t = 1; t < NT; t += 2) {
        DSTEP(t, 1);
        if (t + 1 < NT) DSTEP(t + 1, 0);
    }
    if (grp == 0) DMA_K(nxt.K, nxt.kb0, 0);
    { const char* qg_ = (const char*)(nxt.Q + (size_t)(wid * QBLK + r32) * D + hi * 8);
      PG8_LAS unsigned char* const qd_ = ldsL + D_OFF_Q + wid * ((8 - DQR) * 1024);
#pragma unroll
      for (int d0 = DQR; d0 < 8; ++d0) DMA16(qg_ + d0 * 32, qd_ + (d0 - DQR) * 1024); }
    f32x4 tn0 = {0.f, 0.f, 0.f, 0.f}; if (wid == 0) tn0 = *(const f32x4*)(nxt.tab + lane * 4);
    SBAR();
    DM_PV(1);
    SBAR();
    if (hi == 0) li_l[r32] = l_reg; asm volatile("s_waitcnt lgkmcnt(0)" ::: "memory");
    { unsigned* sw = (unsigned*)cur.scr + (size_t)wid * 4096 + lane * 4;
      float rl[16];
#pragma unroll
      for (int r = 0; r < 16; ++r) rl[r] = __builtin_amdgcn_rcpf(li_l[crow(r, hi)]);
      if (cur.c == 0) {
#pragma unroll
        for (int d0 = 0; d0 < 8; ++d0) {
#pragma unroll
            for (int h = 0; h < 2; ++h) { u32x4 w;
#pragma unroll
                for (int j = 0; j < 4; ++j) w[j] = cvtpk(o[d0][8 * h + 2 * j] * rl[8 * h + 2 * j], o[d0][8 * h + 2 * j + 1] * rl[8 * h + 2 * j + 1]);
                *(u32x4*)(sw + (d0 * 2 + h) * 256) = w; }
            asm volatile("" ::: "memory"); }
      } else {
        float ssq[16];
#pragma unroll
        for (int r = 0; r < 16; ++r) ssq[r] = 0.f;
        const float lam = cur.lam;
#define O0V(w_, j_) (((j_) & 1) ? __uint_as_float((w_)[(j_) >> 1] & 0xffff0000u) : __uint_as_float((w_)[(j_) >> 1] << 16))
#pragma unroll
        for (int d0 = 0; d0 < 8; d0 += 4) {
            u32x4 a[8];
#pragma unroll
            for (int i = 0; i < 8; ++i) a[i] = *(const u32x4*)(sw + (d0 * 2 + i) * 256);
#pragma unroll
            for (int i = 0; i < 8; ++i)
#pragma unroll
                for (int j = 0; j < 8; ++j) { const int r = 8 * (i & 1) + j; const float d = O0V(a[i], j) - lam * (o[d0 + (i >> 1)][r] * rl[r]); ssq[r] += d * d; }
            asm volatile("" ::: "memory"); }
#pragma unroll
        for (int r = 0; r < 16; ++r) ssq[r] = 0.8f * __builtin_amdgcn_rsqf(half_sum32(ssq[r]) * (1.0f / 256.0f) + 1e-5f);
        bf16* Ow = (bf16*)cur.O + (size_t)(wid * QBLK) * 4096 + r32;
        float gg[8];
#pragma unroll
        for (int d0 = 0; d0 < 8; ++d0) gg[d0] = cur.gs[d0 * 32 + r32];
#pragma unroll
        for (int h = 0; h < 2; ++h) {
            u32x4 a[8];
#pragma unroll
            for (int d0 = 0; d0 < 8; ++d0) a[d0] = *(const u32x4*)(sw + (d0 * 2 + h) * 256);
#pragma unroll
            for (int j = 0; j < 8; ++j) { const int r = 8 * h + j;
#pragma unroll
                for (int d0 = 0; d0 < 8; ++d0) { const float v = (O0V(a[d0], j) - lam * (o[d0][r] * rl[r])) * (ssq[r] * gg[d0]); const float vn = dpp_xor1(v);
                    if ((r32 & 1) == 0) *(unsigned*)(Ow + (size_t)crow(r, hi) * 4096 + d0 * 32) = cvtpk(v, vn); } }
            asm volatile("" ::: "memory"); }
#undef O0V
      } }
    if (wid == 0) { const int l2_ = pg8::hw_lane(); *(f32x4*)((float*)(lds + OFF_TAB + (S.tb ^ 1) * 1024) + l2_ * 4) = tn0; }
    S.tb ^= 1;
#pragma unroll
    for (int d0 = 0; d0 < DQR; ++d0) S.qr[d0] = ld8(nxt.Q + (size_t)(wid * QBLK + r32) * D + d0 * 16 + hi * 8);
    VMW(); __syncthreads();
#undef RESC
#undef DSOFT
#undef DSTEP
}
#undef DM_QKPV
#undef DM_QK
#undef DM_PV
#undef KRD
#undef TRD
#undef LGKW1
#undef LGKW2
#undef MFMA
#undef VCAT
#undef ZERO16
#undef DMA16
#undef D_LANE_OFFS
#undef DMA_K
#undef DMA_V
#undef ROW
#undef VMW
#undef VMWN
#undef SLOAD_H
#undef SWRITE_HK
#undef SWRITE_HV
#undef SWRITE_H
}

constexpr int NWAVES = 8;
constexpr int BATCH = 4, SEQ = 4096, DM = 4096, TOK = BATCH * SEQ;
constexpr int NQKV = 12288, INW = 12304, FOFF = 6144;
constexpr int NMEM = 256, MROWS = BATCH * NMEM, DFF = 16384;
constexpr int MHALF = TOK / 2;
constexpr float NORM_EPS = 1e-6f, SUBLN_EPS = 1e-5f;
constexpr int N_PHASES = 11;
constexpr int CV_ITEMS = 64;

constexpr size_t MiB = 1u << 20;
constexpr size_t WS_CTL = 0, CTL_ZERO_BYTES = 1 * MiB;
constexpr size_t WS_WUP = 1 * MiB;
constexpr size_t WS_WDN = WS_WUP + (size_t)DFF * DM * 2;
constexpr size_t WS_WIN = WS_WDN + (size_t)DM * DFF * 2;
constexpr size_t WS_WOUT = WS_WIN + (size_t)NQKV * DM * 2;
constexpr size_t WS_WKV = WS_WOUT + (size_t)DM * DM * 2;
constexpr size_t WS_W2 = WS_WKV + (size_t)2 * DM * DM * 2;
constexpr size_t WS_U = WS_WIN;
constexpr size_t WS_XB = WS_W2 + (size_t)DM * 2 * DM * 2;
constexpr size_t WS_QKV = WS_XB + (size_t)TOK * DM * 2;
constexpr size_t WS_HB = WS_QKV;
constexpr size_t WS_U2 = WS_HB + (size_t)TOK * DM * 2;
constexpr size_t WS_MB = WS_QKV + (size_t)TOK * NQKV * 2;
constexpr size_t WS_KVM = WS_MB + (size_t)MROWS * DM * 2;
constexpr size_t WS_C2 = WS_KVM + (size_t)MROWS * 2 * DM * 2;
constexpr size_t WS_RX = WS_C2 + (size_t)8192 * DM * 2;
constexpr size_t WS_LOGF = WS_RX + (size_t)TOK * 4;
constexpr size_t WS_NCS = WS_LOGF + (size_t)TOK * 16 * 4;
constexpr size_t WS_DTAB = WS_NCS + (size_t)64 * 4096 * 4;
constexpr size_t WS_PART1 = WS_DTAB + 8192;
constexpr size_t WS_PART2 = WS_PART1 + (size_t)TOK * 64 * 4;
constexpr size_t WS_PART3 = WS_PART2 + (size_t)TOK * 64 * 4;
constexpr size_t WS_XB0 = WS_PART3 + (size_t)TOK * 64 * 4;
constexpr size_t WS_END = WS_XB0 + (size_t)TOK * DM * 2;
static_assert(WS_U + (size_t)MHALF * DFF * 2 <= WS_XB, "U half overlays the dead weight copies");
static_assert(WS_U2 + (size_t)MHALF * DFF * 2 <= WS_MB, "h and the second U half overlay QKV");
constexpr int CW_BAR = 4096;
constexpr int CW_KN = 16384;

constexpr int RING_OFF = 0, RING_BYTES = 131072, TSCR_BYTES = 64 * 65 * 4;
constexpr int LDS_BYTES = 163840;
constexpr int LDSCTL_OFF = LDS_BYTES - 2048, MISC_OFF = LDSCTL_OFF + 320, RTAB_OFF = LDSCTL_OFF + 1024;
static_assert(att::LDS_BYTES <= LDSCTL_OFF && att::D_OFF_CV + 16384 <= LDSCTL_OFF, "attention scratch below the LDS control words");

#define GAS __attribute__((address_space(1)))
#define LAS __attribute__((address_space(3)))
typedef unsigned short bf16;
typedef unsigned v4u __attribute__((ext_vector_type(4)));
typedef unsigned v2u __attribute__((ext_vector_type(2)));
typedef float f32x4 __attribute__((ext_vector_type(4)));
#define LDS_WAIT() asm volatile("s_waitcnt lgkmcnt(0)" ::: "memory")
#define VM_WAIT() asm volatile("s_waitcnt vmcnt(0)" ::: "memory")
__device__ __forceinline__ unsigned f2bf(float f) { unsigned u = __builtin_bit_cast(unsigned, f); return (u + 0x7fffu + ((u >> 16) & 1u)) >> 16; }
__device__ __forceinline__ unsigned pk2(float lo, float hi) { return f2bf(lo) | (f2bf(hi) << 16); }

#define XB_TMO      128
#define XB_XCNT(j)  (256  + 64 * (j))
#define XB_XSUB(j)  (1280 + 64 * (j))
#define XB_XGEN(j)  (2304 + 64 * (j))
#define XB_TOP      3328
#define XB_TOPGEN   3392
#define XCD_BAR_WORDS 3456
#define XB_SPIN_CAP (1u << 18)
__device__ __forceinline__ unsigned xb_ld(unsigned* p)              { return __hip_atomic_load(p, __ATOMIC_RELAXED, __HIP_MEMORY_SCOPE_AGENT); }
__device__ __forceinline__ unsigned xb_add(unsigned* p, unsigned v) { return __hip_atomic_fetch_add(p, v, __ATOMIC_RELAXED, __HIP_MEMORY_SCOPE_AGENT); }
__device__ __forceinline__ unsigned xb_xcc_id() { return (unsigned)__builtin_amdgcn_s_getreg((3 << 11) | 20) & 0xFu; }
#define XB_SPIN(cond, bar) do { unsigned _sp = 0; while (cond) { __builtin_amdgcn_s_sleep(1); \
    if ((++_sp & 255u) == 0u) { if (xb_ld(&(bar)[XB_TMO])) break; if (_sp > XB_SPIN_CAP) { atomicAdd(&(bar)[XB_TMO], 1u); break; } } } } while (0)
struct XcdBarrier { unsigned* bar; unsigned x; volatile LAS unsigned* st; };
__device__ __forceinline__ XcdBarrier xcd_barrier_post(unsigned* bar, volatile LAS unsigned* st, const int tid) {
    XcdBarrier b; b.bar = bar; b.x = xb_xcc_id(); b.st = st;
    if (tid == 0) (void)xb_add(&bar[XB_XCNT(b.x)], 1u);
    return b;
}
__device__ __forceinline__ void xcd_barrier_complete(unsigned* bar, unsigned x, unsigned& nloc, unsigned& nx) {
    const unsigned G = gridDim.x * gridDim.y * gridDim.z;
    unsigned sum, cnt, mine, sp = 0u;
    for (;;) {
        sum = 0u; cnt = 0u; mine = 0u;
#pragma unroll
        for (unsigned j = 0; j < 16; ++j) { const unsigned c = xb_ld(&bar[XB_XCNT(j)]); sum += c; cnt += (c > 0u) ? 1u : 0u; mine = (j == x) ? c : mine; }
        if (sum == G) break;
        __builtin_amdgcn_s_sleep(1);
        if ((++sp & 255u) == 0u) { if (xb_ld(&bar[XB_TMO])) break; if (sp > XB_SPIN_CAP) { atomicAdd(&bar[XB_TMO], 1u); break; } }
    }
    nloc = mine > 0u ? mine : 1u; nx = cnt > 0u ? cnt : 1u;
}
__device__ __forceinline__ void xcd_barrier(const XcdBarrier& b, const int tid) {
    asm volatile("s_waitcnt vmcnt(0)" ::: "memory");
    __syncthreads();
    if (tid == 0) {
        unsigned* bar = b.bar;
        __builtin_amdgcn_s_waitcnt(0);
        unsigned nloc = b.st[0], nx = b.st[1];
        if (nloc == 0u) { xcd_barrier_complete(bar, b.x, nloc, nx); b.st[0] = nloc; b.st[1] = nx; }
        const unsigned old = xb_add(&bar[XB_XSUB(b.x)], 1u);
        const unsigned gen = old / nloc;
        if (old + 1u == (gen + 1u) * nloc) {
            __builtin_amdgcn_fence(__ATOMIC_RELEASE, "agent");
            asm volatile("s_waitcnt vmcnt(0)" ::: "memory");
            const unsigned og = xb_add(&bar[XB_TOP], 1u);
            const unsigned tg = og / nx;
            if (og + 1u == (tg + 1u) * nx) xb_add(&bar[XB_TOPGEN], 1u);
            else XB_SPIN(xb_ld(&bar[XB_TOPGEN]) == tg, bar);
            __builtin_amdgcn_fence(__ATOMIC_ACQUIRE, "agent");
            xb_add(&bar[XB_XGEN(b.x)], 1u);
            asm volatile("s_waitcnt vmcnt(0)" ::: "memory");
        } else {
            XB_SPIN(xb_ld(&bar[XB_XGEN(b.x)]) == gen, bar);
            __builtin_amdgcn_fence(__ATOMIC_ACQUIRE, "agent");
            asm volatile("s_waitcnt vmcnt(0)" ::: "memory");
        }
    }
    __syncthreads();
}

struct Frame {
    LAS unsigned char* lds;
    volatile LAS unsigned* MISC;
    unsigned* ctl;
    int wave;
    int vcu, G;
};
__device__ __forceinline__ float wave_sum(float v) {
#pragma unroll
    for (int o = 1; o < 64; o <<= 1) v += __shfl_xor(v, o);
    return v;
}
__device__ __forceinline__ void transpose_item(const float* W, int ldw, int k0, int n_src0, bf16* WT, int ldo, int n_dst0, LAS float* scr, int lane, const float* kscale = nullptr) {
    f32x4 v[8];
#pragma unroll
    for (int i = 0; i < 8; ++i) v[i] = *(const f32x4*)(W + (size_t)(k0 + 8 * i + (lane >> 3)) * ldw + n_src0 + 4 * (lane & 7));
    if (kscale) {
#pragma unroll
        for (int i = 0; i < 8; ++i) v[i] = v[i] * kscale[k0 + 8 * i + (lane >> 3)]; }
#pragma unroll
    for (int i = 0; i < 8; ++i) { LAS float* d = scr + (8 * i + (lane >> 3)) * 33 + 4 * (lane & 7); d[0] = v[i][0]; d[1] = v[i][1]; d[2] = v[i][2]; d[3] = v[i][3]; }
    LDS_WAIT(); asm volatile("" ::: "memory");
    const int c = lane & 7;
#pragma unroll
    for (int j = 0; j < 4; ++j) { const int n = (lane >> 3) + 8 * j; const LAS float* s = scr + (8 * c) * 33 + n;
        v4u o; o.x = pk2(s[0 * 33], s[1 * 33]); o.y = pk2(s[2 * 33], s[3 * 33]); o.z = pk2(s[4 * 33], s[5 * 33]); o.w = pk2(s[6 * 33], s[7 * 33]);
        *(GAS v4u*)(WT + (size_t)(n_dst0 + n) * ldo + k0 + 8 * c) = o; }
    LDS_WAIT(); asm volatile("" ::: "memory");
}
struct TItem { const float* src; bf16* dst; const float* ks; int ldw, ldo, kblk; };
__device__ __forceinline__ void titem_load(const TItem& t, f32x4 (&v)[16], float (&kv)[16], int lane) {
#pragma unroll
    for (int i = 0; i < 16; ++i) v[i] = __builtin_nontemporal_load((const f32x4*)(t.src + (size_t)(4 * i + (lane >> 4)) * t.ldw + 4 * (lane & 15)));
#pragma unroll
    for (int i = 0; i < 16; ++i) kv[i] = t.ks ? t.ks[4 * i + (lane >> 4)] : 1.0f;
}
__device__ __forceinline__ void titem_store(const TItem& t, const f32x4 (&v)[16], const float (&kv)[16], LAS float* scr, int lane) {
#pragma unroll
    for (int i = 0; i < 16; ++i) { LAS float* d = scr + (4 * i + (lane >> 4)) * 65 + 4 * (lane & 15); d[0] = v[i][0] * kv[i]; d[1] = v[i][1] * kv[i]; d[2] = v[i][2] * kv[i]; d[3] = v[i][3] * kv[i]; }
    LDS_WAIT(); asm volatile("" ::: "memory");
    const int c = lane & 7;
#pragma unroll
    for (int j = 0; j < 8; ++j) { const int n = (lane >> 3) + 8 * j; const LAS float* s = scr + (8 * c) * 65 + n;
        v4u o; o.x = pk2(s[0 * 65], s[1 * 65]); o.y = pk2(s[2 * 65], s[3 * 65]); o.z = pk2(s[4 * 65], s[5 * 65]); o.w = pk2(s[6 * 65], s[7 * 65]);
        if (t.kblk) *(GAS v4u*)(t.dst + ((size_t)(n >> 4) * t.kblk + (c >> 2)) * 512 + (n & 15) * 32 + 8 * (c & 3)) = o;
        else *(GAS v4u*)(t.dst + (size_t)n * t.ldo + 8 * c) = o; }
    LDS_WAIT(); asm volatile("" ::: "memory");
}
__device__ __forceinline__ TItem titem_mat(const float* W, int N, bf16* WT, int ldo, int coff, int item, const float* kscale) {
    const int nblk = N / 64, kb = item / nblk, nb = item % nblk; TItem t;
    t.src = W + (size_t)(64 * kb) * N + 64 * nb; t.dst = WT + coff + (size_t)(64 * nb) * ldo + 64 * kb; t.ks = kscale ? kscale + 64 * kb : nullptr; t.ldw = N; t.ldo = ldo; t.kblk = 0; return t;
}
__device__ __forceinline__ TItem titem_blk(const float* W, int K, int N, bf16* WT, int item, const float* kscale) {
    const int nblk = N / 64, kb = item / nblk, nb = item % nblk; TItem t;
    t.src = W + (size_t)(64 * kb) * N + 64 * nb; t.dst = WT + ((size_t)(4 * nb) * (K / 32) + 2 * kb) * 512; t.ks = kscale ? kscale + 64 * kb : nullptr; t.ldw = N; t.ldo = 0; t.kblk = K / 32; return t;
}
#define TITEM_LOOP(first, count, stride, DECODE) do { int it_ = (first); if (it_ < (count)) { TItem cur_; { const int r = it_; DECODE(cur_, r); } f32x4 v_[16]; float kv_[16]; titem_load(cur_, v_, kv_, LANE);   \
        for (;;) { const int nx_ = it_ + (stride); const bool hn_ = nx_ < (count); TItem nxt_ = cur_; f32x4 vn_[16]; float kvn_[16];                                                  \
            if (hn_) { { const int r = nx_; DECODE(nxt_, r); } titem_load(nxt_, vn_, kvn_, LANE); }                                                                             \
            titem_store(cur_, v_, kv_, scr, LANE); if (!hn_) break; cur_ = nxt_; it_ = nx_; _Pragma("unroll") for (int q_ = 0; q_ < 16; ++q_) { v_[q_] = vn_[q_]; kv_[q_] = kvn_[q_]; } } } } while (0)
__device__ __forceinline__ void transpose_mat_item(const float* W, int K, int N, bf16* WT, int ldo, int coff, LAS float* scr, int item, int lane, const float* kscale = nullptr) {
    const int nblk = N / 32, kb = item / nblk, nb = item % nblk;
    transpose_item(W, N, 64 * kb, 32 * nb, WT + coff, ldo, 32 * nb, scr, lane, kscale);
}

struct Args { const float* in[22]; float* out; unsigned char* ws; int ph_lo, ph_hi, li, pad; };
template <int OFF> __device__ __forceinline__ void* karg_ptr() {
    __attribute__((address_space(1))) void* p; asm volatile("s_load_dwordx2 %0, %1, %2\n\ts_waitcnt lgkmcnt(0)" : "=s"(p) : "s"(__builtin_amdgcn_kernarg_segment_ptr()), "n"(OFF)); return (void*)p;
}

__global__ void __launch_bounds__(NWAVES * 64, 2) fwd_kernel(Args args) {
    extern __shared__ __attribute__((aligned(16))) unsigned char lds[];
    Frame F;
    F.lds = (LAS unsigned char*)lds;
    F.MISC = (volatile LAS unsigned*)(F.lds + MISC_OFF);
    F.wave = __builtin_amdgcn_readfirstlane((int)threadIdx.x >> 6);
#define LANE lane_
#define TID tid_
    const int lane0_ = pg8::hw_lane(), tid0_ = F.wave * 64 + lane0_;
    F.G = gridDim.x; { const int bx = blockIdx.x; F.vcu = (F.G % 8 == 0) ? (bx % 8) * (F.G / 8) + bx / 8 : bx; }
    F.ctl = (unsigned*)((unsigned char*)karg_ptr<8 * 23>() + WS_CTL);
    for (int u = tid0_; u < (LDS_BYTES - LDSCTL_OFF) / 4; u += NWAVES * 64) ((LAS unsigned*)(F.lds + LDSCTL_OFF))[u] = 0u;
    __syncthreads();
    XcdBarrier bar; bar.bar = F.ctl + CW_BAR; bar.x = 0; bar.st = nullptr;
    if (!MK_PER_PHASE) bar = xcd_barrier_post(F.ctl + CW_BAR, F.MISC + 8, tid0_);
#define GRID_BAR() do { if (!MK_PER_PHASE) xcd_barrier(bar, F.wave * 64 + pg8::hw_lane()); } while (0)
    const int lo = args.ph_lo, hi = args.ph_hi;
#define IN(k) (lo <= (k) && (k) < hi)
#define BOTH(k) (IN(k) && IN((k) + 1))
    const int gw = F.vcu * NWAVES + F.wave, NGW = F.G * NWAVES;

#define INP(i) ((const float*)karg_ptr<8 * (i)>())
#define WSP(T, off) ((T*)(wsb + (off)))
#define WSBASE() unsigned char* const wsb = (unsigned char*)karg_ptr<8 * 23>(); const int lane_ = pg8::hw_lane(); const int tid_ = F.wave * 64 + lane_; (void)tid_
#define WupT  WSP(bf16, WS_WUP)
#define WdnT  WSP(bf16, WS_WDN)
#define WinT  WSP(bf16, WS_WIN)
#define WoutT WSP(bf16, WS_WOUT)
#define WkvT  WSP(bf16, WS_WKV)
#define W2    WSP(bf16, WS_W2)
#define Ub    WSP(bf16, WS_U)
#define Ub2   WSP(bf16, WS_U2)
#define XB    WSP(bf16, WS_XB)
#define XB0   WSP(bf16, WS_XB0)
#define QKV   WSP(bf16, WS_QKV)
#define HB    WSP(bf16, WS_HB)
#define MB    WSP(bf16, WS_MB)
#define KVM   WSP(bf16, WS_KVM)
#define C2    WSP(bf16, WS_C2)
#define RX    WSP(float, WS_RX)
#define LOGF  WSP(float, WS_LOGF)
#define NCS   WSP(float, WS_NCS)
#define DTAB  WSP(float, WS_DTAB)
#define PART1 WSP(float, WS_PART1)
#define PART2 WSP(float, WS_PART2)
#define PART3 WSP(float, WS_PART3)
#define OD    ((bf16*)outp)

    if (IN(0)) {
        WSBASE(); const float* const xin = INP(0); const float* const mem = INP(1); const float* const g_mix = INP(2); const float* const w_in = INP(3); const float* const b_forget = INP(4);
        const float* const g_mem = INP(13); const float* const wk_mem = INP(15); const float* const wv_mem = INP(16);
        LAS float* scr = (LAS float*)(F.lds + RING_OFF + F.wave * TSCR_BYTES);
        constexpr int I_IN = (DM / 64) * (NQKV / 64), I_SQ = (DM / 64) * (DM / 64);
        constexpr int NITEMS = I_IN + 2 * I_SQ;
#define P0_DECODE(T, r0) do { int r_ = (r0);                                                                                           \
            if (r_ < I_IN) { const int nblk = NQKV / 64, kb = r_ / nblk, nb = r_ % nblk, nd = 64 * nb, nsrc = nd < FOFF ? nd : nd + 16;        \
                (T).src = w_in + (size_t)(64 * kb) * INW + nsrc; (T).dst = WinT + ((size_t)(nd / 16) * (DM / 32) + 2 * kb) * 512; (T).ks = g_mix + 64 * kb; (T).ldw = INW; (T).ldo = 0; (T).kblk = DM / 32; } \
            else if (r_ < I_IN + I_SQ) (T) = titem_mat(wk_mem, DM, WkvT, DM, 0, r_ - I_IN, nullptr);                                          \
            else (T) = titem_mat(wv_mem, DM, WkvT + (size_t)DM * DM, DM, 0, r_ - I_IN - I_SQ, nullptr); } while (0)
        TITEM_LOOP(gw, NITEMS, NGW, P0_DECODE);
#undef P0_DECODE
        for (int m = gw; m < MROWS; m += NGW) { const f32x4* xr = (const f32x4*)(mem + (size_t)m * DM) + LANE; f32x4 v[16]; float s = 0.f;
#pragma unroll
            for (int j = 0; j < 16; ++j) { v[j] = xr[64 * j]; s += (v[j][0] * v[j][0] + v[j][1] * v[j][1]) + (v[j][2] * v[j][2] + v[j][3] * v[j][3]); }
            const float rs = 1.0f / sqrtf(wave_sum(s) * (1.0f / DM) + NORM_EPS);
            unsigned long long* o8 = (unsigned long long*)(MB + (size_t)m * DM) + LANE;
#pragma unroll
            for (int j = 0; j < 16; ++j) { const f32x4 g = *((const f32x4*)g_mem + LANE + 64 * j);
                o8[64 * j] = (unsigned long long)pk2(v[j][0] * rs * g[0], v[j][1] * rs * g[1]) | ((unsigned long long)pk2(v[j][2] * rs * g[2], v[j][3] * rs * g[3]) << 32); } }
        __syncthreads();
        {   constexpr int WFP = DM + 8; constexpr int XCH_OFF = ((16 * WFP * 2 + 255) / 256) * 256;
            static_assert(XCH_OFF + 4 * 288 * 4 <= LDSCTL_OFF, "forget-gate table + exchange fit below the LDS control words");
            LAS bf16* wfT = (LAS bf16*)(F.lds + RING_OFF);
#pragma unroll
            for (int k = TID; k < DM; k += NWAVES * 64) { const float g = g_mix[k]; const f32x4* wp = (const f32x4*)(w_in + (size_t)k * INW + FOFF);
#pragma unroll
                for (int q = 0; q < 4; ++q) { const f32x4 w = wp[q];
#pragma unroll
                    for (int c = 0; c < 4; ++c) wfT[(4 * q + c) * WFP + k] = (bf16)f2bf(w[c] * g); } }
            __syncthreads();
            const int kh = F.wave & 1, lrow = LANE & 15, q = LANE >> 4;
            LAS float* xch = (LAS float*)(F.lds + RING_OFF + XCH_OFF) + (F.wave >> 1) * 288;
            for (int rg = F.vcu * 4 + (F.wave >> 1); rg < TOK / 16; rg += F.G * 4) { const int r0 = rg * 16;
                const float* xr = xin + (size_t)(r0 + lrow) * DM + kh * (DM / 2) + 8 * q;
                bf16* xo = XB0 + ((size_t)rg * (DM / 32) + kh * (DM / 64)) * 512 + lrow * 32 + 8 * q;
                const LAS bf16* wl = wfT + lrow * WFP + kh * (DM / 2) + 8 * q;
                f32x4 acc = {0.f, 0.f, 0.f, 0.f}; float ss = 0.f;
#pragma unroll 8
                for (int ks = 0; ks < DM / 64; ++ks) {
                    const f32x4 a = __builtin_nontemporal_load((const f32x4*)(xr + 32 * ks)), b = __builtin_nontemporal_load((const f32x4*)(xr + 32 * ks + 4));
                    ss += ((a[0] * a[0] + a[1] * a[1]) + (a[2] * a[2] + a[3] * a[3])) + ((b[0] * b[0] + b[1] * b[1]) + (b[2] * b[2] + b[3] * b[3]));
                    v4u w; w.x = pk2(a[0], a[1]); w.y = pk2(a[2], a[3]); w.z = pk2(b[0], b[1]); w.w = pk2(b[2], b[3]);
                    *(GAS v4u*)(xo + 512 * ks) = w;
                    const pg8::bf16x8 wf = *(const LAS pg8::bf16x8*)(wl + 32 * ks);
                    acc = __builtin_amdgcn_mfma_f32_16x16x32_bf16(*reinterpret_cast<const pg8::bf16x8*>(&w), wf, acc, 0, 0, 0); }
                ss += __shfl_xor(ss, 16); ss += __shfl_xor(ss, 32);
                if (kh == 1) {
#pragma unroll
                    for (int i = 0; i < 4; ++i) xch[LANE * 4 + i] = acc[i];
                    if (q == 0) xch[256 + lrow] = ss; }
                __syncthreads();
                if (kh == 0) {
#pragma unroll
                    for (int i = 0; i < 4; ++i) acc[i] += xch[LANE * 4 + i];
                    ss += xch[256 + lrow];
                    const float rs = 1.0f / sqrtf(ss * (1.0f / DM) + NORM_EPS);
                    if (q == 0) { RX[r0 + lrow] = rs; xch[272 + lrow] = rs; }
                    LDS_WAIT(); asm volatile("" ::: "memory");
                    const float bf_ = b_forget[lrow];
#pragma unroll
                    for (int i = 0; i < 4; ++i) { const float z = acc[i] * xch[272 + 4 * q + i] + bf_; LOGF[(size_t)(r0 + 4 * q + i) * 16 + lrow] = fminf(z, 0.f) - log1pf(expf(-fabsf(z))); } }
                __syncthreads(); }
        }
        if (BOTH(0)) GRID_BAR();
    }

    if (IN(1)) {
        WSBASE();
        pg8::MapPlainAB g{(const char*)XB0, (const char*)WinT, DM, DM, DM}; pg8::StaticOrder S; S.init(TOK, NQKV, F.G, (int)blockIdx.x);
        pg8::Unit u0; int pm0 = -1; if (S.next(0, u0)) pm0 = u0.pm;
        LAS float* rtab = (LAS float*)(F.lds + RTAB_OFF);
        if (pm0 >= 0 && TID < 256) rtab[TID] = RX[pm0 * 256 + TID];
        __syncthreads();
        pg8::EpiQKV E{QKV, RX, rtab, pm0, F.ctl + CW_KN};
        pg8::gemm_phase<pg8::MapPlainAB, pg8::EpiQKV, pg8::StaticOrder, true, true>(F.lds + RING_OFF, g, S, E, F.wave);
    }

    if (IN(2)) {
        WSBASE(); const float* const rel_bias = INP(10);
        {   pg8::MapPlain g{(const char*)MB, (const char*)WkvT, DM, DM, DM}; pg8::StaticOrder S; S.init(MROWS, 2 * DM, F.G, (int)blockIdx.x);
            pg8::EpiBf16 E{KVM, 2 * DM, 1.0f, 0};
            pg8::gemm_phase<pg8::MapPlain, pg8::EpiBf16, pg8::StaticOrder, true, true>(F.lds + RING_OFF, g, S, E, F.wave); }
        {
            const float* const w_out = INP(11); const float* const wq_mem = INP(14); const float* const wo_mem = INP(17); const float* const w_up = INP(19); const float* const w_down = INP(20);
            const float* const g_cross = INP(12); const float* const g_mlp = INP(18);
            const bool big = F.G > 128, late = big && (int)blockIdx.x < 128;
            const int nconv = big ? (late ? 128 : F.G - 128) : F.G, myc = big ? (late ? (int)blockIdx.x : (int)blockIdx.x - 128) : (int)blockIdx.x;
            {
                LAS float* scr = (LAS float*)(F.lds + RING_OFF + F.wave * TSCR_BYTES);
                constexpr int I_SQ = (DM / 64) * (DM / 64), I_UP = (DM / 64) * (DFF / 64), I_DN = (DFF / 64) * (DM / 64), I_WQ = DM * DM / 512;
                const int nd3 = (CV_ITEMS * F.G <= I_DN) ? CV_ITEMS * F.G : I_DN;
                const int NITEMS = 2 * I_SQ + I_UP + I_DN - nd3;
                const int it_lo = !big ? 0 : (late ? (NITEMS / 5) * 4 : 0), it_hi = !big ? NITEMS : (late ? NITEMS : (NITEMS / 5) * 4);
                const int wq_lo = !big ? 0 : (late ? (I_WQ / 5) * 4 : 0), wq_hi = !big ? I_WQ : (late ? I_WQ : (I_WQ / 5) * 4);
#define P2_DECODE(T, r0) do { int r_ = (r0);                                                                                           \
            if (r_ < I_SQ) (T) = titem_blk(w_out, DM, DM, WoutT, r_, nullptr);                                                             \
            else if (r_ < 2 * I_SQ) (T) = titem_mat(wo_mem, DM, W2, 2 * DM, DM, r_ - I_SQ, nullptr);                                          \
            else if (r_ < 2 * I_SQ + I_UP) (T) = titem_blk(w_up, DM, DFF, WupT, r_ - 2 * I_SQ, g_mlp);                                     \
            else (T) = titem_blk(w_down, DFF, DM, WdnT, r_ - 2 * I_SQ - I_UP + nd3, nullptr); } while (0)
                TITEM_LOOP(it_lo + myc * NWAVES + F.wave, it_hi, nconv * NWAVES, P2_DECODE);
#undef P2_DECODE
                {
                    const int st_ = nconv * NWAVES;
                    for (int r0 = wq_lo + myc * NWAVES + F.wave; r0 < wq_hi; r0 += 4 * st_) {
                        f32x4 a[4], b[4]; float gc[4];
#pragma unroll
                        for (int u = 0; u < 4; ++u) { const int r = r0 + u * st_; if (r < wq_hi) { const int e = r * 512 + LANE * 8;
                            a[u] = __builtin_nontemporal_load((const f32x4*)(wq_mem + e)); b[u] = __builtin_nontemporal_load((const f32x4*)(wq_mem + e + 4)); gc[u] = g_cross[e >> 12]; } }
#pragma unroll
                        for (int u = 0; u < 4; ++u) { const int r = r0 + u * st_; if (r < wq_hi) { const int e = r * 512 + LANE * 8, d = e >> 12, c = e & 4095;
                            const f32x4 x0 = a[u] * gc[u], x1 = b[u] * gc[u];
                            v4u o; o.x = pk2(x0[0], x0[1]); o.y = pk2(x0[2], x0[3]); o.z = pk2(x1[0], x1[1]); o.w = pk2(x1[2], x1[3]);
                            *(GAS v4u*)(W2 + (size_t)d * 8192 + c) = o; } } } }
                __syncthreads();
            }
        }
        for (int job = F.G - 1 - (int)blockIdx.x; job < 65; job += F.G) {
            if (job < 64) {
                const int b = job >> 4, h = job & 15; LAS float* wt = (LAS float*)(F.lds + RING_OFF);
                float v[8]; const int s0 = TID * 8;
#pragma unroll
                for (int i = 0; i < 8; ++i) v[i] = LOGF[(size_t)(b * SEQ + s0 + i) * 16 + h];
#pragma unroll
                for (int i = 1; i < 8; ++i) v[i] += v[i - 1];
                float tot = v[7], inc = tot;
#pragma unroll
                for (int o = 1; o < 64; o <<= 1) { const float t = __shfl_up(inc, o); if (LANE >= o) inc += t; }
                __syncthreads();
                if (LANE == 63) wt[F.wave] = inc;
                __syncthreads();
                float base = inc - tot;
                for (int w = 0; w < F.wave; ++w) base += wt[w];
#pragma unroll
                for (int i = 0; i < 8; ++i) NCS[(size_t)job * SEQ + s0 + i] = -(base + v[i]) * (1.0f / att::SCALE);
                __syncthreads();
            } else {
                for (int idx = TID; idx < 8 * 256; idx += NWAVES * 64) { const int hd = idx >> 8, rel = (idx & 255) - 192; const int n = rel < 0 ? -rel : rel;
                    int bk = rel > 0 ? 16 : 0;
                    if (n < 8) bk += n; else { int lg = 31 - __clz((n * n) >> 6); lg = lg > 7 ? 7 : lg; bk += 8 + lg; }
                    DTAB[idx] = (rel_bias[bk * 8 + hd] - rel_bias[15 * 8 + hd]) * (1.0f / att::SCALE); }
            }
        }
        if (BOTH(2)) GRID_BAR();
    }

    if (IN(3)) {
        WSBASE(); float* const outp = (float*)karg_ptr<8 * 22>();
        auto fox_ref = [&](int L, int pass) { const int hu = L >> 3, xx = (L < 256) ? (L & 7) : 7 - (L & 7), b = hu >> 4, h = hu & 15, qb = pass ? 15 - xx : xx; att::BlockRef r;
            const float* knp = (const float*)(F.ctl + CW_KN) + hu * 4; r.kmax2 = 1.05f * ((knp[0] + knp[1]) + (knp[2] + knp[3]));
            r.Q = QKV + ((size_t)(b * 96 + h) * SEQ + (size_t)qb * 256) * 128; r.K = QKV + (size_t)(b * 96 + 16 + h) * SEQ * 128; r.V = QKV + (size_t)(b * 96 + 32 + h) * SEQ * 128;
            r.O = XB + ((size_t)(b * SEQ + qb * 256)) * DM + h * 128; r.tab = NCS + (size_t)hu * SEQ; r.P0 = qb * 256; r.kb0 = qb * 256 + 192; r.tabn = qb * 256 + 256; return r; };
        const float* const lq1 = INP(5); const float* const lk1 = INP(6); const float* const lq2 = INP(7); const float* const lk2 = INP(8); const float* const g_subln = INP(9);
        float lam = 0.f;
        auto dif_ref = [&](int L, int k) { const int hu = (L - 512) >> 3, xx = L & 7, b = hu >> 3, hd = hu & 7, c = k & 1, qb = (k >> 1) ? 15 - xx : xx; att::BlockRef r;
            r.Q = QKV + ((size_t)(b * 96 + 48 + hd * 2 + c) * SEQ + (size_t)qb * 256) * 128; r.K = QKV + (size_t)(b * 96 + 64 + hd * 2 + c) * SEQ * 128; r.V = QKV + (size_t)(b * 96 + 80 + hd * 2) * SEQ * 128;
            r.O = XB + ((size_t)(b * SEQ + qb * 256)) * DM + 2048 + hd * 256; r.tab = DTAB + hd * 256; r.P0 = qb * 256; r.kb0 = 0; r.kmax2 = 0.f; r.tabn = 256;
            r.c = c; r.lam = lam; r.gs = g_subln; r.scr = outp + (size_t)F.vcu * 65536; return r; };
        int nA = 0, nT = 0; for (int L = F.vcu; L < 768; L += F.G) { ++nT; if (L < 512) ++nA; }
        const int nD = nT - nA;
        auto ref = [&](int k) { const int L = F.vcu + (k >> 1) * F.G; return fox_ref(L, k & 1); };
        auto dref = [&](int k) { const int L = F.vcu + (nA + (k >> 2)) * F.G; return dif_ref(L, k & 3); };
        if (nA > 0) {
            att::Seam S; att::BlockRef cur = ref(0);
            att::attn_prime(cur, (char*)lds + RING_OFF, S, F.wave);
            for (int k = 0; k < 2 * nA; ++k) { const att::BlockRef nxt = ref(k + 1 < 2 * nA ? k + 1 : k); att::attn_block<0>(cur, nxt, (char*)lds + RING_OFF, S, F.wave); cur = nxt; }
        }
        att::CvState cv{INP(20), WdnT, 2 * CV_ITEMS * F.vcu, 2 * CV_ITEMS * (F.vcu + 1), 0};
        if (nD > 0) {
            lam = expf(wave_sum(lq1[LANE] * lk1[LANE] + lq1[LANE + 64] * lk1[LANE + 64])) - expf(wave_sum(lq2[LANE] * lk2[LANE] + lq2[LANE + 64] * lk2[LANE + 64])) + 0.2f;
            att::DSeam S; att::BlockRef cur = dref(0);
            att::dattn_prime(cur, (char*)lds + RING_OFF, F.lds + RING_OFF, S, F.wave);
            for (int k = 0; k < 4 * nD; ++k) { const att::BlockRef nxt = dref(k + 1 < 4 * nD ? k + 1 : k); att::dattn_block(cur, nxt, (char*)lds + RING_OFF, F.lds + RING_OFF, S, cv, F.wave); cur = nxt; }
            att::dattn_finish(F.wave);
        }
        __syncthreads();
        att::cv_finish(cv, (char*)lds + RING_OFF, F.lds + RING_OFF, F.wave);
        if (BOTH(3)) GRID_BAR();
    }


    if (IN(5)) {
        WSBASE();
        {   pg8::MapPlainB g{(const char*)XB, (const char*)WoutT, DM, DM, DM}; pg8::StaticOrder S; S.init(TOK, DM, F.G, (int)blockIdx.x);
            pg8::EpiRes<true, true, true, true> E{XB0, HB, DM, PART1, 0};
            pg8::gemm_phase<pg8::MapPlainB, pg8::EpiRes<true, true, true, true>, pg8::StaticOrder, true, true>(F.lds + RING_OFF, g, S, E, F.wave); }
        {   pg8::MapAbsorb g{(const char*)KVM, (const char*)W2, 2 * DM, 2 * DM, 1024}; pg8::StaticOrder S; S.init(8192, DM, F.G, (int)blockIdx.x);
            pg8::EpiBf16 E{C2, DM, 0.03125f, 16};
            pg8::gemm_phase<pg8::MapAbsorb, pg8::EpiBf16, pg8::StaticOrder, true, true>(F.lds + RING_OFF, g, S, E, F.wave); }
        if (BOTH(5)) GRID_BAR();
    }

    if (IN(6)) {
        WSBASE();
        pg8::MapBatchBA g{(const char*)HB, (const char*)C2, DM, DM, DM, (size_t)1024 * DM * 2}; pg8::StaticOrder S; S.init(TOK, 1024, F.G, (int)blockIdx.x);
        pg8::EpiSoftmax E{XB, 1024, PART1, NORM_EPS};
        pg8::gemm_phase<pg8::MapBatchBA, pg8::EpiSoftmax, pg8::StaticOrder, false, true>(F.lds + RING_OFF, g, S, E, F.wave);
        if (BOTH(6)) GRID_BAR();
    }

    if (IN(7)) {
        WSBASE();
        pg8::MapBatchB g{(const char*)XB, (const char*)(C2 + (size_t)4096 * DM), 1024, DM, 1024, (size_t)1024 * 2}; pg8::StaticOrder S; S.init(TOK, DM, F.G, (int)blockIdx.x);
        pg8::EpiRes<true, true, true, true> E{HB, HB, DM, PART2, 0};
        pg8::gemm_phase<pg8::MapBatchB, pg8::EpiRes<true, true, true, true>, pg8::StaticOrder, true, true>(F.lds + RING_OFF, g, S, E, F.wave);
        if (BOTH(7)) GRID_BAR();
    }

    if (IN(8)) {
        WSBASE();
        pg8::MapPlainAB g{(const char*)HB, (const char*)WupT, DM, DM, DM}; pg8::StaticOrder S; S.init(TOK, DFF, F.G, (int)blockIdx.x);
        pg8::Unit u0; int pm0 = -1; if (S.next(0, u0)) pm0 = u0.pm;
        LAS float* rtab = (LAS float*)(F.lds + RTAB_OFF);
        if (pm0 >= 0) pg8::row_rstd_table(rtab, PART2, pm0 * 256, NORM_EPS, TID);
        pg8::EpiRelu2 E{Ub, Ub2, DFF, PART2, 0, NORM_EPS, rtab, pm0};
        pg8::gemm_phase<pg8::MapPlainAB, pg8::EpiRelu2, pg8::StaticOrder, true, true>(F.lds + RING_OFF, g, S, E, F.wave);
        if (BOTH(8)) GRID_BAR();
    }
    if (IN(9)) {
        WSBASE();
        pg8::MapBlkA g{(const char*)Ub, (const char*)Ub2, (const char*)WdnT, DFF, DFF}; pg8::StaticOrder S; S.init(TOK, DM, F.G, (int)blockIdx.x);
        pg8::EpiRes<true, true, true, false> E{HB, XB0, DM, PART3, 0};
        pg8::gemm_phase<pg8::MapBlkA, pg8::EpiRes<true, true, true, false>, pg8::StaticOrder, true, true>(F.lds + RING_OFF, g, S, E, F.wave);
        if (BOTH(9)) GRID_BAR();
    }

    if (IN(10)) {
        WSBASE(); float* const outp = (float*)karg_ptr<8 * 22>(); const float* const g_final = INP(21);
        unsigned bad = 0u;
        if (!MK_PER_PHASE) bad = __hip_atomic_load(F.ctl + CW_BAR + XB_TMO, __ATOMIC_RELAXED, __HIP_MEMORY_SCOPE_AGENT);
        const float poison = bad ? __builtin_nanf("") : 1.0f;
        for (int m = gw; m < TOK; m += NGW) {
            const float ssq = wave_sum(PART3[(size_t)m * 64 + LANE]);
            const float rs = poison / sqrtf(ssq * (1.0f / DM) + NORM_EPS);
            const pg8::u32x4* hr = (const pg8::u32x4*)(XB0 + (size_t)m * DM) + LANE; f32x4* orow = (f32x4*)(outp + (size_t)m * DM) + 2 * LANE;
            pg8::u32x4 w[8];
#pragma unroll
            for (int j = 0; j < 8; ++j) w[j] = __builtin_nontemporal_load(hr + 64 * j);
#pragma unroll
            for (int j = 0; j < 8; ++j) { const f32x4 g0 = *((const f32x4*)g_final + 2 * LANE + 128 * j), g1 = *((const f32x4*)g_final + 2 * LANE + 128 * j + 1);
                const f32x4 a = {__uint_as_float(w[j].x << 16), __uint_as_float(w[j].x & 0xffff0000u), __uint_as_float(w[j].y << 16), __uint_as_float(w[j].y & 0xffff0000u)};
                const f32x4 b = {__uint_as_float(w[j].z << 16), __uint_as_float(w[j].z & 0xffff0000u), __uint_as_float(w[j].w << 16), __uint_as_float(w[j].w & 0xffff0000u)};
                orow[128 * j] = a * rs * g0; orow[128 * j + 1] = b * rs * g1; } }
    }
#undef IN
#undef BOTH
#undef GRID_BAR
}

extern "C" void kernel_launch(void* const* d_in, const int* in_sizes, int n_in, void* d_out, int out_size, void* d_ws, size_t ws_size, hipStream_t stream) {
    static int grid = 0;
    if (grid == 0) {
        if (n_in != 22 || in_sizes[0] != TOK * DM || out_size != TOK * DM || ws_size < WS_END) { fprintf(stderr, "kernel_launch: unexpected shapes / workspace (n_in %d, ws %zu < %zu)\n", n_in, ws_size, (size_t)WS_END); grid = -1; return; }
        int dev = 0, cus = 0, per_cu = 0;
        if (hipGetDevice(&dev) != hipSuccess || hipDeviceGetAttribute(&cus, hipDeviceAttributeMultiprocessorCount, dev) != hipSuccess) { grid = -1; return; }
        if (hipFuncSetAttribute((const void*)fwd_kernel, hipFuncAttributeMaxDynamicSharedMemorySize, LDS_BYTES) != hipSuccess) { fprintf(stderr, "kernel_launch: hipFuncSetAttribute failed\n"); grid = -1; return; }
        if (hipOccupancyMaxActiveBlocksPerMultiprocessor(&per_cu, (const void*)fwd_kernel, NWAVES * 64, LDS_BYTES) != hipSuccess || per_cu < 1) { fprintf(stderr, "kernel_launch: occupancy query reports %d\n", per_cu); }
        (void)hipGetLastError();
        grid = cus;
    }
    if (grid < 0) return;
    if (hipMemsetAsync((char*)d_ws + WS_CTL, 0, CTL_ZERO_BYTES, stream) != hipSuccess) return;
    Args a{};
    for (int i = 0; i < 22; ++i) a.in[i] = (const float*)d_in[i];
    a.out = (float*)d_out; a.ws = (unsigned char*)d_ws;
#if MK_PER_PHASE
    for (int p = 0; p < N_PHASES; ++p) { a.ph_lo = p; a.ph_hi = p + 1; a.li = p; a.pad = 0;
        for (int rep = 0; rep < ((PROBE_DUP_MASK >> p) & 1) + 1; ++rep)
            hipLaunchKernelGGL(fwd_kernel, dim3(grid), dim3(NWAVES * 64), LDS_BYTES, stream, a); }
#else
    a.ph_lo = 0; a.ph_hi = N_PHASES; a.li = 0; a.pad = 0;
    hipLaunchKernelGGL(fwd_kernel, dim3(grid), dim3(NWAVES * 64), LDS_BYTES, stream, a);
#endif
}
```

```cpp
#include <hip/hip_runtime.h>
#include <cstdio>
#include <cstdint>

#ifndef PROBE_DUP_MASK
#define PROBE_DUP_MASK 0
#endif
#ifndef MK_PER_PHASE
#define MK_PER_PHASE 0
#endif

namespace pg8 {
#define PG8_LAS __attribute__((address_space(3)))
typedef unsigned short bf16_t;
typedef short bf16x8 __attribute__((ext_vector_type(8)));
typedef float f32x4 __attribute__((ext_vector_type(4)));
typedef float f32x2 __attribute__((ext_vector_type(2)));
typedef unsigned u32x4 __attribute__((ext_vector_type(4)));
typedef unsigned u32x2 __attribute__((ext_vector_type(2)));
constexpr int BM = 256, BK = 64, HALF = 128, HTB = HALF * BK * 2, STAGE_BYTES = 8 * HTB, NXCD = 8, WGM = 8;

__host__ __device__ __forceinline__ int lds_byte(int r, int c) { const int st = (r >> 4) * 2 + (c >> 5), rr = r & 15, cc = c & 31, ob = rr * 64 + cc * 2; return st * 1024 + (ob ^ (((ob >> 9) & 1) << 5)); }
__host__ __device__ __forceinline__ void stage_rc(int b, int& R, int& C) { const int st = b / 1024, sb = b % 1024, swz = sb ^ (((sb >> 9) & 1) << 5); R = (st >> 1) * 16 + swz / 64; C = (st & 1) * 32 + (swz % 64) / 2; }
__host__ __device__ __forceinline__ int perm32(int rho) { const int n = rho >> 4, i = rho & 15; return 8 * (i >> 2) + 4 * n + (i & 3); }

struct Unit { int pm, pn; };

struct StaticOrder {
    int nM, nN, nwg, G, c;
    __host__ __device__ __forceinline__ void init(int M, int N, int G_, int c_) { nM = M / BM; nN = N / BM; nwg = nM * nN; G = G_; c = c_; }
    __host__ __device__ __forceinline__ bool next(int i, Unit& u) const {
        const long L = (long)i * G + c; if (L >= nwg) return false;
        int wgid = (int)L; { const int q = nwg / NXCD, r = nwg % NXCD, xcd = wgid % NXCD, off = wgid / NXCD; wgid = (xcd < r ? xcd * (q + 1) : r * (q + 1) + (xcd - r) * q) + off; }
        const int nig = WGM * nN, gid = wgid / nig, fm = gid * WGM, gsz = (nM - fm) < WGM ? (nM - fm) : WGM;
        u.pm = fm + ((wgid % nig) % gsz); u.pn = (wgid % nig) / gsz; return true;
    }
};

__device__ __forceinline__ unsigned cvt_pk_bf16(float lo, float hi) { unsigned r; asm volatile("v_cvt_pk_bf16_f32 %0, %1, %2" : "=v"(r) : "v"(lo), "v"(hi)); return r; }
__device__ __forceinline__ int hw_lane() { unsigned l; asm volatile("v_mbcnt_lo_u32_b32 %0, -1, 0\n\tv_mbcnt_hi_u32_b32 %0, -1, %0" : "=v"(l)); return (int)(l & 63u); }

template <bool ABLK, bool BBLK> struct MapPlainT {
    const char* A; const char* Bt; int lda, ldb, K;
    __device__ __forceinline__ unsigned blk(int R, int C) const { return (unsigned)(((R >> 4) * (K / 32) + (C >> 5)) * 1024 + ((R & 15) * 32 + (C & 31)) * 2); }
    __device__ __forceinline__ unsigned voffA(int R, int C) const { return ABLK ? blk(R, C) : (unsigned)(R * lda + C) * 2u; }
    __device__ __forceinline__ size_t kstepA() const { return ABLK ? (size_t)2048 : (size_t)(BK * 2); }
    __device__ __forceinline__ size_t hstepA() const { return ABLK ? (size_t)8 * (K / 32) * 1024 : (size_t)HALF * lda * 2; }
    __device__ __forceinline__ unsigned voffB(int R, int C) const { return BBLK ? blk(R, C) : (unsigned)(R * ldb + C) * 2u; }
    __device__ __forceinline__ size_t kstepB() const { return BBLK ? (size_t)2048 : (size_t)(BK * 2); }
    __device__ __forceinline__ size_t hstepB() const { return BBLK ? (size_t)8 * (K / 32) * 1024 : (size_t)HALF * ldb * 2; }
    __device__ __forceinline__ const char* a_base(const Unit& u) const { return A + (ABLK ? (size_t)u.pm * 16 * (K / 32) * 1024 : (size_t)u.pm * 256 * lda * 2); }
    __device__ __forceinline__ const char* b_base(const Unit& u) const { return Bt + (BBLK ? (size_t)u.pn * 16 * (K / 32) * 1024 : (size_t)u.pn * 256 * ldb * 2); }
};
typedef MapPlainT<false, false> MapPlain;
typedef MapPlainT<false, true> MapPlainB;
typedef MapPlainT<true, true> MapPlainAB;
struct MapBlkA {
    const char* A0; const char* A1; const char* Bt; int ldb, K;
    __device__ __forceinline__ const char* a_base(const Unit& u) const { const size_t pstride = (size_t)16 * (K / 32) * 1024; return (u.pm < 32 ? A0 + (size_t)u.pm * pstride : A1 + (size_t)(u.pm - 32) * pstride); }
    __device__ __forceinline__ const char* b_base(const Unit& u) const { return Bt + (size_t)u.pn * 16 * (K / 32) * 1024; }
    __device__ __forceinline__ unsigned voffA(int R, int C) const { return (unsigned)(((R >> 4) * (K / 32) + (C >> 5)) * 1024 + ((R & 15) * 32 + (C & 31)) * 2); }
    __device__ __forceinline__ size_t kstepA() const { return (size_t)2048; }
    __device__ __forceinline__ size_t hstepA() const { return (size_t)8 * (K / 32) * 1024; }
    __device__ __forceinline__ unsigned voffB(int R, int C) const { return voffA(R, C); }
    __device__ __forceinline__ size_t kstepB() const { return (size_t)2048; }
    __device__ __forceinline__ size_t hstepB() const { return hstepA(); }
};
template <bool ABLK> struct MapBatchBT {
    const char* A; const char* Bt; int lda, ldb, K; size_t bstride;
    __device__ __forceinline__ unsigned voffA(int R, int C) const { return ABLK ? (unsigned)(((R >> 4) * (K / 32) + (C >> 5)) * 1024 + ((R & 15) * 32 + (C & 31)) * 2) : (unsigned)(R * lda + C) * 2u; }
    __device__ __forceinline__ size_t kstepA() const { return ABLK ? (size_t)2048 : (size_t)(BK * 2); }
    __device__ __forceinline__ size_t hstepA() const { return ABLK ? (size_t)8 * (K / 32) * 1024 : (size_t)HALF * lda * 2; }
    __device__ __forceinline__ unsigned voffB(int R, int C) const { return (unsigned)(R * ldb + C) * 2u; }
    __device__ __forceinline__ size_t kstepB() const { return (size_t)(BK * 2); }
    __device__ __forceinline__ size_t hstepB() const { return (size_t)HALF * ldb * 2; }
    __device__ __forceinline__ const char* a_base(const Unit& u) const { return A + (ABLK ? (size_t)u.pm * 16 * (K / 32) * 1024 : (size_t)u.pm * 256 * lda * 2); }
    __device__ __forceinline__ const char* b_base(const Unit& u) const { return Bt + (size_t)(u.pm >> 4) * bstride + (size_t)u.pn * 256 * ldb * 2; }
};
typedef MapBatchBT<false> MapBatchB;
typedef MapBatchBT<true> MapBatchBA;
struct MapAbsorb {
    const char* kvm; const char* W2; int lda, ldb, K;
    __device__ __forceinline__ unsigned voffB(int R, int C) const { return (unsigned)(R * ldb + C) * 2u; }
    __device__ __forceinline__ size_t kstepB() const { return (size_t)(BK * 2); }
    __device__ __forceinline__ size_t hstepB() const { return (size_t)HALF * ldb * 2; }
    __device__ __forceinline__ unsigned voffA(int R, int C) const { return (unsigned)(R * lda + C) * 2u; }
    __device__ __forceinline__ size_t kstepA() const { return (size_t)(BK * 2); }
    __device__ __forceinline__ size_t hstepA() const { return (size_t)HALF * lda * 2; }
    __device__ __forceinline__ const char* a_base(const Unit& u) const {
        if (u.pm < 16) return kvm + ((size_t)(u.pm >> 2) * 256 * 8192 + (size_t)(u.pm & 3) * 1024) * 2;
        return W2 + ((size_t)(u.pm - 16) * 256 * 8192 + 4096 + (size_t)(u.pn & 3) * 1024) * 2; }
    __device__ __forceinline__ const char* b_base(const Unit& u) const {
        if (u.pm < 16) return W2 + ((size_t)u.pn * 256 * 8192 + (size_t)(u.pm & 3) * 1024) * 2;
        return kvm + ((size_t)(u.pn >> 2) * 256 * 8192 + 4096 + (size_t)(u.pn & 3) * 1024) * 2; }
};


__device__ __forceinline__ float row_rstd(const float* part, int row, int fq, float eps) {
    const f32x4* p = (const f32x4*)(part + (size_t)row * 64 + fq * 16);
    const f32x4 a = p[0], b = p[1], c = p[2], d = p[3];
    float s = ((a[0] + a[1]) + (a[2] + a[3])) + ((b[0] + b[1]) + (b[2] + b[3])) + ((c[0] + c[1]) + (c[2] + c[3])) + ((d[0] + d[1]) + (d[2] + d[3]));
    s += __shfl_xor(s, 16); s += __shfl_xor(s, 32);
    return __builtin_amdgcn_rsqf(s * (1.0f / 4096.0f) + eps);
}

struct EpiQKV {
    static constexpr bool PERM = true, AFTER_DRAIN = false;
    bf16_t* O; const float* rx; const PG8_LAS float* tab; int tab_pm;
    unsigned* kn;
    __device__ __forceinline__ void operator()(const f32x4 (&acc)[2][2][4][2], const Unit& u, int wr, int wc, int fr, int fq) const {
        const int row0 = u.pm * BM + wr * 64 + fr, d0 = wc * 32 + 8 * fq; const bool tb = (u.pm == tab_pm);
#pragma unroll
        for (int ai = 0; ai < 2; ++ai)
#pragma unroll
            for (int m = 0; m < 4; ++m) { const int row = row0 + ai * HALF + m * 16; const float r = tb ? tab[ai * HALF + wr * 64 + m * 16 + fr] : rx[row]; const int b = row >> 12, s = row & 4095;
#pragma unroll
                for (int bj = 0; bj < 2; ++bj) { const int head = u.pn * 2 + bj;
                    const f32x4 v0 = acc[ai][bj][m][0] * r, v1 = acc[ai][bj][m][1] * r;
                    u32x4 w; w.x = cvt_pk_bf16(v0[0], v0[1]); w.y = cvt_pk_bf16(v0[2], v0[3]); w.z = cvt_pk_bf16(v1[0], v1[1]); w.w = cvt_pk_bf16(v1[2], v1[3]);
                    *(u32x4*)(O + (((size_t)(b * 96 + head) * 4096 + s) * 128 + d0)) = w; } }
        if (u.pn >= 8 && u.pn < 16) {
#pragma unroll
            for (int bj = 0; bj < 2; ++bj) { float mx = 0.f;
#pragma unroll
                for (int ai = 0; ai < 2; ++ai)
#pragma unroll
                    for (int m = 0; m < 4; ++m) { const int row = row0 + ai * HALF + m * 16; const float r = tb ? tab[ai * HALF + wr * 64 + m * 16 + fr] : rx[row];
                        const f32x4 v0 = acc[ai][bj][m][0] * r, v1 = acc[ai][bj][m][1] * r;
                        float q = ((v0[0] * v0[0] + v0[1] * v0[1]) + (v0[2] * v0[2] + v0[3] * v0[3])) + ((v1[0] * v1[0] + v1[1] * v1[1]) + (v1[2] * v1[2] + v1[3] * v1[3]));
                        q += __shfl_xor(q, 16); q += __shfl_xor(q, 32); mx = fmaxf(mx, q); }
                mx = fmaxf(mx, __shfl_xor(mx, 1)); mx = fmaxf(mx, __shfl_xor(mx, 2)); mx = fmaxf(mx, __shfl_xor(mx, 4)); mx = fmaxf(mx, __shfl_xor(mx, 8));
                if (fr == 0 && fq == 0) atomicMax(kn + ((size_t)((u.pm >> 4) * 16 + (u.pn * 2 + bj - 16)) * 4 + wc), __float_as_uint(mx)); } }
    }
};
struct EpiBf16 {
    static constexpr bool PERM = true, AFTER_DRAIN = false;
    bf16_t* O; int ldc; float s0; int pm_split;
    __device__ __forceinline__ void operator()(const f32x4 (&acc)[2][2][4][2], const Unit& u, int wr, int wc, int fr, int fq) const {
        const int row0 = u.pm * BM + wr * 64 + fr, col0 = u.pn * BM + wc * 32 + 8 * fq; const float sc = (u.pm < pm_split) ? s0 : 1.0f;
#pragma unroll
        for (int ai = 0; ai < 2; ++ai)
#pragma unroll
            for (int m = 0; m < 4; ++m) { bf16_t* rowp = O + (size_t)(row0 + ai * HALF + m * 16) * ldc + col0;
#pragma unroll
                for (int bj = 0; bj < 2; ++bj) { const f32x4 v0 = acc[ai][bj][m][0] * sc, v1 = acc[ai][bj][m][1] * sc;
                    u32x4 w; w.x = cvt_pk_bf16(v0[0], v0[1]); w.y = cvt_pk_bf16(v0[2], v0[3]); w.z = cvt_pk_bf16(v1[0], v1[1]); w.w = cvt_pk_bf16(v1[2], v1[3]);
                    *(u32x4*)(rowp + bj * HALF) = w; } }
    }
};
struct EpiRelu2 {
    static constexpr bool PERM = true, AFTER_DRAIN = false;
    bf16_t* O; bf16_t* O1; int ldc; const float* part; int row_off; float eps; const PG8_LAS float* tab; int tab_pm;
    __device__ __forceinline__ void operator()(const f32x4 (&acc)[2][2][4][2], const Unit& u, int wr, int wc, int fr, int fq) const {
        const int row0 = u.pm * BM + wr * 64 + fr, col0 = u.pn * BM + wc * 32 + 8 * fq;
        float rs[2][4];
        if (u.pm == tab_pm) {
#pragma unroll
            for (int ai = 0; ai < 2; ++ai)
#pragma unroll
                for (int m = 0; m < 4; ++m) rs[ai][m] = tab[ai * HALF + wr * 64 + m * 16 + fr];
        } else {
#pragma unroll
            for (int ai = 0; ai < 2; ++ai) {
                f32x4 pp[4][4];
#pragma unroll
                for (int m = 0; m < 4; ++m) { const f32x4* p = (const f32x4*)(part + (size_t)(row_off + row0 + ai * HALF + m * 16) * 64 + fq * 16);
#pragma unroll
                    for (int q = 0; q < 4; ++q) pp[m][q] = p[q]; }
#pragma unroll
                for (int m = 0; m < 4; ++m) { float s = 0.f;
#pragma unroll
                    for (int q = 0; q < 4; ++q) s += (pp[m][q][0] + pp[m][q][1]) + (pp[m][q][2] + pp[m][q][3]);
                    s += __shfl_xor(s, 16); s += __shfl_xor(s, 32); rs[ai][m] = __builtin_amdgcn_rsqf(s * (1.0f / 4096.0f) + eps); }
                asm volatile("" ::: "memory"); } }
#pragma unroll
        for (int ai = 0; ai < 2; ++ai)
#pragma unroll
            for (int m = 0; m < 4; ++m) { const int row = row0 + ai * HALF + m * 16; const float r = rs[ai][m];
                const int rb = (u.pm & 31) * 16 + ai * 8 + wr * 4 + m, cb = u.pn * 8 + wc;
                bf16_t* rowp = (u.pm < 32 ? O : O1) + ((size_t)rb * (ldc / 32) + cb) * 512 + fr * 32 + 8 * fq;
#pragma unroll
                for (int bj = 0; bj < 2; ++bj) { f32x4 v0 = acc[ai][bj][m][0] * r, v1 = acc[ai][bj][m][1] * r;
#pragma unroll
                    for (int j = 0; j < 4; ++j) { v0[j] = fmaxf(v0[j], 0.f); v0[j] *= v0[j]; v1[j] = fmaxf(v1[j], 0.f); v1[j] *= v1[j]; }
                    u32x4 w; w.x = cvt_pk_bf16(v0[0], v0[1]); w.y = cvt_pk_bf16(v0[2], v0[3]); w.z = cvt_pk_bf16(v1[0], v1[1]); w.w = cvt_pk_bf16(v1[2], v1[3]);
                    *(u32x4*)(rowp + bj * 4 * 512) = w; } }
    }
};
__device__ __forceinline__ void row_rstd_table(PG8_LAS float* tab, const float* part, int grow0, float eps, int tid) {
    const int row = tid >> 1, hf = tid & 1; const f32x4* p = (const f32x4*)(part + (size_t)(grow0 + row) * 64 + hf * 32); float s = 0.f;
#pragma unroll
    for (int i = 0; i < 8; ++i) { const f32x4 a = p[i]; s += (a[0] + a[1]) + (a[2] + a[3]); }
    s += __shfl_xor(s, 1);
    if (hf == 0) tab[row] = __builtin_amdgcn_rsqf(s * (1.0f / 4096.0f) + eps);
    __syncthreads();
}
template <bool BASE_BF16, bool OUT_BF16, bool BASE_BLK = false, bool OUT_BLK = false> struct EpiRes {
    static constexpr bool PERM = true, AFTER_DRAIN = false;
    const void* base; void* out; int ldc; float* part; int row_off;
    __device__ __forceinline__ void operator()(const f32x4 (&acc)[2][2][4][2], const Unit& u, int wr, int wc, int fr, int fq) const {
        const int row0 = row_off + u.pm * BM + wr * 64 + fr, col0 = u.pn * BM + wc * 32 + 8 * fq;
        const int rb0 = (row_off >> 4) + u.pm * 16 + wr * 4, cb0 = u.pn * 8 + wc;
#pragma unroll
        for (int ai = 0; ai < 2; ++ai) {
            f32x4 b0[4][2], b1[4][2];
#pragma unroll
            for (int m = 0; m < 4; ++m)
#pragma unroll
                for (int bj = 0; bj < 2; ++bj) { const size_t off = BASE_BLK ? ((size_t)(rb0 + ai * 8 + m) * (ldc / 32) + cb0 + bj * 4) * 512 + fr * 32 + 8 * fq : (size_t)(row0 + ai * HALF + m * 16) * ldc + col0 + bj * HALF;
                    if constexpr (BASE_BF16) { const u32x4 w = *(const u32x4*)((const bf16_t*)base + off);
                        b0[m][bj] = (f32x4){__uint_as_float(w.x << 16), __uint_as_float(w.x & 0xffff0000u), __uint_as_float(w.y << 16), __uint_as_float(w.y & 0xffff0000u)};
                        b1[m][bj] = (f32x4){__uint_as_float(w.z << 16), __uint_as_float(w.z & 0xffff0000u), __uint_as_float(w.w << 16), __uint_as_float(w.w & 0xffff0000u)}; }
                    else { b0[m][bj] = *(const f32x4*)((const float*)base + off); b1[m][bj] = *(const f32x4*)((const float*)base + off + 4); } }
#pragma unroll
            for (int m = 0; m < 4; ++m) { const int row = row0 + ai * HALF + m * 16; float ss = 0.f;
#pragma unroll
                for (int bj = 0; bj < 2; ++bj) { const size_t off = OUT_BLK ? ((size_t)(rb0 + ai * 8 + m) * (ldc / 32) + cb0 + bj * 4) * 512 + fr * 32 + 8 * fq : (size_t)row * ldc + col0 + bj * HALF;
                    const f32x4 o0 = b0[m][bj] + acc[ai][bj][m][0], o1 = b1[m][bj] + acc[ai][bj][m][1];
                    ss += ((o0[0] * o0[0] + o0[1] * o0[1]) + (o0[2] * o0[2] + o0[3] * o0[3])) + ((o1[0] * o1[0] + o1[1] * o1[1]) + (o1[2] * o1[2] + o1[3] * o1[3]));
                    if constexpr (OUT_BF16) { u32x4 w; w.x = cvt_pk_bf16(o0[0], o0[1]); w.y = cvt_pk_bf16(o0[2], o0[3]); w.z = cvt_pk_bf16(o1[0], o1[1]); w.w = cvt_pk_bf16(o1[2], o1[3]);
                        *(u32x4*)((bf16_t*)out + off) = w; }
                    else { *(f32x4*)((float*)out + off) = o0; *(f32x4*)((float*)out + off + 4) = o1; } }
                ss += __shfl_xor(ss, 16); ss += __shfl_xor(ss, 32);
                if (fq == 0) part[(size_t)row * 64 + u.pn * 4 + wc] = ss; }
            asm volatile("" ::: "memory"); }
    }
};
struct EpiSoftmax {
    static constexpr bool PERM = true, AFTER_DRAIN = true;
    bf16_t* O; int ldc; const float* part; float eps;
    __device__ __forceinline__ void fused(f32x4 (&acc)[2][2][4][2], const Unit& u, int wr, int wc, int fr, int fq, PG8_LAS unsigned char* lds, int wid, int lane) const {
        PG8_LAS float* R = (PG8_LAS float*)lds;
        PG8_LAS f32x2* X = (PG8_LAS f32x2*)(lds + 1024);
        const int tid = wid * 64 + lane;
        {   const int row = tid >> 1, hf = tid & 1; const f32x4* p = (const f32x4*)(part + (size_t)(u.pm * BM + row) * 64 + hf * 32); float s = 0.f;
#pragma unroll
            for (int i = 0; i < 8; ++i) { const f32x4 a = p[i]; s += (a[0] + a[1]) + (a[2] + a[3]); }
            s += __shfl_xor(s, 1);
            if (hf == 0) R[row] = __builtin_amdgcn_rsqf(s * (1.0f / 4096.0f) + eps) * 1.4426950408889634f; }
        asm volatile("s_waitcnt lgkmcnt(0)" ::: "memory"); __builtin_amdgcn_s_barrier(); asm volatile("" ::: "memory");
        float mw[2][4];
#pragma unroll
        for (int ai = 0; ai < 2; ++ai)
#pragma unroll
            for (int m = 0; m < 4; ++m) { const int r = ai * HALF + wr * 64 + m * 16 + fr; const float rs = R[r]; float mx = -3.0e38f;
#pragma unroll
                for (int bj = 0; bj < 2; ++bj)
#pragma unroll
                    for (int n = 0; n < 2; ++n) { acc[ai][bj][m][n] = acc[ai][bj][m][n] * rs; const f32x4 x = acc[ai][bj][m][n]; mx = fmaxf(mx, fmaxf(fmaxf(x[0], x[1]), fmaxf(x[2], x[3]))); }
                mx = fmaxf(mx, __shfl_xor(mx, 16)); mx = fmaxf(mx, __shfl_xor(mx, 32)); mw[ai][m] = mx; float s = 0.f;
#pragma unroll
                for (int bj = 0; bj < 2; ++bj)
#pragma unroll
                    for (int n = 0; n < 2; ++n) { f32x4 x = acc[ai][bj][m][n];
#pragma unroll
                        for (int j = 0; j < 4; ++j) { x[j] = __builtin_amdgcn_exp2f(x[j] - mx); s += x[j]; }
                        acc[ai][bj][m][n] = x; }
                s += __shfl_xor(s, 16); s += __shfl_xor(s, 32);
                if (fq == 0) X[r * 4 + wc] = (f32x2){mx, s}; }
        asm volatile("s_waitcnt lgkmcnt(0)" ::: "memory"); __builtin_amdgcn_s_barrier(); asm volatile("" ::: "memory");
        const int row0 = u.pm * BM + wr * 64 + fr, col0 = u.pn * BM + wc * 32 + 8 * fq;
#pragma unroll
        for (int ai = 0; ai < 2; ++ai)
#pragma unroll
            for (int m = 0; m < 4; ++m) { const int r = ai * HALF + wr * 64 + m * 16 + fr;
                const f32x2 a = X[r * 4 + 0], b = X[r * 4 + 1], c = X[r * 4 + 2], d = X[r * 4 + 3];
                const float M = fmaxf(fmaxf(a.x, b.x), fmaxf(c.x, d.x));
                const float S = a.y * __builtin_amdgcn_exp2f(a.x - M) + b.y * __builtin_amdgcn_exp2f(b.x - M) + c.y * __builtin_amdgcn_exp2f(c.x - M) + d.y * __builtin_amdgcn_exp2f(d.x - M);
                const float f = __builtin_amdgcn_exp2f(mw[ai][m] - M) / S;
                bf16_t* rowp = O + (size_t)(row0 + ai * HALF + m * 16) * ldc + col0;
#pragma unroll
                for (int bj = 0; bj < 2; ++bj) { const f32x4 v0 = acc[ai][bj][m][0] * f, v1 = acc[ai][bj][m][1] * f;
                    u32x4 w; w.x = cvt_pk_bf16(v0[0], v0[1]); w.y = cvt_pk_bf16(v0[2], v0[3]); w.z = cvt_pk_bf16(v1[0], v1[1]); w.w = cvt_pk_bf16(v1[2], v1[3]);
                    *(u32x4*)(rowp + bj * HALF) = w; } }
    }
};

template <class Map, class Epi, class Sched, bool ALIGN_EPI = false, bool SP2 = false>
__device__ __forceinline__ void gemm_phase(PG8_LAS unsigned char* lds, const Map G, const Sched& S, const Epi& E, const int wid_) {
    const int wid = wid_ & 7, lane = hw_lane(), tid = wid * 64 + lane, wr = wid >> 2, wc = wid & 3, fr = lane & 15, fq = lane >> 4;
    const int nt = G.K / BK;
    unsigned voffA[2], voffB[2];
#pragma unroll
    for (int i = 0; i < 2; ++i) { int R, C; stage_rc(tid * 16 + i * 8192, R, C); const int Rb = Epi::PERM ? ((R & ~31) + perm32(R & 31)) : R;
        voffA[i] = G.voffA(R, C); voffB[i] = G.voffB(Rb, C); }
    const size_t kstepA = G.kstepA(), kstepB = G.kstepB();
    const size_t hstepA = G.hstepA(), hstepB = G.hstepB();
    const unsigned ldsw = (unsigned)wid * 1024u;
    const int aoff = lds_byte(wr * 64 + fr, fq * 8), boff = lds_byte(wc * 32 + fr, fq * 8);
#define PG8_SA(b, h) (((b) * 2 + (h)) * HTB)
#define PG8_SB(b, h) ((4 + (b) * 2 + (h)) * HTB)
#define PG8_STAGE(bufoff, gbase, voff) do { _Pragma("unroll") for (int _i = 0; _i < 2; ++_i) \
        __builtin_amdgcn_global_load_lds((const unsigned*)((const char*)(gbase) + (voff)[_i]), (PG8_LAS unsigned*)(lds + (bufoff) + ldsw + _i * 8192), 16, 0, 0); } while (0)
#define PG8_LDA(dst, b, h) do { _Pragma("unroll") for (int m = 0; m < 4; ++m) _Pragma("unroll") for (int k = 0; k < 2; ++k) dst[m][k] = *(const PG8_LAS bf16x8*)(lds + PG8_SA(b, h) + aoff + m * 2048 + k * 1024); } while (0)
#define PG8_LDB(dst, b, h) do { _Pragma("unroll") for (int n = 0; n < 2; ++n) _Pragma("unroll") for (int k = 0; k < 2; ++k) dst[n][k] = *(const PG8_LAS bf16x8*)(lds + PG8_SB(b, h) + boff + n * 2048 + k * 1024); } while (0)
#define PG8_MMA(ai, bj, At, Bt) do { __builtin_amdgcn_s_setprio(1); _Pragma("unroll") for (int m = 0; m < 4; ++m) _Pragma("unroll") for (int n = 0; n < 2; ++n) _Pragma("unroll") for (int k = 0; k < 2; ++k) \
        acc[ai][bj][m][n] = __builtin_amdgcn_mfma_f32_16x16x32_bf16(Bt[n][k], At[m][k], acc[ai][bj][m][n], 0, 0, 0); __builtin_amdgcn_s_setprio(0); } while (0)
#define PG8_WAIT_V(n) asm volatile("s_waitcnt vmcnt(" #n ")" ::: "memory")
#define PG8_WAIT_L(n) asm volatile("s_waitcnt lgkmcnt(" #n ")" ::: "memory")
#define PG8_BAR __builtin_amdgcn_s_barrier()
#define PG8_SCHED __builtin_amdgcn_sched_barrier(0)
    Unit cur, nxt; int ui = 0;
    if (!S.next(0, cur)) return;
    f32x4 acc[2][2][4][2];
#pragma unroll
    for (int a = 0; a < 2; ++a)
#pragma unroll
        for (int b = 0; b < 2; ++b)
#pragma unroll
            for (int m = 0; m < 4; ++m)
#pragma unroll
                for (int n = 0; n < 2; ++n) acc[a][b][m][n] = (f32x4){0.f, 0.f, 0.f, 0.f};
    bf16x8 At[4][2], B0[2][2], B1[2][2];
    const char* cA = G.a_base(cur); const char* cB = G.b_base(cur);
    if constexpr (SP2) {
        PG8_STAGE(PG8_SB(0, 0), cB, voffB); PG8_STAGE(PG8_SB(0, 1), cB + hstepB, voffB); PG8_STAGE(PG8_SA(0, 0), cA, voffA); PG8_STAGE(PG8_SA(0, 1), cA + hstepA, voffA);
        if (wr == 1) PG8_BAR;
        PG8_WAIT_V(2); PG8_BAR;
        PG8_STAGE(PG8_SB(1, 0), cB + kstepB, voffB); PG8_STAGE(PG8_SA(1, 0), cA + kstepA, voffA); PG8_STAGE(PG8_SB(1, 1), cB + hstepB + kstepB, voffB);
        PG8_WAIT_V(6); PG8_BAR;
    } else {
        PG8_STAGE(PG8_SB(0, 0), cB, voffB); PG8_STAGE(PG8_SA(0, 0), cA, voffA); PG8_STAGE(PG8_SB(0, 1), cB + hstepB, voffB); PG8_STAGE(PG8_SA(0, 1), cA + hstepA, voffA);
        if (wr == 1) PG8_BAR;
        PG8_WAIT_V(4); PG8_BAR;
        PG8_STAGE(PG8_SB(1, 0), cB + kstepB, voffB); PG8_STAGE(PG8_SA(1, 0), cA + kstepA, voffA); PG8_STAGE(PG8_SB(1, 1), cB + hstepB + kstepB, voffB);
        PG8_WAIT_V(6); PG8_BAR;
    }
    for (;;) {
        const bool has_next = S.next(ui + 1, nxt);
        const char* nA = has_next ? G.a_base(nxt) : cA; const char* nB = has_next ? G.b_base(nxt) : cB;
        for (int t = 0; t < nt; t += 2) {
            const bool last = (t == nt - 2);
            const char* a1 = cA + (size_t)(t + 1) * kstepA;
            const char* a2 = last ? nA : cA + (size_t)(t + 2) * kstepA; const char* b2 = last ? nB : cB + (size_t)(t + 2) * kstepB;
            const char* a3 = a2 + kstepA; const char* b3 = b2 + kstepB;
            if constexpr (SP2) {
            PG8_LDB(B0, 0, 0); PG8_LDB(B1, 0, 1); PG8_SCHED; PG8_LDA(At, 0, 0); PG8_STAGE(PG8_SA(1, 1), a1 + hstepA, voffA);
            PG8_WAIT_V(8); PG8_WAIT_L(0); PG8_BAR; PG8_MMA(0, 0, At, B0); PG8_MMA(0, 1, At, B1); PG8_BAR; PG8_SCHED;
            PG8_LDA(At, 0, 1); PG8_STAGE(PG8_SB(0, 0), b2, voffB); PG8_STAGE(PG8_SB(0, 1), b2 + hstepB, voffB); PG8_STAGE(PG8_SA(0, 0), a2, voffA);
            PG8_WAIT_V(8); PG8_WAIT_L(0); PG8_BAR; PG8_MMA(1, 0, At, B0); PG8_MMA(1, 1, At, B1); PG8_BAR; PG8_SCHED;
            PG8_LDB(B0, 1, 0); PG8_LDB(B1, 1, 1); PG8_SCHED; PG8_LDA(At, 1, 0); PG8_STAGE(PG8_SA(0, 1), a2 + hstepA, voffA);
            PG8_WAIT_V(8); PG8_WAIT_L(0); PG8_BAR; PG8_MMA(0, 0, At, B0); PG8_MMA(0, 1, At, B1); PG8_BAR; PG8_SCHED;
            PG8_LDA(At, 1, 1); PG8_STAGE(PG8_SB(1, 0), b3, voffB); PG8_STAGE(PG8_SB(1, 1), b3 + hstepB, voffB); PG8_STAGE(PG8_SA(1, 0), a3, voffA);
            PG8_WAIT_V(8); PG8_WAIT_L(0); PG8_BAR; PG8_MMA(1, 0, At, B0); PG8_MMA(1, 1, At, B1); PG8_BAR; PG8_SCHED;
            } else {
            PG8_LDB(B0, 0, 0); PG8_SCHED; PG8_LDA(At, 0, 0); PG8_STAGE(PG8_SA(1, 1), a1 + hstepA, voffA);
            PG8_WAIT_L(8); PG8_BAR; PG8_WAIT_L(0); PG8_MMA(0, 0, At, B0); PG8_BAR; PG8_SCHED;
            PG8_LDB(B1, 0, 1); PG8_STAGE(PG8_SB(0, 0), b2, voffB);
            PG8_BAR; PG8_WAIT_L(0); PG8_MMA(0, 1, At, B1); PG8_BAR;
            PG8_LDA(At, 0, 1); PG8_STAGE(PG8_SA(0, 0), a2, voffA);
            PG8_BAR; PG8_WAIT_L(0); PG8_MMA(1, 0, At, B0); PG8_BAR; PG8_SCHED;
            PG8_STAGE(PG8_SB(0, 1), b2 + hstepB, voffB);
            PG8_WAIT_V(6); PG8_BAR; PG8_MMA(1, 1, At, B1); PG8_BAR;
            PG8_LDB(B0, 1, 0); PG8_SCHED; PG8_LDA(At, 1, 0); PG8_STAGE(PG8_SA(0, 1), a2 + hstepA, voffA);
            PG8_WAIT_L(8); PG8_BAR; PG8_WAIT_L(0); PG8_MMA(0, 0, At, B0); PG8_BAR; PG8_SCHED;
            PG8_LDB(B1, 1, 1); PG8_STAGE(PG8_SB(1, 0), b3, voffB);
            PG8_BAR; PG8_WAIT_L(0); PG8_MMA(0, 1, At, B1); PG8_BAR;
            PG8_LDA(At, 1, 1); PG8_STAGE(PG8_SA(1, 0), a3, voffA);
            PG8_BAR; PG8_WAIT_L(0); PG8_MMA(1, 0, At, B0); PG8_BAR; PG8_SCHED;
            PG8_STAGE(PG8_SB(1, 1), b3 + hstepB, voffB);
            PG8_WAIT_V(6); PG8_BAR; PG8_MMA(1, 1, At, B1); PG8_BAR;
            }
        }
        if constexpr (ALIGN_EPI) { if (wr == 0) PG8_BAR; }
        if constexpr (!Epi::AFTER_DRAIN) { E(acc, cur, wr, wc, fr, fq); }
        if (!has_next) break;
#pragma unroll
        for (int a = 0; a < 2; ++a)
#pragma unroll
            for (int b = 0; b < 2; ++b)
#pragma unroll
                for (int m = 0; m < 4; ++m)
#pragma unroll
                    for (int n = 0; n < 2; ++n) acc[a][b][m][n] = (f32x4){0.f, 0.f, 0.f, 0.f};
        cur = nxt; cA = nA; cB = nB; ++ui;
        if constexpr (ALIGN_EPI) { if (wr == 1) PG8_BAR; }
    }
    PG8_WAIT_V(0);
    if constexpr (!ALIGN_EPI) { if (wr == 0) PG8_BAR; }
    PG8_BAR;
    if constexpr (Epi::AFTER_DRAIN) { E.fused(acc, cur, wr, wc, fr, fq, lds, wid, lane); }
#undef PG8_SA
#undef PG8_SB
#undef PG8_STAGE
#undef PG8_LDA
#undef PG8_LDB
#undef PG8_MMA
#undef PG8_WAIT_V
#undef PG8_WAIT_L
#undef PG8_BAR
#undef PG8_SCHED
}
}

namespace att {
typedef unsigned short bf16;
typedef short bf16x8 __attribute__((ext_vector_type(8)));
typedef short s16x4 __attribute__((ext_vector_type(4)));
typedef float f32x16 __attribute__((ext_vector_type(16)));
typedef float f32x4 __attribute__((ext_vector_type(4)));
typedef unsigned u32x4 __attribute__((ext_vector_type(4)));
constexpr int D = 128, NW = 8, QBLK = 32, KVBLK = 64, QB = NW * QBLK;
constexpr float SCALE = 0.08838834764831845f;
constexpr float THR = 8.f;
constexpr int SHM_V = KVBLK * D * 2, SHM_K = KVBLK * D * 2;
constexpr int OFF_SCR = 2 * SHM_V + 2 * SHM_K, OFF_TAB = OFF_SCR + NW * 64 * 4, OFF_Q = OFF_TAB + 2 * 16384, LDS_BYTES = OFF_Q + NW * 4096;

#define KSWZ(row, colB) ((row) * 256 + ((colB) ^ (((row) & 7) << 4)))
#define SBAR() __builtin_amdgcn_sched_barrier(0)
__device__ __forceinline__ int v_st(int k, int c) { const int kk = (k & ~0xC) | ((k & 4) << 1) | ((k & 8) >> 1); return ((kk >> 3) * 4 + (c >> 5)) * 512 + ((kk & 7) * 32 + (c & 31)) * 2; }
__device__ __forceinline__ int v_rd_base(int lane) { return ((lane & 3) << 3) | (((lane >> 2) & 3) << 6) | (((lane >> 4) & 1) << 5) | (((lane >> 5) & 1) << 8); }
constexpr int v_rd_off(int d0, int ks, int half) { return d0 * 512 + ks * 4096 + half * 2048; }
__device__ __forceinline__ int crow(int r, int hi) { return (r & 3) + 8 * (r >> 2) + 4 * hi; }
__device__ __forceinline__ unsigned cvtpk(float lo, float hi) { unsigned r; asm volatile("v_cvt_pk_bf16_f32 %0, %1, %2" : "=v"(r) : "v"(lo), "v"(hi)); return r; }
__device__ __forceinline__ bf16x8 ld8(const bf16* p) { return *reinterpret_cast<const bf16x8*>(p); }

__device__ __forceinline__ void mask_tile(f32x16& p0, f32x16& p1, int dq) {
    const float NEG = -__builtin_inff();
#pragma unroll
    for (int r = 0; r < 16; ++r) {
        const int c = (r & 3) + 8 * (r >> 2);
        if (dq - c < 0) p0[r] = NEG;
        if (dq - c - 32 < 0) p1[r] = NEG;
    }
}
__device__ __forceinline__ void diff_bias(f32x16& p0, f32x16& p1, const float* tl, int kb) {
    const float* t = tl + kb;
#pragma unroll
    for (int g = 0; g < 4; ++g) {
#pragma unroll
        for (int j = 0; j < 4; ++j) { const int c = j + 8 * g; p0[4 * g + j] += t[c]; p1[4 * g + j] += t[c + 32]; }
        asm volatile("" ::: "memory"); }
}
__device__ __forceinline__ void partialSM(f32x16& p0, f32x16& p1, float& m_reg, float& mn, float& alpha) {
    float pmax = fmaxf(p0[0], p1[0]);
#pragma unroll
    for (int r = 1; r < 16; ++r) pmax = __builtin_fmaxf(__builtin_fmaxf(pmax, p0[r]), p1[r]);
    { auto rr = __builtin_amdgcn_permlane32_swap(__float_as_uint(pmax), __float_as_uint(pmax), false, false);
      pmax = fmaxf(__uint_as_float(rr[0]), __uint_as_float(rr[1])); }
    constexpr float C2 = 1.4426950408889634f * SCALE;
    if (__builtin_expect(__all((pmax - m_reg) * SCALE <= THR), 1)) { mn = m_reg; alpha = 1.f; }
    else { mn = fmaxf(m_reg, pmax); alpha = __builtin_amdgcn_exp2f((m_reg - mn) * C2); m_reg = mn; }
    const float mnL = -mn * C2;
    for (int r = 0; r < 16; ++r) p0[r] = fmaf(p0[r], C2, mnL); for (int r = 0; r < 16; ++r) p1[r] = fmaf(p1[r], C2, mnL);
    for (int r = 0; r < 16; ++r) p0[r] = __builtin_amdgcn_exp2f(p0[r]);
}
__device__ __forceinline__ void finishSM(f32x16& p0, f32x16& p1, float alpha, float& l_reg, bf16x8& pa0, bf16x8& pa1, bf16x8& pa2, bf16x8& pa3) {
    for (int r = 0; r < 16; ++r) p1[r] = __builtin_amdgcn_exp2f(p1[r]);
    float ps = 0; for (int r = 0; r < 16; ++r) ps += p0[r]; for (int r = 0; r < 16; ++r) ps += p1[r];
    { auto rr = __builtin_amdgcn_permlane32_swap(__float_as_uint(ps), __float_as_uint(ps), false, false);
      ps = __uint_as_float(rr[0]) + __uint_as_float(rr[1]); }
    l_reg = l_reg * alpha + ps;
#define PK4(P, B_, OUT) do { unsigned a0 = cvtpk(P[B_+0], P[B_+1]), a1 = cvtpk(P[B_+2], P[B_+3]);                          \
        unsigned b0 = cvtpk(P[B_+4], P[B_+5]), b1 = cvtpk(P[B_+6], P[B_+7]);                                             \
        auto r0 = __builtin_amdgcn_permlane32_swap(a0, b0, false, false); auto r1 = __builtin_amdgcn_permlane32_swap(a1, b1, false, false); \
        u32x4 w = {r0[0], r1[0], r0[1], r1[1]}; OUT = *reinterpret_cast<bf16x8*>(&w); } while (0)
    PK4(p0, 0, pa0); PK4(p0, 8, pa1); PK4(p1, 0, pa2); PK4(p1, 8, pa3);
#undef PK4
}
template <int KB, int MODE, int QR = 4>
__device__ __forceinline__ void qkt(f32x16& p0, f32x16& p1, const char* K_lds, int r32, int hi, const bf16x8* qr, const char* qsl, const float* tabk) {
    p0 = f32x16{}; p1 = f32x16{};
    float x0 = 0.f, x1 = 0.f;
    if (MODE == 0) { x0 = tabk[0]; x1 = tabk[32]; }
    const char* kb[4];
#pragma unroll
    for (int dd = 0; dd < 4; ++dd) kb[dd] = K_lds + KB * SHM_K + KSWZ(r32, (dd * 16 + hi * 8) * 2);
#pragma unroll
    for (int d0 = 0; d0 < 8; ++d0) { const char* a = kb[d0 & 3] + (d0 >> 2) * 128;
        bf16x8 b0 = *reinterpret_cast<const bf16x8*>(a);
        bf16x8 b1 = *reinterpret_cast<const bf16x8*>(a + 32 * 256);
        const bf16x8 qv = (d0 < QR) ? qr[d0 < QR ? d0 : 0] : *reinterpret_cast<const bf16x8*>(qsl + (d0 - QR) * 1024);
        p0 = __builtin_amdgcn_mfma_f32_32x32x16_bf16(b0, qv, p0, 0, 0, 0);
        p1 = __builtin_amdgcn_mfma_f32_32x32x16_bf16(b1, qv, p1, 0, 0, 0); }
    if (MODE == 0) {
        const unsigned ua = __float_as_uint(x0), a1 = ua & 0xffff0000u; const float ra = x0 - __uint_as_float(a1); const unsigned a2 = __float_as_uint(ra) & 0xffff0000u; const float rb = ra - __uint_as_float(a2);
        const unsigned ub = __float_as_uint(x1), b1 = ub & 0xffff0000u; const float rc = x1 - __uint_as_float(b1); const unsigned b2 = __float_as_uint(rc) & 0xffff0000u; const float rd = rc - __uint_as_float(b2);
        u32x4 ka = {hi ? 0u : ((a1 >> 16) | a2), hi ? 0u : (__float_as_uint(rb) >> 16), 0u, 0u};
        u32x4 kb2 = {hi ? 0u : ((b1 >> 16) | b2), hi ? 0u : (__float_as_uint(rd) >> 16), 0u, 0u};
        const u32x4 qx = {0x3f803f80u, 0x00003f80u, 0u, 0u};
        p0 = __builtin_amdgcn_mfma_f32_32x32x16_bf16(*reinterpret_cast<bf16x8*>(&ka), *reinterpret_cast<const bf16x8*>(&qx), p0, 0, 0, 0);
        p1 = __builtin_amdgcn_mfma_f32_32x32x16_bf16(*reinterpret_cast<bf16x8*>(&kb2), *reinterpret_cast<const bf16x8*>(&qx), p1, 0, 0, 0);
    }
}
template <int VB>
__device__ __forceinline__ void pv_tile(f32x16* o, int vb0, bf16x8 pa0, bf16x8 pa1, bf16x8 pa2, bf16x8 pa3) {
#define TRRD(dst, off) asm volatile("ds_read_b64_tr_b16 %0, %1 offset:%2" : "=&v"(dst) : "v"(vb0), "i"(off) : "memory")
#define PV_D0(d0) do { s16x4 l0, l1, l2, l3, h0, h1, h2, h3; constexpr int b_ = VB * SHM_V + v_rd_off(d0, 0, 0); \
        TRRD(l0, b_); TRRD(h0, b_ + 2048); TRRD(l1, b_ + 4096); TRRD(h1, b_ + 6144); TRRD(l2, b_ + 8192); TRRD(h2, b_ + 10240); TRRD(l3, b_ + 12288); TRRD(h3, b_ + 14336); \
        asm volatile("s_waitcnt lgkmcnt(0)" ::: "memory"); SBAR();   \
        o[d0] = __builtin_amdgcn_mfma_f32_32x32x16_bf16(pa0, (bf16x8){l0[0], l0[1], l0[2], l0[3], h0[0], h0[1], h0[2], h0[3]}, o[d0], 0, 0, 0);   \
        o[d0] = __builtin_amdgcn_mfma_f32_32x32x16_bf16(pa1, (bf16x8){l1[0], l1[1], l1[2], l1[3], h1[0], h1[1], h1[2], h1[3]}, o[d0], 0, 0, 0);   \
        o[d0] = __builtin_amdgcn_mfma_f32_32x32x16_bf16(pa2, (bf16x8){l2[0], l2[1], l2[2], l2[3], h2[0], h2[1], h2[2], h2[3]}, o[d0], 0, 0, 0);   \
        o[d0] = __builtin_amdgcn_mfma_f32_32x32x16_bf16(pa3, (bf16x8){l3[0], l3[1], l3[2], l3[3], h3[0], h3[1], h3[2], h3[3]}, o[d0], 0, 0, 0); } while (0)
    PV_D0(0); PV_D0(1); PV_D0(2); PV_D0(3);
#undef PV_D0
#undef TRRD
}

struct BlockRef { const bf16* Q; const bf16* K; const bf16* V; void* O; const float* tab; int P0; int kb0; float kmax2; int tabn; int c; float lam; const float* gs; float* scr; };
struct Seam { bf16x8 qr[8]; bf16x8 st_v0, st_v1, st_k0, st_k1; int tb; };
#define ROW(p, k0, rr) ((p) + (size_t)((k0) + (rr)) * D + sc)
#define VMW() asm volatile("s_waitcnt vmcnt(0)" ::: "memory")
#define VMWN(n) asm volatile("s_waitcnt vmcnt(%0)" :: "i"(n) : "memory")
#define SLOAD_H(Kp, Vp, k0) do { S.st_v0 = ld8(ROW(Vp, k0, sr)); S.st_v1 = ld8(ROW(Vp, k0, 32 + sr));              \
                         S.st_k0 = ld8(ROW(Kp, k0, sr)); S.st_k1 = ld8(ROW(Kp, k0, 32 + sr)); } while (0)
#define SWRITE_HK(bf) do { *(bf16x8*)(K_lds + (bf) * SHM_K + kws) = S.st_k0; *(bf16x8*)(K_lds + (bf) * SHM_K + kws + 32 * 256) = S.st_k1; } while (0)
#define SWRITE_HV(bf) do { *(bf16x8*)(V_lds + (bf) * SHM_V + vst0) = S.st_v0; *(bf16x8*)(V_lds + (bf) * SHM_V + vst1) = S.st_v1; } while (0)
#define SWRITE_H(bf) do { SWRITE_HV(bf); SWRITE_HK(bf); } while (0)
__device__ __forceinline__ void attn_prime(const BlockRef& cur, char* lds, Seam& S, const int wid_) {
    const int wid = wid_ & 7, lane = pg8::hw_lane(), tid = wid * 64 + lane, r32 = lane & 31, hi = lane >> 5;
    const int sr = tid >> 4, sc = (tid & 15) * 8, kws = KSWZ(sr, sc * 2); char* K_lds = lds + 2 * SHM_V;
#pragma unroll
    for (int d0 = 0; d0 < 8; ++d0) S.qr[d0] = ld8(cur.Q + (size_t)(wid * QBLK + r32) * D + d0 * 16 + hi * 8);
    SLOAD_H(cur.K, cur.V, cur.kb0); VMW(); SWRITE_HK(0);
    S.tb = 0; { float* tabL = (float*)(lds + OFF_TAB); for (int i = tid * 4; i < cur.tabn; i += 2048) *(f32x4*)(tabL + i) = *(const f32x4*)(cur.tab + i); }
    __syncthreads();
}
template <int MODE>
__device__ __forceinline__ void attn_block(const BlockRef& cur, const BlockRef& nxt, char* lds, Seam& S, const int wid_) {
    const int wid = wid_ & 7, lane = pg8::hw_lane(), tid = wid * 64 + lane, r32 = lane & 31, hi = lane >> 5;
    constexpr int ldo = MODE ? 2048 : 4096;
    int NT = cur.P0 / KVBLK + 4;
    const int jtop = NT - 1;
    const int qlo = cur.P0 + wid * QBLK, row = qlo + r32;
    const int qlo_m = MODE ? (qlo | 63) : qlo;
    const int qm = (MODE ? (row | 63) : row) - 4 * hi;
    char* V_lds = lds; char* K_lds = lds + 2 * SHM_V;
    float* ws = (float*)(lds + OFF_SCR) + wid * 64; float* li_l = ws, * al_l = ws + 32;
    float* tabL = (float*)(lds + OFF_TAB + S.tb * 16384);
    float qn2 = 0.f;
    if (MODE == 0) {
#pragma unroll
        for (int d0 = 0; d0 < 8; ++d0)
#pragma unroll
            for (int e = 0; e < 8; ++e) { const float f = __uint_as_float((unsigned)(unsigned short)S.qr[d0][e] << 16); qn2 += f * f; }
        auto rr = __builtin_amdgcn_permlane32_swap(__float_as_uint(qn2), __float_as_uint(qn2), false, false); qn2 = __uint_as_float(rr[0]) + __uint_as_float(rr[1]); }
    char* qsl = lds + OFF_Q + wid * 4096 + lane * 16;
#pragma unroll
    for (int j = 0; j < 4; ++j) *(bf16x8*)(qsl + j * 1024) = S.qr[4 + j];
    if (MODE == 0) {
        const float X = 2.0f * sqrtf(qn2 * cur.kmax2) - tabL[row];
        float xm = X;
#pragma unroll
        for (int o_ = 1; o_ < 64; o_ <<= 1) xm = fmaxf(xm, __shfl_xor(xm, o_));
        if (lane == 0) li_l[0] = xm;
        __syncthreads();
        float xb = -3.0e38f;
#pragma unroll
        for (int w = 0; w < NW; ++w) xb = fmaxf(xb, ((float*)(lds + OFF_SCR))[w * 64]);
        const float thr = -164.0f / (1.4426950408889634f * SCALE) - xb;
        int lo = 0, hi_ = jtop;
        while (lo < hi_) { const int mid = (lo + hi_) >> 1; if (tabL[64 * mid + 63] < thr) lo = mid + 1; else hi_ = mid; }
        NT = jtop - lo + 1;
        __syncthreads();
    }
    const float* tl = MODE ? (tabL + (192 + 4 * hi - row)) : (tabL + r32);
    float m_reg = -1e30f, l_reg = 0; f32x16 o[4] = {};
    const int sr = tid >> 4, sc = (tid & 15) * 8, vst0 = v_st(sr, sc), vst1 = v_st(32 + sr, sc), kws = KSWZ(sr, sc * 2);
    const int vb0 = (int)(uintptr_t)V_lds + v_rd_base(lane);
    const bf16* Kh = cur.K; const bf16* Vh = cur.V;
#define RESC(a) do { if (__any((a) < 1.f)) { if (hi == 0) al_l[r32] = (a); asm volatile("s_waitcnt lgkmcnt(0)" ::: "memory");              \
                     for (int d_ = 0; d_ < 4; ++d_) for (int r = 0; r < 16; ++r) o[d_][r] *= al_l[crow(r, hi)]; } } while (0)
#define KBASE(t) (MODE == 0 ? (jtop - (t)) * KVBLK : (t) * KVBLK)
#define MASKT(P0_, P1_, t) do { const int kb_ = KBASE(t);                                                                    \
        if (MODE == 1) { if (kb_ >= qlo - 153 && kb_ <= qlo_m) diff_bias(P0_, P1_, tl, kb_); }                              \
        if (kb_ + KVBLK - 1 > qlo_m) mask_tile(P0_, P1_, qm - kb_); } while (0)
    constexpr int NQL = 8;
#define SEAM_K0() do { VMWN(NQL); SWRITE_HK(0); SBAR(); } while (0)
    f32x16 pA0, pA1, pB0, pB1; float mnA, mnB, alA, alB; bf16x8 pa0, pa1, pa2, pa3;
    SWRITE_HV(0); SBAR();
    if (NT > 1) { SLOAD_H(Kh, Vh, KBASE(1)); }
    SBAR(); qkt<0, MODE>(pA0, pA1, K_lds, r32, hi, S.qr, qsl, tl + KBASE(0));
    MASKT(pA0, pA1, 0); partialSM(pA0, pA1, m_reg, mnA, alA);
    if (NT > 1) { VMW(); SWRITE_HK(1); }
    __syncthreads();
#define HALF_STEP(PX0, PX1, mnX, alX, PY0, PY1, alY, t, KB, VB, SB) do {                                                      \
        SWRITE_HV(KB);                                                                                                        \
        if ((t) + 1 < NT) { SLOAD_H(Kh, Vh, KBASE((t) + 1)); }                                                                \
        SBAR(); qkt<KB, MODE>(PX0, PX1, K_lds, r32, hi, S.qr, qsl, tl + KBASE(t));                                           \
        finishSM(PY0, PY1, alY, l_reg, pa0, pa1, pa2, pa3); SBAR();                                                           \
        pv_tile<VB>(o, vb0, pa0, pa1, pa2, pa3); MASKT(PX0, PX1, (t)); partialSM(PX0, PX1, m_reg, mnX, alX);                  \
        if ((t) + 1 < NT) { VMW(); SWRITE_HK(SB); }                                                                           \
        RESC(alX); __syncthreads(); } while (0)
    for (int t = 1; t + 1 < NT; t += 2) {
        HALF_STEP(pB0, pB1, mnB, alB, pA0, pA1, alA, t, 1, 0, 0);
        HALF_STEP(pA0, pA1, mnA, alA, pB0, pB1, alB, t + 1, 0, 1, 1);
    }
    const bool even = (NT & 1) == 0;
    if (even) { SWRITE_HV(1); SBAR(); qkt<1, MODE>(pB0, pB1, K_lds, r32, hi, S.qr, qsl, tl + KBASE(NT - 1)); SBAR(); }
    SLOAD_H(nxt.K, nxt.V, nxt.kb0); SBAR();
#pragma unroll
    for (int d0 = 0; d0 < 4; ++d0) S.qr[d0] = ld8(nxt.Q + (size_t)(wid * QBLK + r32) * D + d0 * 16 + hi * 8);
    SBAR();
    finishSM(pA0, pA1, alA, l_reg, pa0, pa1, pa2, pa3); SBAR();
    pv_tile<0>(o, vb0, pa0, pa1, pa2, pa3);
    if (even) { MASKT(pB0, pB1, NT - 1); partialSM(pB0, pB1, m_reg, mnB, alB); __syncthreads(); RESC(alB);
        finishSM(pB0, pB1, alB, l_reg, pa0, pa1, pa2, pa3); SBAR(); pv_tile<1>(o, vb0, pa0, pa1, pa2, pa3); }
    SBAR();
#pragma unroll
    for (int d0 = 4; d0 < 8; ++d0) S.qr[d0] = ld8(nxt.Q + (size_t)(wid * QBLK + r32) * D + d0 * 16 + hi * 8);
    SBAR(); SEAM_K0();
    f32x4 tn0 = {0.f, 0.f, 0.f, 0.f}, tn1 = {0.f, 0.f, 0.f, 0.f};
    if (tid * 4 < nxt.tabn) tn0 = *(const f32x4*)(nxt.tab + tid * 4);
    if (tid * 4 + 2048 < nxt.tabn) tn1 = *(const f32x4*)(nxt.tab + tid * 4 + 2048);
    SBAR();
    if (hi == 0) li_l[r32] = l_reg; asm volatile("s_waitcnt lgkmcnt(0)" ::: "memory");
    float rli[16];
#pragma unroll
    for (int r = 0; r < 16; ++r) rli[r] = __builtin_amdgcn_rcpf(li_l[crow(r, hi)]);
    if (MODE == 0) { bf16* Ow = (bf16*)cur.O + (size_t)(wid * QBLK) * ldo;
#pragma unroll
        for (int r = 0; r < 16; ++r) { const int orow = crow(r, hi);
#pragma unroll
            for (int d0 = 0; d0 < 4; ++d0) { const float v = o[d0][r] * rli[r]; const float vn = __shfl_xor(v, 1);
                if ((r32 & 1) == 0) *(unsigned*)(Ow + (size_t)orow * ldo + d0 * 32 + r32) = cvtpk(v, vn); } } }
    else { bf16* Ow = (bf16*)cur.O + (size_t)(wid * QBLK) * ldo;
#pragma unroll
        for (int r = 0; r < 16; ++r) { const int orow = crow(r, hi);
#pragma unroll
            for (int d0 = 0; d0 < 4; ++d0) { const float v = o[d0][r] * rli[r]; const float vn = __shfl_xor(v, 1);
                if ((r32 & 1) == 0) *(unsigned*)(Ow + (size_t)orow * ldo + d0 * 32 + r32) = cvtpk(v, vn); } } }
    { float* tabN = (float*)(lds + OFF_TAB + (S.tb ^ 1) * 16384);
      if (tid * 4 < nxt.tabn) *(f32x4*)(tabN + tid * 4) = tn0;
      if (tid * 4 + 2048 < nxt.tabn) *(f32x4*)(tabN + tid * 4 + 2048) = tn1; }
    S.tb ^= 1;
    __syncthreads();
#undef RESC
#undef KBASE
#undef MASKT
#undef SEAM_K0
#undef HALF_STEP
}

constexpr int DQR = 4;
constexpr int D_OFF_V1 = OFF_TAB + 2048, D_OFF_Q = D_OFF_V1 + 2 * SHM_V, D_LDS_BYTES = D_OFF_Q + NW * (8 - DQR) * 1024;
constexpr int VHALF_B = 4096 * 128 * 2;
struct DSeam { bf16x8 qr[DQR]; int tb; };
#define DMA16(g, l) __builtin_amdgcn_global_load_lds((const unsigned*)(g), (PG8_LAS unsigned*)(l), 16, 0, 0)
#define D_LANE_OFFS()                                                                                                                  \
    const int grp = wid >> 2, wa_ = wid & 3;                    \
    const int krow_ = 4 * wa_ + (lane >> 4);                                                                                           \
    const unsigned koff = (unsigned)(krow_ * 256 + (((lane & 15) ^ (krow_ & 7)) << 4));                                                \
    const int vs_ = 2 * wa_ + (lane >> 5), vkk_ = (vs_ >> 2) * 8 + ((lane >> 2) & 7), vk_ = (vkk_ & ~0xC) | ((vkk_ & 4) << 1) | ((vkk_ & 8) >> 1); \
    const unsigned voff = (unsigned)(vk_ * 256 + ((vs_ & 3) * 32 + (lane & 3) * 8) * 2);                                               \
    PG8_LAS unsigned char* const kdst = ldsL + 2 * SHM_V + wa_ * 1024; PG8_LAS unsigned char* const vdst0 = ldsL + wa_ * 1024; PG8_LAS unsigned char* const vdst1 = ldsL + D_OFF_V1 + wa_ * 1024
#define DMA_K(Kp, key0, KB_) do { const char* g_ = (const char*)(Kp) + (size_t)(key0) * 256;                                           \
        _Pragma("unroll") for (int j_ = 0; j_ < 4; ++j_) DMA16(g_ + j_ * 4096 + koff, kdst + (KB_) * SHM_K + j_ * 4096); } while (0)
#define DMA_V(Vp, key0, VB_) do { const char* g_ = (const char*)(Vp) + (size_t)(key0) * 256;                                           \
        _Pragma("unroll") for (int j_ = 0; j_ < 4; ++j_) DMA16(g_ + j_ * 4096 + voff, vdst0 + (VB_) * SHM_V + j_ * 4096);                 \
        _Pragma("unroll") for (int j_ = 0; j_ < 4; ++j_) DMA16(g_ + (VHALF_B + j_ * 4096) + voff, vdst1 + (VB_) * SHM_V + j_ * 4096); } while (0)
__device__ __forceinline__ float dpp_xor1(float v) { return __int_as_float(__builtin_amdgcn_mov_dpp(__float_as_int(v), 0xB1, 0xF, 0xF, true)); }
__device__ __forceinline__ float half_sum32(float v) {
    v += __int_as_float(__builtin_amdgcn_mov_dpp(__float_as_int(v), 0xB1, 0xF, 0xF, true));
    v += __int_as_float(__builtin_amdgcn_mov_dpp(__float_as_int(v), 0x4E, 0xF, 0xF, true));
    v += __int_as_float(__builtin_amdgcn_mov_dpp(__float_as_int(v), 0x141, 0xF, 0xF, true));
    v += __int_as_float(__builtin_amdgcn_mov_dpp(__float_as_int(v), 0x140, 0xF, 0xF, true));
    { auto rr = __builtin_amdgcn_permlane16_swap(__float_as_uint(v), __float_as_uint(v), false, false); v = __uint_as_float(rr[0]) + __uint_as_float(rr[1]); }
    return v;
}
__device__ __forceinline__ void dattn_prime(const BlockRef& cur, char* lds, PG8_LAS unsigned char* ldsL, DSeam& S, const int wid_) {
    const int wid = wid_ & 7, lane = pg8::hw_lane(), tid = wid * 64 + lane, r32 = lane & 31, hi = lane >> 5;
    D_LANE_OFFS(); (void)voff; (void)vdst0; (void)vdst1;
    char* qsl = lds + D_OFF_Q + wid * ((8 - DQR) * 1024) + lane * 16;
#pragma unroll
    for (int d0 = 0; d0 < DQR; ++d0) S.qr[d0] = ld8(cur.Q + (size_t)(wid * QBLK + r32) * D + d0 * 16 + hi * 8);
#pragma unroll
    for (int d0 = DQR; d0 < 8; ++d0) { const bf16x8 t = ld8(cur.Q + (size_t)(wid * QBLK + r32) * D + d0 * 16 + hi * 8); *(bf16x8*)(qsl + (d0 - DQR) * 1024) = t; }
    if (grp == 0) DMA_K(cur.K, cur.kb0, 0);
    S.tb = 0; if (tid < 64) *(f32x4*)((float*)(lds + OFF_TAB) + tid * 4) = *(const f32x4*)(cur.tab + tid * 4);
    VMW(); __syncthreads();
    if (grp == 1) __syncthreads();
}
constexpr int D_OFF_CV = D_LDS_BYTES;
constexpr int CV_N = 4096, CV_KBLK = 512;
struct CvState { const float* src; bf16* dst; int next, end, hist; };
#define CV_DMA(h, par) do { const int it_ = (h) >> 1, kh_ = (h) & 1, nbk_ = CV_N >> 6, kb_ = it_ / nbk_, nb_ = it_ - kb_ * nbk_, wv_ = wid & 3;                   \
        const char* g_ = (const char*)(cv.src + (size_t)(64 * kb_ + 32 * kh_ + 8 * wv_) * CV_N + 64 * nb_);                                             \
        const unsigned off_ = (unsigned)(((lane >> 4) * CV_N + 4 * ((lane & 15) ^ (4 * wv_))) * 4);       \
        PG8_LAS unsigned char* l_ = ldsL + D_OFF_CV + (par) * 8192 + wv_ * 2048;                                                                         \
        __builtin_amdgcn_global_load_lds((const unsigned*)(g_ + off_), (PG8_LAS unsigned*)l_, 16, 0, 0);                                                 \
        __builtin_amdgcn_global_load_lds((const unsigned*)(g_ + (size_t)CV_N * 16 + off_), (PG8_LAS unsigned*)(l_ + 1024), 16, 0, 0); } while (0)
#define CV_CONVERT(h, par) do { const int it_ = (h) >> 1, kh_ = (h) & 1, nbk_ = CV_N >> 6, kb_ = it_ / nbk_, nb_ = it_ - kb_ * nbk_, wv_ = wid & 3;               \
        const int nl_ = lane >> 2, kg_ = lane & 3, ch_ = ((16 * wv_ + nl_) >> 2) ^ (4 * kg_);                                                            \
        const float* s_ = (const float*)(lds + D_OFF_CV + (par) * 8192 + kg_ * 2048 + ch_ * 16 + (nl_ & 3) * 4);         \
        float v_[8]; _Pragma("unroll") for (int j_ = 0; j_ < 8; ++j_) v_[j_] = s_[j_ * 64];                                                              \
        u32x4 o_; o_[0] = cvtpk(v_[0], v_[1]); o_[1] = cvtpk(v_[2], v_[3]); o_[2] = cvtpk(v_[4], v_[5]); o_[3] = cvtpk(v_[6], v_[7]);                     \
        *(u32x4*)(cv.dst + ((size_t)(4 * nb_ + wv_) * CV_KBLK + 2 * kb_ + kh_) * 512 + lane * 8) = o_; } while (0)
#define CV_CONVERT_H(h, par, hf) do { const int it_ = (h) >> 1, kh_ = (h) & 1, nbk_ = CV_N >> 6, kb_ = it_ / nbk_, nb_ = it_ - kb_ * nbk_, wv_ = wid & 3;         \
        const int nl_ = lane >> 2, kg_ = lane & 3, ch_ = ((16 * wv_ + nl_) >> 2) ^ (4 * kg_);                                                            \
        const float* s_ = (const float*)(lds + D_OFF_CV + (par) * 8192 + kg_ * 2048 + (hf) * 1024 + ch_ * 16 + (nl_ & 3) * 4);                           \
        float v_[4]; _Pragma("unroll") for (int j_ = 0; j_ < 4; ++j_) v_[j_] = s_[j_ * 64];                                                              \
        typedef unsigned u32x2_ __attribute__((ext_vector_type(2))); u32x2_ o_; o_[0] = cvtpk(v_[0], v_[1]); o_[1] = cvtpk(v_[2], v_[3]);                \
        *(u32x2_*)(cv.dst + ((size_t)(4 * nb_ + wv_) * CV_KBLK + 2 * kb_ + kh_) * 512 + lane * 8 + 4 * (hf)) = o_; } while (0)
__device__ __forceinline__ void cv_finish(CvState& cv, char* lds, PG8_LAS unsigned char* ldsL, const int wid_) {
    const int wid = wid_ & 7, lane = pg8::hw_lane(), grp = wid >> 2;
    if (cv.hist & 4) { const int ha_ = cv.next - ((cv.hist & 1) ? 2 : 1); if (grp == 0) CV_CONVERT_H(ha_, ha_ % 3, 1); }
    if (cv.hist & 1) { const int h_ = cv.next - 1; if (grp == 1) VMW(); __syncthreads(); if (grp == 1) CV_CONVERT(h_, h_ % 3); }
    __syncthreads(); cv.hist = 0;
    while (cv.next < cv.end) { const int h_ = cv.next++; if (grp == 1) { CV_DMA(h_, 0); VMW(); } __syncthreads(); if (grp == 1) CV_CONVERT(h_, 0); __syncthreads(); }
}
__device__ __forceinline__ void dattn_finish(const int wid_) { if (((wid_ & 7) >> 2) == 0) __syncthreads(); }
#define KRD(dst, a, off) asm volatile("ds_read_b128 %0, %1 offset:%2" : "=v"(dst) : "v"(a), "i"(off) : "memory")
#define TRD(dst, a, off) asm volatile("ds_read_b64_tr_b16 %0, %1 offset:%2" : "=v"(dst) : "v"(a), "i"(off) : "memory")
#define LGKW1(n, x) asm volatile("s_waitcnt lgkmcnt(%1)" : "+v"(x) : "i"(n) : "memory")
#define LGKW2(n, x, y) asm volatile("s_waitcnt lgkmcnt(%2)" : "+v"(x), "+v"(y) : "i"(n) : "memory")
#define MFMA(a, b, c) __builtin_amdgcn_mfma_f32_32x32x16_bf16(a, b, c, 0, 0, 0)
#define VCAT(l, h) ((bf16x8){l[0], l[1], l[2], l[3], h[0], h[1], h[2], h[3]})
#define ZERO16 ((f32x16){0.f, 0.f, 0.f, 0.f, 0.f, 0.f, 0.f, 0.f, 0.f, 0.f, 0.f, 0.f, 0.f, 0.f, 0.f, 0.f})
#define DM_QKPV(KB_, VB_) do { \
        KRD(ks0, ka0, (KB_) * SHM_K + 0); \
        KRD(ks1, ka0, (KB_) * SHM_K + 8192); \
        KRD(ks2, ka1, (KB_) * SHM_K + 0); \
        KRD(ks3, ka1, (KB_) * SHM_K + 8192); \
        KRD(ks4, ka2, (KB_) * SHM_K + 0); \
        KRD(ks5, ka2, (KB_) * SHM_K + 8192); \
        KRD(qs0, qa, 0); \
        KRD(qs1, qa, 1024); \
        LGKW1(7, ks0); pX0 = MFMA(ks0, S.qr[0], ZERO16); SBAR(); \
        KRD(ks0, ka3, (KB_) * SHM_K + 0); \
        LGKW1(7, ks1); pX1 = MFMA(ks1, S.qr[0], ZERO16); SBAR(); \
        KRD(ks1, ka3, (KB_) * SHM_K + 8192); \
        LGKW1(7, ks2); pX0 = MFMA(ks2, S.qr[1], pX0); SBAR(); \
        KRD(ks2, ka0, (KB_) * SHM_K + 128); \
        LGKW1(7, ks3); pX1 = MFMA(ks3, S.qr[1], pX1); SBAR(); \
        KRD(ks3, ka0, (KB_) * SHM_K + 8320); \
        LGKW1(7, ks4); pX0 = MFMA(ks4, S.qr[2], pX0); SBAR(); \
        KRD(ks4, ka1, (KB_) * SHM_K + 128); \
        LGKW1(7, ks5); pX1 = MFMA(ks5, S.qr[2], pX1); SBAR(); \
        KRD(ks5, ka1, (KB_) * SHM_K + 8320); \
        LGKW1(5, ks0); pX0 = MFMA(ks0, S.qr[3], pX0); SBAR(); \
        KRD(ks0, ka2, (KB_) * SHM_K + 128); \
        LGKW1(5, ks1); pX1 = MFMA(ks1, S.qr[3], pX1); SBAR(); \
        KRD(ks1, ka2, (KB_) * SHM_K + 8320); \
        LGKW2(5, ks2, qs0); pX0 = MFMA(ks2, qs0, pX0); SBAR(); \
        KRD(ks2, ka3, (KB_) * SHM_K + 128); \
        LGKW2(5, ks3, qs0); pX1 = MFMA(ks3, qs0, pX1); SBAR(); \
        KRD(ks3, ka3, (KB_) * SHM_K + 8320); \
        KRD(qs0, qa, 2048); \
        LGKW2(6, ks4, qs1); pX0 = MFMA(ks4, qs1, pX0); SBAR(); \
        TRD(vl4, vb0, (VB_) * SHM_V + 0); TRD(vh4, vb0, (VB_) * SHM_V + 2048); \
        LGKW2(7, ks5, qs1); pX1 = MFMA(ks5, qs1, pX1); SBAR(); \
        TRD(vl5, vb0, (VB_) * SHM_V + 4096); TRD(vh5, vb0, (VB_) * SHM_V + 6144); \
        KRD(qs1, qa, 3072); \
        LGKW2(5, ks0, qs0); pX0 = MFMA(ks0, qs0, pX0); SBAR(); \
        TRD(vl0, vb0, (VB_) * SHM_V + 8192); TRD(vh0, vb0, (VB_) * SHM_V + 10240); \
        LGKW2(7, ks1, qs0); pX1 = MFMA(ks1, qs0, pX1); SBAR(); \
        TRD(vl1, vb0, (VB_) * SHM_V + 12288); TRD(vh1, vb0, (VB_) * SHM_V + 14336); \
        LGKW2(4, ks2, qs1); pX0 = MFMA(ks2, qs1, pX0); SBAR(); \
        TRD(vl2, vb0, (VB_) * SHM_V + 512); TRD(vh2, vb0, (VB_) * SHM_V + 2560); \
        LGKW2(6, ks3, qs1); pX1 = MFMA(ks3, qs1, pX1); SBAR(); \
        TRD(vl3, vb0, (VB_) * SHM_V + 4608); TRD(vh3, vb0, (VB_) * SHM_V + 6656); \
        LGKW2(11, vl4, vh4); o[0] = MFMA(pa0, VCAT(vl4, vh4), o[0]); SBAR(); \
        TRD(vl4, vb0, (VB_) * SHM_V + 8704); TRD(vh4, vb0, (VB_) * SHM_V + 10752); \
        LGKW2(11, vl5, vh5); o[0] = MFMA(pa1, VCAT(vl5, vh5), o[0]); SBAR(); \
        TRD(vl5, vb0, (VB_) * SHM_V + 12800); TRD(vh5, vb0, (VB_) * SHM_V + 14848); \
        LGKW2(10, vl0, vh0); o[0] = MFMA(pa2, VCAT(vl0, vh0), o[0]); SBAR(); \
        TRD(vl0, vb0, (VB_) * SHM_V + 1024); TRD(vh0, vb0, (VB_) * SHM_V + 3072); \
        LGKW2(10, vl1, vh1); o[0] = MFMA(pa3, VCAT(vl1, vh1), o[0]); SBAR(); \
        TRD(vl1, vb0, (VB_) * SHM_V + 5120); TRD(vh1, vb0, (VB_) * SHM_V + 7168); \
        LGKW2(10, vl2, vh2); o[1] = MFMA(pa0, VCAT(vl2, vh2), o[1]); SBAR(); \
        TRD(vl2, vb0, (VB_) * SHM_V + 9216); TRD(vh2, vb0, (VB_) * SHM_V + 11264); \
        LGKW2(10, vl3, vh3); o[1] = MFMA(pa1, VCAT(vl3, vh3), o[1]); SBAR(); \
        TRD(vl3, vb0, (VB_) * SHM_V + 13312); TRD(vh3, vb0, (VB_) * SHM_V + 15360); \
        LGKW2(10, vl4, vh4); o[1] = MFMA(pa2, VCAT(vl4, vh4), o[1]); SBAR(); \
        TRD(vl4, vb0, (VB_) * SHM_V + 1536); TRD(vh4, vb0, (VB_) * SHM_V + 3584); \
        LGKW2(10, vl5, vh5); o[1] = MFMA(pa3, VCAT(vl5, vh5), o[1]); SBAR(); \
        TRD(vl5, vb0, (VB_) * SHM_V + 5632); TRD(vh5, vb0, (VB_) * SHM_V + 7680); \
        LGKW2(10, vl0, vh0); o[2] = MFMA(pa0, VCAT(vl0, vh0), o[2]); SBAR(); \
        TRD(vl0, vb0, (VB_) * SHM_V + 9728); TRD(vh0, vb0, (VB_) * SHM_V + 11776); \
        LGKW2(10, vl1, vh1); o[2] = MFMA(pa1, VCAT(vl1, vh1), o[2]); SBAR(); \
        TRD(vl1, vb0, (VB_) * SHM_V + 13824); TRD(vh1, vb0, (VB_) * SHM_V + 15872); \
        LGKW2(10, vl2, vh2); o[2] = MFMA(pa2, VCAT(vl2, vh2), o[2]); SBAR(); \
        TRD(vl2, vb1, (VB_) * SHM_V + 0); TRD(vh2, vb1, (VB_) * SHM_V + 2048); \
        LGKW2(10, vl3, vh3); o[2] = MFMA(pa3, VCAT(vl3, vh3), o[2]); SBAR(); \
        TRD(vl3, vb1, (VB_) * SHM_V + 4096); TRD(vh3, vb1, (VB_) * SHM_V + 6144); \
        LGKW2(10, vl4, vh4); o[3] = MFMA(pa0, VCAT(vl4, vh4), o[3]); SBAR(); \
        TRD(vl4, vb1, (VB_) * SHM_V + 8192); TRD(vh4, vb1, (VB_) * SHM_V + 10240); \
        LGKW2(10, vl5, vh5); o[3] = MFMA(pa1, VCAT(vl5, vh5), o[3]); SBAR(); \
        TRD(vl5, vb1, (VB_) * SHM_V + 12288); TRD(vh5, vb1, (VB_) * SHM_V + 14336); \
        LGKW2(10, vl0, vh0); o[3] = MFMA(pa2, VCAT(vl0, vh0), o[3]); SBAR(); \
        TRD(vl0, vb1, (VB_) * SHM_V + 512); TRD(vh0, vb1, (VB_) * SHM_V + 2560); \
        LGKW2(10, vl1, vh1); o[3] = MFMA(pa3, VCAT(vl1, vh1), o[3]); SBAR(); \
        TRD(vl1, vb1, (VB_) * SHM_V + 4608); TRD(vh1, vb1, (VB_) * SHM_V + 6656); \
        LGKW2(10, vl2, vh2); o[4] = MFMA(pa0, VCAT(vl2, vh2), o[4]); SBAR(); \
        TRD(vl2, vb1, (VB_) * SHM_V + 8704); TRD(vh2, vb1, (VB_) * SHM_V + 10752); \
        LGKW2(10, vl3, vh3); o[4] = MFMA(pa1, VCAT(vl3, vh3), o[4]); SBAR(); \
        TRD(vl3, vb1, (VB_) * SHM_V + 12800); TRD(vh3, vb1, (VB_) * SHM_V + 14848); \
        LGKW2(10, vl4, vh4); o[4] = MFMA(pa2, VCAT(vl4, vh4), o[4]); SBAR(); \
        TRD(vl4, vb1, (VB_) * SHM_V + 1024); TRD(vh4, vb1, (VB_) * SHM_V + 3072); \
        LGKW2(10, vl5, vh5); o[4] = MFMA(pa3, VCAT(vl5, vh5), o[4]); SBAR(); \
        TRD(vl5, vb1, (VB_) * SHM_V + 5120); TRD(vh5, vb1, (VB_) * SHM_V + 7168); \
        LGKW2(10, vl0, vh0); o[5] = MFMA(pa0, VCAT(vl0, vh0), o[5]); SBAR(); \
        TRD(vl0, vb1, (VB_) * SHM_V + 9216); TRD(vh0, vb1, (VB_) * SHM_V + 11264); \
        LGKW2(10, vl1, vh1); o[5] = MFMA(pa1, VCAT(vl1, vh1), o[5]); SBAR(); \
        TRD(vl1, vb1, (VB_) * SHM_V + 13312); TRD(vh1, vb1, (VB_) * SHM_V + 15360); \
        LGKW2(10, vl2, vh2); o[5] = MFMA(pa2, VCAT(vl2, vh2), o[5]); SBAR(); \
        TRD(vl2, vb1, (VB_) * SHM_V + 1536); TRD(vh2, vb1, (VB_) * SHM_V + 3584); \
        LGKW2(10, vl3, vh3); o[5] = MFMA(pa3, VCAT(vl3, vh3), o[5]); SBAR(); \
        TRD(vl3, vb1, (VB_) * SHM_V + 5632); TRD(vh3, vb1, (VB_) * SHM_V + 7680); \
        LGKW2(10, vl4, vh4); o[6] = MFMA(pa0, VCAT(vl4, vh4), o[6]); SBAR(); \
        TRD(vl4, vb1, (VB_) * SHM_V + 9728); TRD(vh4, vb1, (VB_) * SHM_V + 11776); \
        LGKW2(10, vl5, vh5); o[6] = MFMA(pa1, VCAT(vl5, vh5), o[6]); SBAR(); \
        TRD(vl5, vb1, (VB_) * SHM_V + 13824); TRD(vh5, vb1, (VB_) * SHM_V + 15872); \
        LGKW2(10, vl0, vh0); o[6] = MFMA(pa2, VCAT(vl0, vh0), o[6]); SBAR(); \
        LGKW2(8, vl1, vh1); o[6] = MFMA(pa3, VCAT(vl1, vh1), o[6]); SBAR(); \
        LGKW2(6, vl2, vh2); o[7] = MFMA(pa0, VCAT(vl2, vh2), o[7]); SBAR(); \
        LGKW2(4, vl3, vh3); o[7] = MFMA(pa1, VCAT(vl3, vh3), o[7]); SBAR(); \
        LGKW2(2, vl4, vh4); o[7] = MFMA(pa2, VCAT(vl4, vh4), o[7]); SBAR(); \
        LGKW2(0, vl5, vh5); o[7] = MFMA(pa3, VCAT(vl5, vh5), o[7]); SBAR(); } while (0)
#define DM_QK(KB_) do { \
        KRD(ks0, ka0, (KB_) * SHM_K + 0); \
        KRD(ks1, ka0, (KB_) * SHM_K + 8192); \
        KRD(ks2, ka1, (KB_) * SHM_K + 0); \
        KRD(ks3, ka1, (KB_) * SHM_K + 8192); \
        KRD(ks4, ka2, (KB_) * SHM_K + 0); \
        KRD(ks5, ka2, (KB_) * SHM_K + 8192); \
        KRD(qs0, qa, 0); \
        KRD(qs1, qa, 1024); \
        LGKW1(7, ks0); pX0 = MFMA(ks0, S.qr[0], ZERO16); SBAR(); \
        KRD(ks0, ka3, (KB_) * SHM_K + 0); \
        LGKW1(7, ks1); pX1 = MFMA(ks1, S.qr[0], ZERO16); SBAR(); \
        KRD(ks1, ka3, (KB_) * SHM_K + 8192); \
        LGKW1(7, ks2); pX0 = MFMA(ks2, S.qr[1], pX0); SBAR(); \
        KRD(ks2, ka0, (KB_) * SHM_K + 128); \
        LGKW1(7, ks3); pX1 = MFMA(ks3, S.qr[1], pX1); SBAR(); \
        KRD(ks3, ka0, (KB_) * SHM_K + 8320); \
        LGKW1(7, ks4); pX0 = MFMA(ks4, S.qr[2], pX0); SBAR(); \
        KRD(ks4, ka1, (KB_) * SHM_K + 128); \
        LGKW1(7, ks5); pX1 = MFMA(ks5, S.qr[2], pX1); SBAR(); \
        KRD(ks5, ka1, (KB_) * SHM_K + 8320); \
        LGKW1(5, ks0); pX0 = MFMA(ks0, S.qr[3], pX0); SBAR(); \
        KRD(ks0, ka2, (KB_) * SHM_K + 128); \
        LGKW1(5, ks1); pX1 = MFMA(ks1, S.qr[3], pX1); SBAR(); \
        KRD(ks1, ka2, (KB_) * SHM_K + 8320); \
        LGKW2(5, ks2, qs0); pX0 = MFMA(ks2, qs0, pX0); SBAR(); \
        KRD(ks2, ka3, (KB_) * SHM_K + 128); \
        LGKW2(5, ks3, qs0); pX1 = MFMA(ks3, qs0, pX1); SBAR(); \
        KRD(ks3, ka3, (KB_) * SHM_K + 8320); \
        KRD(qs0, qa, 2048); \
        LGKW2(6, ks4, qs1); pX0 = MFMA(ks4, qs1, pX0); SBAR(); \
        LGKW2(5, ks5, qs1); pX1 = MFMA(ks5, qs1, pX1); SBAR(); \
        KRD(qs1, qa, 3072); \
        LGKW2(1, ks0, qs0); pX0 = MFMA(ks0, qs0, pX0); SBAR(); \
        LGKW2(1, ks1, qs0); pX1 = MFMA(ks1, qs0, pX1); SBAR(); \
        LGKW2(0, ks2, qs1); pX0 = MFMA(ks2, qs1, pX0); SBAR(); \
        LGKW2(0, ks3, qs1); pX1 = MFMA(ks3, qs1, pX1); SBAR(); } while (0)
#define DM_PV(VB_) do { \
        TRD(vl0, vb0, (VB_) * SHM_V + 0); TRD(vh0, vb0, (VB_) * SHM_V + 2048); \
        TRD(vl1, vb0, (VB_) * SHM_V + 4096); TRD(vh1, vb0, (VB_) * SHM_V + 6144); \
        TRD(vl2, vb0, (VB_) * SHM_V + 8192); TRD(vh2, vb0, (VB_) * SHM_V + 10240); \
        TRD(vl3, vb0, (VB_) * SHM_V + 12288); TRD(vh3, vb0, (VB_) * SHM_V + 14336); \
        TRD(vl4, vb0, (VB_) * SHM_V + 512); TRD(vh4, vb0, (VB_) * SHM_V + 2560); \
        TRD(vl5, vb0, (VB_) * SHM_V + 4608); TRD(vh5, vb0, (VB_) * SHM_V + 6656); \
        LGKW2(10, vl0, vh0); o[0] = MFMA(pa0, VCAT(vl0, vh0), o[0]); SBAR(); \
        TRD(vl0, vb0, (VB_) * SHM_V + 8704); TRD(vh0, vb0, (VB_) * SHM_V + 10752); \
        LGKW2(10, vl1, vh1); o[0] = MFMA(pa1, VCAT(vl1, vh1), o[0]); SBAR(); \
        TRD(vl1, vb0, (VB_) * SHM_V + 12800); TRD(vh1, vb0, (VB_) * SHM_V + 14848); \
        LGKW2(10, vl2, vh2); o[0] = MFMA(pa2, VCAT(vl2, vh2), o[0]); SBAR(); \
        TRD(vl2, vb0, (VB_) * SHM_V + 1024); TRD(vh2, vb0, (VB_) * SHM_V + 3072); \
        LGKW2(10, vl3, vh3); o[0] = MFMA(pa3, VCAT(vl3, vh3), o[0]); SBAR(); \
        TRD(vl3, vb0, (VB_) * SHM_V + 5120); TRD(vh3, vb0, (VB_) * SHM_V + 7168); \
        LGKW2(10, vl4, vh4); o[1] = MFMA(pa0, VCAT(vl4, vh4), o[1]); SBAR(); \
        TRD(vl4, vb0, (VB_) * SHM_V + 9216); TRD(vh4, vb0, (VB_) * SHM_V + 11264); \
        LGKW2(10, vl5, vh5); o[1] = MFMA(pa1, VCAT(vl5, vh5), o[1]); SBAR(); \
        TRD(vl5, vb0, (VB_) * SHM_V + 13312); TRD(vh5, vb0, (VB_) * SHM_V + 15360); \
        LGKW2(10, vl0, vh0); o[1] = MFMA(pa2, VCAT(vl0, vh0), o[1]); SBAR(); \
        TRD(vl0, vb0, (VB_) * SHM_V + 1536); TRD(vh0, vb0, (VB_) * SHM_V + 3584); \
        LGKW2(10, vl1, vh1); o[1] = MFMA(pa3, VCAT(vl1, vh1), o[1]); SBAR(); \
        TRD(vl1, vb0, (VB_) * SHM_V + 5632); TRD(vh1, vb0, (VB_) * SHM_V + 7680); \
        LGKW2(10, vl2, vh2); o[2] = MFMA(pa0, VCAT(vl2, vh2), o[2]); SBAR(); \
        TRD(vl2, vb0, (VB_) * SHM_V + 9728); TRD(vh2, vb0, (VB_) * SHM_V + 11776); \
        LGKW2(10, vl3, vh3); o[2] = MFMA(pa1, VCAT(vl3, vh3), o[2]); SBAR(); \
        TRD(vl3, vb0, (VB_) * SHM_V + 13824); TRD(vh3, vb0, (VB_) * SHM_V + 15872); \
        LGKW2(10, vl4, vh4); o[2] = MFMA(pa2, VCAT(vl4, vh4), o[2]); SBAR(); \
        TRD(vl4, vb1, (VB_) * SHM_V + 0); TRD(vh4, vb1, (VB_) * SHM_V + 2048); \
        LGKW2(10, vl5, vh5); o[2] = MFMA(pa3, VCAT(vl5, vh5), o[2]); SBAR(); \
        TRD(vl5, vb1, (VB_) * SHM_V + 4096); TRD(vh5, vb1, (VB_) * SHM_V + 6144); \
        LGKW2(10, vl0, vh0); o[3] = MFMA(pa0, VCAT(vl0, vh0), o[3]); SBAR(); \
        TRD(vl0, vb1, (VB_) * SHM_V + 8192); TRD(vh0, vb1, (VB_) * SHM_V + 10240); \
        LGKW2(10, vl1, vh1); o[3] = MFMA(pa1, VCAT(vl1, vh1), o[3]); SBAR(); \
        TRD(vl1, vb1, (VB_) * SHM_V + 12288); TRD(vh1, vb1, (VB_) * SHM_V + 14336); \
        LGKW2(10, vl2, vh2); o[3] = MFMA(pa2, VCAT(vl2, vh2), o[3]); SBAR(); \
        TRD(vl2, vb1, (VB_) * SHM_V + 512); TRD(vh2, vb1, (VB_) * SHM_V + 2560); \
        LGKW2(10, vl3, vh3); o[3] = MFMA(pa3, VCAT(vl3, vh3), o[3]); SBAR(); \
        TRD(vl3, vb1, (VB_) * SHM_V + 4608); TRD(vh3, vb1, (VB_) * SHM_V + 6656); \
        LGKW2(10, vl4, vh4); o[4] = MFMA(pa0, VCAT(vl4, vh4), o[4]); SBAR(); \
        TRD(vl4, vb1, (VB_) * SHM_V + 8704); TRD(vh4, vb1, (VB_) * SHM_V + 10752); \
        LGKW2(10, vl5, vh5); o[4] = MFMA(pa1, VCAT(vl5, vh5), o[4]); SBAR(); \
        TRD(vl5, vb1, (VB_) * SHM_V + 12800); TRD(vh5, vb1, (VB_) * SHM_V + 14848); \
        LGKW2(10, vl0, vh0); o[4] = MFMA(pa2, VCAT(vl0, vh0), o[4]); SBAR(); \
        TRD(vl0, vb1, (VB_) * SHM_V + 1024); TRD(vh0, vb1, (VB_) * SHM_V + 3072); \
        LGKW2(10, vl1, vh1); o[4] = MFMA(pa3, VCAT(vl1, vh1), o[4]); SBAR(); \
        TRD(vl1, vb1, (VB_) * SHM_V + 5120); TRD(vh1, vb1, (VB_) * SHM_V + 7168); \
        LGKW2(10, vl2, vh2); o[5] = MFMA(pa0, VCAT(vl2, vh2), o[5]); SBAR(); \
        TRD(vl2, vb1, (VB_) * SHM_V + 9216); TRD(vh2, vb1, (VB_) * SHM_V + 11264); \
        LGKW2(10, vl3, vh3); o[5] = MFMA(pa1, VCAT(vl3, vh3), o[5]); SBAR(); \
        TRD(vl3, vb1, (VB_) * SHM_V + 13312); TRD(vh3, vb1, (VB_) * SHM_V + 15360); \
        LGKW2(10, vl4, vh4); o[5] = MFMA(pa2, VCAT(vl4, vh4), o[5]); SBAR(); \
        TRD(vl4, vb1, (VB_) * SHM_V + 1536); TRD(vh4, vb1, (VB_) * SHM_V + 3584); \
        LGKW2(10, vl5, vh5); o[5] = MFMA(pa3, VCAT(vl5, vh5), o[5]); SBAR(); \
        TRD(vl5, vb1, (VB_) * SHM_V + 5632); TRD(vh5, vb1, (VB_) * SHM_V + 7680); \
        LGKW2(10, vl0, vh0); o[6] = MFMA(pa0, VCAT(vl0, vh0), o[6]); SBAR(); \
        TRD(vl0, vb1, (VB_) * SHM_V + 9728); TRD(vh0, vb1, (VB_) * SHM_V + 11776); \
        LGKW2(10, vl1, vh1); o[6] = MFMA(pa1, VCAT(vl1, vh1), o[6]); SBAR(); \
        TRD(vl1, vb1, (VB_) * SHM_V + 13824); TRD(vh1, vb1, (VB_) * SHM_V + 15872); \
        LGKW2(10, vl2, vh2); o[6] = MFMA(pa2, VCAT(vl2, vh2), o[6]); SBAR(); \
        LGKW2(8, vl3, vh3); o[6] = MFMA(pa3, VCAT(vl3, vh3), o[6]); SBAR(); \
        LGKW2(6, vl4, vh4); o[7] = MFMA(pa0, VCAT(vl4, vh4), o[7]); SBAR(); \
        LGKW2(4, vl5, vh5); o[7] = MFMA(pa1, VCAT(vl5, vh5), o[7]); SBAR(); \
        LGKW2(2, vl0, vh0); o[7] = MFMA(pa2, VCAT(vl0, vh0), o[7]); SBAR(); \
        LGKW2(0, vl1, vh1); o[7] = MFMA(pa3, VCAT(vl1, vh1), o[7]); SBAR(); } while (0)
__device__ __forceinline__ void dattn_block(const BlockRef& cur, const BlockRef& nxt, char* lds, PG8_LAS unsigned char* ldsL, DSeam& S, CvState& cv, const int wid_) {
    const int wid = wid_ & 7, lane = pg8::hw_lane(), tid = wid * 64 + lane, r32 = lane & 31, hi = lane >> 5;
    constexpr int ldo = 2048;
    const int NT = cur.P0 / KVBLK + 4;
    const int qlo = cur.P0 + wid * QBLK, row = qlo + r32, qlo_m = qlo | 63, qm = (row | 63) - 4 * hi;
    char* K_lds = lds + 2 * SHM_V;
    float* ws = (float*)(lds + OFF_SCR) + wid * 64; float* li_l = ws, * al_l = ws + 32;
    const float* tl = (const float*)(lds + OFF_TAB + S.tb * 1024) + (192 + 4 * hi - row);
    const char* qsl = lds + D_OFF_Q + wid * ((8 - DQR) * 1024) + lane * 16;
    D_LANE_OFFS();
    float m_reg = -1e30f, l_reg = 0; f32x16 o[8] = {};
    const int vb0 = (int)(uintptr_t)lds + v_rd_base(lane), vb1 = vb0 + D_OFF_V1;
    const bf16* Kh = cur.K; const bf16* Vh = cur.V;
    f32x16 pX0, pX1; bf16x8 pa0, pa1, pa2, pa3;
    bf16x8 ks0, ks1, ks2, ks3, ks4, ks5, qs0, qs1; s16x4 vl0, vl1, vl2, vl3, vl4, vl5, vh0, vh1, vh2, vh3, vh4, vh5;
    const int ka0 = (int)(uintptr_t)K_lds + KSWZ(r32, (0 * 16 + hi * 8) * 2), ka1 = (int)(uintptr_t)K_lds + KSWZ(r32, (1 * 16 + hi * 8) * 2), ka2 = (int)(uintptr_t)K_lds + KSWZ(r32, (2 * 16 + hi * 8) * 2), ka3 = (int)(uintptr_t)K_lds + KSWZ(r32, (3 * 16 + hi * 8) * 2);
    const int qa = (int)(uintptr_t)qsl;
#define RESC(a) do { if (__any((a) < 1.f)) { if (hi == 0) al_l[r32] = (a); asm volatile("s_waitcnt lgkmcnt(0)" ::: "memory");              \
                     for (int d_ = 0; d_ < 8; ++d_) for (int r = 0; r < 16; ++r) o[d_][r] *= al_l[crow(r, hi)]; } } while (0)
#define DSOFT(t) do { const int kb_ = (t) * KVBLK;                                                                           \
        if (kb_ >= qlo - 153 && kb_ <= qlo_m) diff_bias(pX0, pX1, tl, kb_);                                                  \
        if (kb_ + KVBLK - 1 > qlo_m) mask_tile(pX0, pX1, qm - kb_);                                                          \
        float mn_, al_; partialSM(pX0, pX1, m_reg, mn_, al_); RESC(al_); finishSM(pX0, pX1, al_, l_reg, pa0, pa1, pa2, pa3); } while (0)
#define DSTEP(t, KB) do {                                                                                                     \
        const bool cvi_ = cv.next < cv.end, cvl_ = (cv.hist & 1) != 0, cva_ = (cv.hist & 4) != 0; const int cvh_ = cv.next;     \
        if (grp == 0) { if ((t) + 1 < NT) DMA_K(Kh, ((t) + 1) * KVBLK, (KB) ^ 1);                                             \
                        DMA_V(Vh, (t) * KVBLK, KB); }                                                                         \
        else if (cvi_) CV_DMA(cvh_, cvh_ % 3);                                                                                \
        SBAR(); DM_QKPV(KB, (KB) ^ 1);                                                                                        \
        SBAR(); if (grp == 1 && cvl_) { const int n_ = ((cv.hist >> 1) & 1) + (cvi_ ? 2 : 0);     \
                    if (n_ == 3) VMWN(3); else if (n_ == 2) VMWN(2); else if (n_ == 1) VMWN(1); else VMW(); }                 \
        asm volatile("s_waitcnt lgkmcnt(0)" ::: "memory"); __builtin_amdgcn_s_barrier(); SBAR();                              \
        DSOFT(t);                                                                                                             \
        if (grp == 1 && cvl_) CV_CONVERT_H(cvh_ - 1, (cvh_ - 1) % 3, 0);                                                    \
        if (grp == 0 && cva_) { const int ha_ = cvh_ - (cvl_ ? 2 : 1); CV_CONVERT_H(ha_, ha_ % 3, 1); }                     \
        cv.hist = (cvi_ ? 1 : 0) | (cvl_ ? 2 : 0) | (cvl_ ? 4 : 0); if (cvi_) ++cv.next;                                      \
        if (grp == 0) { if (cva_) VMWN(1); else VMW(); }                            \
        __syncthreads(); } while (0)
    if (grp == 0) { DMA_K(Kh, KVBLK, 1); DMA_V(Vh, 0, 0); }
    SBAR(); DM_QK(0);
    SBAR(); asm volatile("s_waitcnt lgkmcnt(0)" ::: "memory"); __builtin_amdgcn_s_barrier(); SBAR();
    DSOFT(0);
    if (grp == 0) VMW();
    __syncthreads();
    for (int t = 1; t < NT; t += 2) {
        DSTEP(t, 1);
        if (t + 1 < NT) DSTEP(t + 1, 0);
    }
    if (grp == 0) DMA_K(nxt.K, nxt.kb0, 0);
    { const char* qg_ = (const char*)(nxt.Q + (size_t)(wid * QBLK + r32) * D + hi * 8);
      PG8_LAS unsigned char* const qd_ = ldsL + D_OFF_Q + wid * ((8 - DQR) * 1024);
#pragma unroll
      for (int d0 = DQR; d0 < 8; ++d0) DMA16(qg_ + d0 * 32, qd_ + (d0 - DQR) * 1024); }
    f32x4 tn0 = {0.f, 0.f, 0.f, 0.f}; if (wid == 0) tn0 = *(const f32x4*)(nxt.tab + lane * 4);
    SBAR();
    DM_PV(1);
    SBAR();
    if (hi == 0) li_l[r32] = l_reg; asm volatile("s_waitcnt lgkmcnt(0)" ::: "memory");
    { unsigned* sw = (unsigned*)cur.scr + (size_t)wid * 4096 + lane * 4;
      float rl[16];
#pragma unroll
      for (int r = 0; r < 16; ++r) rl[r] = __builtin_amdgcn_rcpf(li_l[crow(r, hi)]);
      if (cur.c == 0) {
#pragma unroll
        for (int d0 = 0; d0 < 8; ++d0) {
#pragma unroll
            for (int h = 0; h < 2; ++h) { u32x4 w;
#pragma unroll
                for (int j = 0; j < 4; ++j) w[j] = cvtpk(o[d0][8 * h + 2 * j] * rl[8 * h + 2 * j], o[d0][8 * h + 2 * j + 1] * rl[8 * h + 2 * j + 1]);
                *(u32x4*)(sw + (d0 * 2 + h) * 256) = w; }
            asm volatile("" ::: "memory"); }
      } else {
        float ssq[16];
#pragma unroll
        for (int r = 0; r < 16; ++r) ssq[r] = 0.f;
        const float lam = cur.lam;
#define O0V(w_, j_) (((j_) & 1) ? __uint_as_float((w_)[(j_) >> 1] & 0xffff0000u) : __uint_as_float((w_)[(j_) >> 1] << 16))
#pragma unroll
        for (int d0 = 0; d0 < 8; d0 += 4) {
            u32x4 a[8];
#pragma unroll
            for (int i = 0; i < 8; ++i) a[i] = *(const u32x4*)(sw + (d0 * 2 + i) * 256);
#pragma unroll
            for (int i = 0; i < 8; ++i)
#pragma unroll
                for (int j = 0; j < 8; ++j) { const int r = 8 * (i & 1) + j; const float d = O0V(a[i], j) - lam * (o[d0 + (i >> 1)][r] * rl[r]); ssq[r] += d * d; }
            asm volatile("" ::: "memory"); }
#pragma unroll
        for (int r = 0; r < 16; ++r) ssq[r] = 0.8f * __builtin_amdgcn_rsqf(half_sum32(ssq[r]) * (1.0f / 256.0f) + 1e-5f);
        bf16* Ow = (bf16*)cur.O + (size_t)(wid * QBLK) * 4096 + r32;
        float gg[8];
#pragma unroll
        for (int d0 = 0; d0 < 8; ++d0) gg[d0] = cur.gs[d0 * 32 + r32];
#pragma unroll
        for (int h = 0; h < 2; ++h) {
            u32x4 a[8];
#pragma unroll
            for (int d0 = 0; d0 < 8; ++d0) a[d0] = *(const u32x4*)(sw + (d0 * 2 + h) * 256);
#pragma unroll
            for (int j = 0; j < 8; ++j) { const int r = 8 * h + j;
#pragma unroll
                for (int d0 = 0; d0 < 8; ++d0) { const float v = (O0V(a[d0], j) - lam * (o[d0][r] * rl[r])) * (ssq[r] * gg[d0]); const float vn = dpp_xor1(v);
                    if ((r32 & 1) == 0) *(unsigned*)(Ow + (size_t)crow(r, hi) * 4096 + d0 * 32) = cvtpk(v, vn); } }
            asm volatile("" ::: "memory"); }
#undef O0V
      } }
    if (wid == 0) { const int l2_ = pg8::hw_lane(); *(f32x4*)((float*)(lds + OFF_TAB + (S.tb ^ 1) * 1024) + l2_ * 4) = tn0; }
    S.tb ^= 1;
#pragma unroll
    for (int d0 = 0; d0 < DQR; ++d0) S.qr[d0] = ld8(nxt.Q + (size_t)(wid * QBLK + r32) * D + d0 * 16 + hi * 8);
    VMW(); __syncthreads();
#undef RESC
#undef DSOFT
#undef DSTEP
}
#undef DM_QKPV
#undef DM_QK
#undef DM_PV
#undef KRD
#undef TRD
#undef LGKW1
#undef LGKW2
#undef MFMA
#undef VCAT
#undef ZERO16
#undef DMA16
#undef D_LANE_OFFS
#undef DMA_K
#undef DMA_V
#undef ROW
#undef VMW
#undef VMWN
#undef SLOAD_H
#undef SWRITE_HK
#undef SWRITE_HV
#undef SWRITE_H
}

constexpr int NWAVES = 8;
constexpr int BATCH = 4, SEQ = 4096, DM = 4096, TOK = BATCH * SEQ;
constexpr int NQKV = 12288, INW = 12304, FOFF = 6144;
constexpr int NMEM = 256, MROWS = BATCH * NMEM, DFF = 16384;
constexpr int MHALF = TOK / 2;
constexpr float NORM_EPS = 1e-6f, SUBLN_EPS = 1e-5f;
constexpr int N_PHASES = 11;
constexpr int CV_ITEMS = 64;

constexpr size_t MiB = 1u << 20;
constexpr size_t WS_CTL = 0, CTL_ZERO_BYTES = 1 * MiB;
constexpr size_t WS_WUP = 1 * MiB;
constexpr size_t WS_WDN = WS_WUP + (size_t)DFF * DM * 2;
constexpr size_t WS_WIN = WS_WDN + (size_t)DM * DFF * 2;
constexpr size_t WS_WOUT = WS_WIN + (size_t)NQKV * DM * 2;
constexpr size_t WS_WKV = WS_WOUT + (size_t)DM * DM * 2;
constexpr size_t WS_W2 = WS_WKV + (size_t)2 * DM * DM * 2;
constexpr size_t WS_U = WS_WIN;
constexpr size_t WS_XB = WS_W2 + (size_t)DM * 2 * DM * 2;
constexpr size_t WS_QKV = WS_XB + (size_t)TOK * DM * 2;
constexpr size_t WS_HB = WS_QKV;
constexpr size_t WS_U2 = WS_HB + (size_t)TOK * DM * 2;
constexpr size_t WS_MB = WS_QKV + (size_t)TOK * NQKV * 2;
constexpr size_t WS_KVM = WS_MB + (size_t)MROWS * DM * 2;
constexpr size_t WS_C2 = WS_KVM + (size_t)MROWS * 2 * DM * 2;
constexpr size_t WS_RX = WS_C2 + (size_t)8192 * DM * 2;
constexpr size_t WS_LOGF = WS_RX + (size_t)TOK * 4;
constexpr size_t WS_NCS = WS_LOGF + (size_t)TOK * 16 * 4;
constexpr size_t WS_DTAB = WS_NCS + (size_t)64 * 4096 * 4;
constexpr size_t WS_PART1 = WS_DTAB + 8192;
constexpr size_t WS_PART2 = WS_PART1 + (size_t)TOK * 64 * 4;
constexpr size_t WS_PART3 = WS_PART2 + (size_t)TOK * 64 * 4;
constexpr size_t WS_XB0 = WS_PART3 + (size_t)TOK * 64 * 4;
constexpr size_t WS_END = WS_XB0 + (size_t)TOK * DM * 2;
static_assert(WS_U + (size_t)MHALF * DFF * 2 <= WS_XB, "U half overlays the dead weight copies");
static_assert(WS_U2 + (size_t)MHALF * DFF * 2 <= WS_MB, "h and the second U half overlay QKV");
constexpr int CW_BAR = 4096;
constexpr int CW_KN = 16384;

constexpr int RING_OFF = 0, RING_BYTES = 131072, TSCR_BYTES = 64 * 65 * 4;
constexpr int LDS_BYTES = 163840;
constexpr int LDSCTL_OFF = LDS_BYTES - 2048, MISC_OFF = LDSCTL_OFF + 320, RTAB_OFF = LDSCTL_OFF + 1024;
static_assert(att::LDS_BYTES <= LDSCTL_OFF && att::D_OFF_CV + 24576 <= LDSCTL_OFF, "attention scratch below the LDS control words");

#define GAS __attribute__((address_space(1)))
#define LAS __attribute__((address_space(3)))
typedef unsigned short bf16;
typedef unsigned v4u __attribute__((ext_vector_type(4)));
typedef unsigned v2u __attribute__((ext_vector_type(2)));
typedef float f32x4 __attribute__((ext_vector_type(4)));
#define LDS_WAIT() asm volatile("s_waitcnt lgkmcnt(0)" ::: "memory")
#define VM_WAIT() asm volatile("s_waitcnt vmcnt(0)" ::: "memory")
__device__ __forceinline__ unsigned f2bf(float f) { unsigned u = __builtin_bit_cast(unsigned, f); return (u + 0x7fffu + ((u >> 16) & 1u)) >> 16; }
__device__ __forceinline__ unsigned pk2(float lo, float hi) { return f2bf(lo) | (f2bf(hi) << 16); }

#define XB_TMO      128
#define XB_XCNT(j)  (256  + 64 * (j))
#define XB_XSUB(j)  (1280 + 64 * (j))
#define XB_XGEN(j)  (2304 + 64 * (j))
#define XB_TOP      3328
#define XB_TOPGEN   3392
#define XCD_BAR_WORDS 3456
#define XB_SPIN_CAP (1u << 18)
__device__ __forceinline__ unsigned xb_ld(unsigned* p)              { return __hip_atomic_load(p, __ATOMIC_RELAXED, __HIP_MEMORY_SCOPE_AGENT); }
__device__ __forceinline__ unsigned xb_add(unsigned* p, unsigned v) { return __hip_atomic_fetch_add(p, v, __ATOMIC_RELAXED, __HIP_MEMORY_SCOPE_AGENT); }
__device__ __forceinline__ unsigned xb_xcc_id() { return (unsigned)__builtin_amdgcn_s_getreg((3 << 11) | 20) & 0xFu; }
#define XB_SPIN(cond, bar) do { unsigned _sp = 0; while (cond) { __builtin_amdgcn_s_sleep(1); \
    if ((++_sp & 255u) == 0u) { if (xb_ld(&(bar)[XB_TMO])) break; if (_sp > XB_SPIN_CAP) { atomicAdd(&(bar)[XB_TMO], 1u); break; } } } } while (0)
struct XcdBarrier { unsigned* bar; unsigned x; volatile LAS unsigned* st; };
__device__ __forceinline__ XcdBarrier xcd_barrier_post(unsigned* bar, volatile LAS unsigned* st, const int tid) {
    XcdBarrier b; b.bar = bar; b.x = xb_xcc_id(); b.st = st;
    if (tid == 0) (void)xb_add(&bar[XB_XCNT(b.x)], 1u);
    return b;
}
__device__ __forceinline__ void xcd_barrier_complete(unsigned* bar, unsigned x, unsigned& nloc, unsigned& nx) {
    const unsigned G = gridDim.x * gridDim.y * gridDim.z;
    unsigned sum, cnt, mine, sp = 0u;
    for (;;) {
        sum = 0u; cnt = 0u; mine = 0u;
#pragma unroll
        for (unsigned j = 0; j < 16; ++j) { const unsigned c = xb_ld(&bar[XB_XCNT(j)]); sum += c; cnt += (c > 0u) ? 1u : 0u; mine = (j == x) ? c : mine; }
        if (sum == G) break;
        __builtin_amdgcn_s_sleep(1);
        if ((++sp & 255u) == 0u) { if (xb_ld(&bar[XB_TMO])) break; if (sp > XB_SPIN_CAP) { atomicAdd(&bar[XB_TMO], 1u); break; } }
    }
    nloc = mine > 0u ? mine : 1u; nx = cnt > 0u ? cnt : 1u;
}
__device__ __forceinline__ void xcd_barrier(const XcdBarrier& b, const int tid) {
    asm volatile("s_waitcnt vmcnt(0)" ::: "memory");
    __syncthreads();
    if (tid == 0) {
        unsigned* bar = b.bar;
        __builtin_amdgcn_s_waitcnt(0);
        unsigned nloc = b.st[0], nx = b.st[1];
        if (nloc == 0u) { xcd_barrier_complete(bar, b.x, nloc, nx); b.st[0] = nloc; b.st[1] = nx; }
        const unsigned old = xb_add(&bar[XB_XSUB(b.x)], 1u);
        const unsigned gen = old / nloc;
        if (old + 1u == (gen + 1u) * nloc) {
            __builtin_amdgcn_fence(__ATOMIC_RELEASE, "agent");
            asm volatile("s_waitcnt vmcnt(0)" ::: "memory");
            const unsigned og = xb_add(&bar[XB_TOP], 1u);
            const unsigned tg = og / nx;
            if (og + 1u == (tg + 1u) * nx) xb_add(&bar[XB_TOPGEN], 1u);
            else XB_SPIN(xb_ld(&bar[XB_TOPGEN]) == tg, bar);
            __builtin_amdgcn_fence(__ATOMIC_ACQUIRE, "agent");
            xb_add(&bar[XB_XGEN(b.x)], 1u);
            asm volatile("s_waitcnt vmcnt(0)" ::: "memory");
        } else {
            XB_SPIN(xb_ld(&bar[XB_XGEN(b.x)]) == gen, bar);
            __builtin_amdgcn_fence(__ATOMIC_ACQUIRE, "agent");
            asm volatile("s_waitcnt vmcnt(0)" ::: "memory");
        }
    }
    __syncthreads();
}

struct Frame {
    LAS unsigned char* lds;
    volatile LAS unsigned* MISC;
    unsigned* ctl;
    int wave;
    int vcu, G;
};
__device__ __forceinline__ float wave_sum(float v) {
#pragma unroll
    for (int o = 1; o < 64; o <<= 1) v += __shfl_xor(v, o);
    return v;
}
__device__ __forceinline__ void transpose_item(const float* W, int ldw, int k0, int n_src0, bf16* WT, int ldo, int n_dst0, LAS float* scr, int lane, const float* kscale = nullptr) {
    f32x4 v[8];
#pragma unroll
    for (int i = 0; i < 8; ++i) v[i] = *(const f32x4*)(W + (size_t)(k0 + 8 * i + (lane >> 3)) * ldw + n_src0 + 4 * (lane & 7));
    if (kscale) {
#pragma unroll
        for (int i = 0; i < 8; ++i) v[i] = v[i] * kscale[k0 + 8 * i + (lane >> 3)]; }
#pragma unroll
    for (int i = 0; i < 8; ++i) { LAS float* d = scr + (8 * i + (lane >> 3)) * 33 + 4 * (lane & 7); d[0] = v[i][0]; d[1] = v[i][1]; d[2] = v[i][2]; d[3] = v[i][3]; }
    LDS_WAIT(); asm volatile("" ::: "memory");
    const int c = lane & 7;
#pragma unroll
    for (int j = 0; j < 4; ++j) { const int n = (lane >> 3) + 8 * j; const LAS float* s = scr + (8 * c) * 33 + n;
        v4u o; o.x = pk2(s[0 * 33], s[1 * 33]); o.y = pk2(s[2 * 33], s[3 * 33]); o.z = pk2(s[4 * 33], s[5 * 33]); o.w = pk2(s[6 * 33], s[7 * 33]);
        *(GAS v4u*)(WT + (size_t)(n_dst0 + n) * ldo + k0 + 8 * c) = o; }
    LDS_WAIT(); asm volatile("" ::: "memory");
}
struct TItem { const float* src; bf16* dst; const float* ks; int ldw, ldo, kblk; };
__device__ __forceinline__ void titem_load(const TItem& t, f32x4 (&v)[16], float (&kv)[16], int lane) {
#pragma unroll
    for (int i = 0; i < 16; ++i) v[i] = __builtin_nontemporal_load((const f32x4*)(t.src + (size_t)(4 * i + (lane >> 4)) * t.ldw + 4 * (lane & 15)));
#pragma unroll
    for (int i = 0; i < 16; ++i) kv[i] = t.ks ? t.ks[4 * i + (lane >> 4)] : 1.0f;
}
__device__ __forceinline__ void titem_store(const TItem& t, const f32x4 (&v)[16], const float (&kv)[16], LAS float* scr, int lane) {
#pragma unroll
    for (int i = 0; i < 16; ++i) { LAS float* d = scr + (4 * i + (lane >> 4)) * 65 + 4 * (lane & 15); d[0] = v[i][0] * kv[i]; d[1] = v[i][1] * kv[i]; d[2] = v[i][2] * kv[i]; d[3] = v[i][3] * kv[i]; }
    LDS_WAIT(); asm volatile("" ::: "memory");
    const int c = lane & 7;
#pragma unroll
    for (int j = 0; j < 8; ++j) { const int n = (lane >> 3) + 8 * j; const LAS float* s = scr + (8 * c) * 65 + n;
        v4u o; o.x = pk2(s[0 * 65], s[1 * 65]); o.y = pk2(s[2 * 65], s[3 * 65]); o.z = pk2(s[4 * 65], s[5 * 65]); o.w = pk2(s[6 * 65], s[7 * 65]);
        if (t.kblk) *(GAS v4u*)(t.dst + ((size_t)(n >> 4) * t.kblk + (c >> 2)) * 512 + (n & 15) * 32 + 8 * (c & 3)) = o;
        else *(GAS v4u*)(t.dst + (size_t)n * t.ldo + 8 * c) = o; }
    LDS_WAIT(); asm volatile("" ::: "memory");
}
__device__ __forceinline__ TItem titem_mat(const float* W, int N, bf16* WT, int ldo, int coff, int item, const float* kscale) {
    const int nblk = N / 64, kb = item / nblk, nb = item % nblk; TItem t;
    t.src = W + (size_t)(64 * kb) * N + 64 * nb; t.dst = WT + coff + (size_t)(64 * nb) * ldo + 64 * kb; t.ks = kscale ? kscale + 64 * kb : nullptr; t.ldw = N; t.ldo = ldo; t.kblk = 0; return t;
}
__device__ __forceinline__ TItem titem_blk(const float* W, int K, int N, bf16* WT, int item, const float* kscale) {
    const int nblk = N / 64, kb = item / nblk, nb = item % nblk; TItem t;
    t.src = W + (size_t)(64 * kb) * N + 64 * nb; t.dst = WT + ((size_t)(4 * nb) * (K / 32) + 2 * kb) * 512; t.ks = kscale ? kscale + 64 * kb : nullptr; t.ldw = N; t.ldo = 0; t.kblk = K / 32; return t;
}
#define TITEM_LOOP(first, count, stride, DECODE) do { int it_ = (first); if (it_ < (count)) { TItem cur_; { const int r = it_; DECODE(cur_, r); } f32x4 v_[16]; float kv_[16]; titem_load(cur_, v_, kv_, LANE);   \
        for (;;) { const int nx_ = it_ + (stride); const bool hn_ = nx_ < (count); TItem nxt_ = cur_; f32x4 vn_[16]; float kvn_[16];                                                  \
            if (hn_) { { const int r = nx_; DECODE(nxt_, r); } titem_load(nxt_, vn_, kvn_, LANE); }                                                                             \
            titem_store(cur_, v_, kv_, scr, LANE); if (!hn_) break; cur_ = nxt_; it_ = nx_; _Pragma("unroll") for (int q_ = 0; q_ < 16; ++q_) { v_[q_] = vn_[q_]; kv_[q_] = kvn_[q_]; } } } } while (0)
__device__ __forceinline__ void transpose_mat_item(const float* W, int K, int N, bf16* WT, int ldo, int coff, LAS float* scr, int item, int lane, const float* kscale = nullptr) {
    const int nblk = N / 32, kb = item / nblk, nb = item % nblk;
    transpose_item(W, N, 64 * kb, 32 * nb, WT + coff, ldo, 32 * nb, scr, lane, kscale);
}

struct Args { const float* in[22]; float* out; unsigned char* ws; int ph_lo, ph_hi, li, pad; };
template <int OFF> __device__ __forceinline__ void* karg_ptr() {
    __attribute__((address_space(1))) void* p; asm volatile("s_load_dwordx2 %0, %1, %2\n\ts_waitcnt lgkmcnt(0)" : "=s"(p) : "s"(__builtin_amdgcn_kernarg_segment_ptr()), "n"(OFF)); return (void*)p;
}

__global__ void __launch_bounds__(NWAVES * 64, 2) fwd_kernel(Args args) {
    extern __shared__ __attribute__((aligned(16))) unsigned char lds[];
    Frame F;
    F.lds = (LAS unsigned char*)lds;
    F.MISC = (volatile LAS unsigned*)(F.lds + MISC_OFF);
    F.wave = __builtin_amdgcn_readfirstlane((int)threadIdx.x >> 6);
#define LANE lane_
#define TID tid_
    const int lane0_ = pg8::hw_lane(), tid0_ = F.wave * 64 + lane0_;
    F.G = gridDim.x; { const int bx = blockIdx.x; F.vcu = (F.G % 8 == 0) ? (bx % 8) * (F.G / 8) + bx / 8 : bx; }
    F.ctl = (unsigned*)((unsigned char*)karg_ptr<8 * 23>() + WS_CTL);
    for (int u = tid0_; u < (LDS_BYTES - LDSCTL_OFF) / 4; u += NWAVES * 64) ((LAS unsigned*)(F.lds + LDSCTL_OFF))[u] = 0u;
    __syncthreads();
    XcdBarrier bar; bar.bar = F.ctl + CW_BAR; bar.x = 0; bar.st = nullptr;
    if (!MK_PER_PHASE) bar = xcd_barrier_post(F.ctl + CW_BAR, F.MISC + 8, tid0_);
#define GRID_BAR() do { if (!MK_PER_PHASE) xcd_barrier(bar, F.wave * 64 + pg8::hw_lane()); } while (0)
    const int lo = args.ph_lo, hi = args.ph_hi;
#define IN(k) (lo <= (k) && (k) < hi)
#define BOTH(k) (IN(k) && IN((k) + 1))
    const int gw = F.vcu * NWAVES + F.wave, NGW = F.G * NWAVES;

#define INP(i) ((const float*)karg_ptr<8 * (i)>())
#define WSP(T, off) ((T*)(wsb + (off)))
#define WSBASE() unsigned char* const wsb = (unsigned char*)karg_ptr<8 * 23>(); const int lane_ = pg8::hw_lane(); const int tid_ = F.wave * 64 + lane_; (void)tid_
#define WupT  WSP(bf16, WS_WUP)
#define WdnT  WSP(bf16, WS_WDN)
#define WinT  WSP(bf16, WS_WIN)
#define WoutT WSP(bf16, WS_WOUT)
#define WkvT  WSP(bf16, WS_WKV)
#define W2    WSP(bf16, WS_W2)
#define Ub    WSP(bf16, WS_U)
#define Ub2   WSP(bf16, WS_U2)
#define XB    WSP(bf16, WS_XB)
#define XB0   WSP(bf16, WS_XB0)
#define QKV   WSP(bf16, WS_QKV)
#define HB    WSP(bf16, WS_HB)
#define MB    WSP(bf16, WS_MB)
#define KVM   WSP(bf16, WS_KVM)
#define C2    WSP(bf16, WS_C2)
#define RX    WSP(float, WS_RX)
#define LOGF  WSP(float, WS_LOGF)
#define NCS   WSP(float, WS_NCS)
#define DTAB  WSP(float, WS_DTAB)
#define PART1 WSP(float, WS_PART1)
#define PART2 WSP(float, WS_PART2)
#define PART3 WSP(float, WS_PART3)
#define OD    ((bf16*)outp)

    if (IN(0)) {
        WSBASE(); const float* const xin = INP(0); const float* const mem = INP(1); const float* const g_mix = INP(2); const float* const w_in = INP(3); const float* const b_forget = INP(4);
        const float* const g_mem = INP(13); const float* const wk_mem = INP(15); const float* const wv_mem = INP(16);
        LAS float* scr = (LAS float*)(F.lds + RING_OFF + F.wave * TSCR_BYTES);
        constexpr int I_IN = (DM / 64) * (NQKV / 64), I_SQ = (DM / 64) * (DM / 64);
        constexpr int NITEMS = I_IN + 2 * I_SQ;
#define P0_DECODE(T, r0) do { int r_ = (r0);                                                                                           \
            if (r_ < I_IN) { const int nblk = NQKV / 64, kb = r_ / nblk, nb = r_ % nblk, nd = 64 * nb, nsrc = nd < FOFF ? nd : nd + 16;        \
                (T).src = w_in + (size_t)(64 * kb) * INW + nsrc; (T).dst = WinT + ((size_t)(nd / 16) * (DM / 32) + 2 * kb) * 512; (T).ks = g_mix + 64 * kb; (T).ldw = INW; (T).ldo = 0; (T).kblk = DM / 32; } \
            else if (r_ < I_IN + I_SQ) (T) = titem_mat(wk_mem, DM, WkvT, DM, 0, r_ - I_IN, nullptr);                                          \
            else (T) = titem_mat(wv_mem, DM, WkvT + (size_t)DM * DM, DM, 0, r_ - I_IN - I_SQ, nullptr); } while (0)
        TITEM_LOOP(gw, NITEMS, NGW, P0_DECODE);
#undef P0_DECODE
        for (int m = gw; m < MROWS; m += NGW) { const f32x4* xr = (const f32x4*)(mem + (size_t)m * DM) + LANE; f32x4 v[16]; float s = 0.f;
#pragma unroll
            for (int j = 0; j < 16; ++j) { v[j] = xr[64 * j]; s += (v[j][0] * v[j][0] + v[j][1] * v[j][1]) + (v[j][2] * v[j][2] + v[j][3] * v[j][3]); }
            const float rs = 1.0f / sqrtf(wave_sum(s) * (1.0f / DM) + NORM_EPS);
            unsigned long long* o8 = (unsigned long long*)(MB + (size_t)m * DM) + LANE;
#pragma unroll
            for (int j = 0; j < 16; ++j) { const f32x4 g = *((const f32x4*)g_mem + LANE + 64 * j);
                o8[64 * j] = (unsigned long long)pk2(v[j][0] * rs * g[0], v[j][1] * rs * g[1]) | ((unsigned long long)pk2(v[j][2] * rs * g[2], v[j][3] * rs * g[3]) << 32); } }
        __syncthreads();
        {   constexpr int WFP = DM + 8; constexpr int XCH_OFF = ((16 * WFP * 2 + 255) / 256) * 256;
            static_assert(XCH_OFF + 4 * 288 * 4 <= LDSCTL_OFF, "forget-gate table + exchange fit below the LDS control words");
            LAS bf16* wfT = (LAS bf16*)(F.lds + RING_OFF);
#pragma unroll
            for (int k = TID; k < DM; k += NWAVES * 64) { const float g = g_mix[k]; const f32x4* wp = (const f32x4*)(w_in + (size_t)k * INW + FOFF);
#pragma unroll
                for (int q = 0; q < 4; ++q) { const f32x4 w = wp[q];
#pragma unroll
                    for (int c = 0; c < 4; ++c) wfT[(4 * q + c) * WFP + k] = (bf16)f2bf(w[c] * g); } }
            __syncthreads();
            const int kh = F.wave & 1, lrow = LANE & 15, q = LANE >> 4;
            LAS float* xch = (LAS float*)(F.lds + RING_OFF + XCH_OFF) + (F.wave >> 1) * 288;
            for (int rg = F.vcu * 4 + (F.wave >> 1); rg < TOK / 16; rg += F.G * 4) { const int r0 = rg * 16;
                const float* xr = xin + (size_t)(r0 + lrow) * DM + kh * (DM / 2) + 8 * q;
                bf16* xo = XB0 + ((size_t)rg * (DM / 32) + kh * (DM / 64)) * 512 + lrow * 32 + 8 * q;
                const LAS bf16* wl = wfT + lrow * WFP + kh * (DM / 2) + 8 * q;
                f32x4 acc = {0.f, 0.f, 0.f, 0.f}; float ss = 0.f;
#pragma unroll 8
                for (int ks = 0; ks < DM / 64; ++ks) {
                    const f32x4 a = __builtin_nontemporal_load((const f32x4*)(xr + 32 * ks)), b = __builtin_nontemporal_load((const f32x4*)(xr + 32 * ks + 4));
                    ss += ((a[0] * a[0] + a[1] * a[1]) + (a[2] * a[2] + a[3] * a[3])) + ((b[0] * b[0] + b[1] * b[1]) + (b[2] * b[2] + b[3] * b[3]));
                    v4u w; w.x = pk2(a[0], a[1]); w.y = pk2(a[2], a[3]); w.z = pk2(b[0], b[1]); w.w = pk2(b[2], b[3]);
                    *(GAS v4u*)(xo + 512 * ks) = w;
                    const pg8::bf16x8 wf = *(const LAS pg8::bf16x8*)(wl + 32 * ks);
                    acc = __builtin_amdgcn_mfma_f32_16x16x32_bf16(*reinterpret_cast<const pg8::bf16x8*>(&w), wf, acc, 0, 0, 0); }
                ss += __shfl_xor(ss, 16); ss += __shfl_xor(ss, 32);
                if (kh == 1) {
#pragma unroll
                    for (int i = 0; i < 4; ++i) xch[LANE * 4 + i] = acc[i];
                    if (q == 0) xch[256 + lrow] = ss; }
                __syncthreads();
                if (kh == 0) {
#pragma unroll
                    for (int i = 0; i < 4; ++i) acc[i] += xch[LANE * 4 + i];
                    ss += xch[256 + lrow];
                    const float rs = 1.0f / sqrtf(ss * (1.0f / DM) + NORM_EPS);
                    if (q == 0) { RX[r0 + lrow] = rs; xch[272 + lrow] = rs; }
                    LDS_WAIT(); asm volatile("" ::: "memory");
                    const float bf_ = b_forget[lrow];
#pragma unroll
                    for (int i = 0; i < 4; ++i) { const float z = acc[i] * xch[272 + 4 * q + i] + bf_; LOGF[(size_t)(r0 + 4 * q + i) * 16 + lrow] = fminf(z, 0.f) - log1pf(expf(-fabsf(z))); } }
                __syncthreads(); }
        }
        if (BOTH(0)) GRID_BAR();
    }

    if (IN(1)) {
        WSBASE();
        pg8::MapPlainAB g{(const char*)XB0, (const char*)WinT, DM, DM, DM}; pg8::StaticOrder S; S.init(TOK, NQKV, F.G, (int)blockIdx.x);
        pg8::Unit u0; int pm0 = -1; if (S.next(0, u0)) pm0 = u0.pm;
        LAS float* rtab = (LAS float*)(F.lds + RTAB_OFF);
        if (pm0 >= 0 && TID < 256) rtab[TID] = RX[pm0 * 256 + TID];
        __syncthreads();
        pg8::EpiQKV E{QKV, RX, rtab, pm0, F.ctl + CW_KN};
        pg8::gemm_phase<pg8::MapPlainAB, pg8::EpiQKV, pg8::StaticOrder, true, true>(F.lds + RING_OFF, g, S, E, F.wave);
    }

    if (IN(2)) {
        WSBASE(); const float* const rel_bias = INP(10);
        {   pg8::MapPlain g{(const char*)MB, (const char*)WkvT, DM, DM, DM}; pg8::StaticOrder S; S.init(MROWS, 2 * DM, F.G, (int)blockIdx.x);
            pg8::EpiBf16 E{KVM, 2 * DM, 1.0f, 0};
            pg8::gemm_phase<pg8::MapPlain, pg8::EpiBf16, pg8::StaticOrder, true, true>(F.lds + RING_OFF, g, S, E, F.wave); }
        {
            const float* const w_out = INP(11); const float* const wq_mem = INP(14); const float* const wo_mem = INP(17); const float* const w_up = INP(19); const float* const w_down = INP(20);
            const float* const g_cross = INP(12); const float* const g_mlp = INP(18);
            const bool big = F.G > 128, late = big && (int)blockIdx.x < 128;
            const int nconv = big ? (late ? 128 : F.G - 128) : F.G, myc = big ? (late ? (int)blockIdx.x : (int)blockIdx.x - 128) : (int)blockIdx.x;
            {
                LAS float* scr = (LAS float*)(F.lds + RING_OFF + F.wave * TSCR_BYTES);
                constexpr int I_SQ = (DM / 64) * (DM / 64), I_UP = (DM / 64) * (DFF / 64), I_DN = (DFF / 64) * (DM / 64), I_WQ = DM * DM / 512;
                const int nd3 = (CV_ITEMS * F.G <= I_DN) ? CV_ITEMS * F.G : I_DN;
                const int NITEMS = 2 * I_SQ + I_UP + I_DN - nd3;
                const int it_lo = !big ? 0 : (late ? (NITEMS / 5) * 4 : 0), it_hi = !big ? NITEMS : (late ? NITEMS : (NITEMS / 5) * 4);
                const int wq_lo = !big ? 0 : (late ? (I_WQ / 5) * 4 : 0), wq_hi = !big ? I_WQ : (late ? I_WQ : (I_WQ / 5) * 4);
#define P2_DECODE(T, r0) do { int r_ = (r0);                                                                                           \
            if (r_ < I_SQ) (T) = titem_blk(w_out, DM, DM, WoutT, r_, nullptr);                                                             \
            else if (r_ < 2 * I_SQ) (T) = titem_mat(wo_mem, DM, W2, 2 * DM, DM, r_ - I_SQ, nullptr);                                          \
            else if (r_ < 2 * I_SQ + I_UP) (T) = titem_blk(w_up, DM, DFF, WupT, r_ - 2 * I_SQ, g_mlp);                                     \
            else (T) = titem_blk(w_down, DFF, DM, WdnT, r_ - 2 * I_SQ - I_UP + nd3, nullptr); } while (0)
                TITEM_LOOP(it_lo + myc * NWAVES + F.wave, it_hi, nconv * NWAVES, P2_DECODE);
#undef P2_DECODE
                {
                    const int st_ = nconv * NWAVES;
                    for (int r0 = wq_lo + myc * NWAVES + F.wave; r0 < wq_hi; r0 += 4 * st_) {
                        f32x4 a[4], b[4]; float gc[4];
#pragma unroll
                        for (int u = 0; u < 4; ++u) { const int r = r0 + u * st_; if (r < wq_hi) { const int e = r * 512 + LANE * 8;
                            a[u] = __builtin_nontemporal_load((const f32x4*)(wq_mem + e)); b[u] = __builtin_nontemporal_load((const f32x4*)(wq_mem + e + 4)); gc[u] = g_cross[e >> 12]; } }
#pragma unroll
                        for (int u = 0; u < 4; ++u) { const int r = r0 + u * st_; if (r < wq_hi) { const int e = r * 512 + LANE * 8, d = e >> 12, c = e & 4095;
                            const f32x4 x0 = a[u] * gc[u], x1 = b[u] * gc[u];
                            v4u o; o.x = pk2(x0[0], x0[1]); o.y = pk2(x0[2], x0[3]); o.z = pk2(x1[0], x1[1]); o.w = pk2(x1[2], x1[3]);
                            *(GAS v4u*)(W2 + (size_t)d * 8192 + c) = o; } } } }
                __syncthreads();
            }
        }
        for (int job = F.G - 1 - (int)blockIdx.x; job < 65; job += F.G) {
            if (job < 64) {
                const int b = job >> 4, h = job & 15; LAS float* wt = (LAS float*)(F.lds + RING_OFF);
                float v[8]; const int s0 = TID * 8;
#pragma unroll
                for (int i = 0; i < 8; ++i) v[i] = LOGF[(size_t)(b * SEQ + s0 + i) * 16 + h];
#pragma unroll
                for (int i = 1; i < 8; ++i) v[i] += v[i - 1];
                float tot = v[7], inc = tot;
#pragma unroll
                for (int o = 1; o < 64; o <<= 1) { const float t = __shfl_up(inc, o); if (LANE >= o) inc += t; }
                __syncthreads();
                if (LANE == 63) wt[F.wave] = inc;
                __syncthreads();
                float base = inc - tot;
                for (int w = 0; w < F.wave; ++w) base += wt[w];
#pragma unroll
                for (int i = 0; i < 8; ++i) NCS[(size_t)job * SEQ + s0 + i] = -(base + v[i]) * (1.0f / att::SCALE);
                __syncthreads();
            } else {
                for (int idx = TID; idx < 8 * 256; idx += NWAVES * 64) { const int hd = idx >> 8, rel = (idx & 255) - 192; const int n = rel < 0 ? -rel : rel;
                    int bk = rel > 0 ? 16 : 0;
                    if (n < 8) bk += n; else { int lg = 31 - __clz((n * n) >> 6); lg = lg > 7 ? 7 : lg; bk += 8 + lg; }
                    DTAB[idx] = (rel_bias[bk * 8 + hd] - rel_bias[15 * 8 + hd]) * (1.0f / att::SCALE); }
            }
        }
        if (BOTH(2)) GRID_BAR();
    }

    if (IN(3)) {
        WSBASE(); float* const outp = (float*)karg_ptr<8 * 22>();
        auto fox_ref = [&](int L, int pass) { const int hu = L >> 3, xx = (L < 256) ? (L & 7) : 7 - (L & 7), b = hu >> 4, h = hu & 15, qb = pass ? 15 - xx : xx; att::BlockRef r;
            const float* knp = (const float*)(F.ctl + CW_KN) + hu * 4; r.kmax2 = 1.05f * ((knp[0] + knp[1]) + (knp[2] + knp[3]));
            r.Q = QKV + ((size_t)(b * 96 + h) * SEQ + (size_t)qb * 256) * 128; r.K = QKV + (size_t)(b * 96 + 16 + h) * SEQ * 128; r.V = QKV + (size_t)(b * 96 + 32 + h) * SEQ * 128;
            r.O = XB + ((size_t)(b * SEQ + qb * 256)) * DM + h * 128; r.tab = NCS + (size_t)hu * SEQ; r.P0 = qb * 256; r.kb0 = qb * 256 + 192; r.tabn = qb * 256 + 256; return r; };
        const float* const lq1 = INP(5); const float* const lk1 = INP(6); const float* const lq2 = INP(7); const float* const lk2 = INP(8); const float* const g_subln = INP(9);
        float lam = 0.f;
        auto dif_ref = [&](int L, int k) { const int hu = (L - 512) >> 3, xx = L & 7, b = hu >> 3, hd = hu & 7, c = k & 1, qb = (k >> 1) ? 15 - xx : xx; att::BlockRef r;
            r.Q = QKV + ((size_t)(b * 96 + 48 + hd * 2 + c) * SEQ + (size_t)qb * 256) * 128; r.K = QKV + (size_t)(b * 96 + 64 + hd * 2 + c) * SEQ * 128; r.V = QKV + (size_t)(b * 96 + 80 + hd * 2) * SEQ * 128;
            r.O = XB + ((size_t)(b * SEQ + qb * 256)) * DM + 2048 + hd * 256; r.tab = DTAB + hd * 256; r.P0 = qb * 256; r.kb0 = 0; r.kmax2 = 0.f; r.tabn = 256;
            r.c = c; r.lam = lam; r.gs = g_subln; r.scr = outp + (size_t)F.vcu * 65536; return r; };
        int nA = 0, nT = 0; for (int L = F.vcu; L < 768; L += F.G) { ++nT; if (L < 512) ++nA; }
        const int nD = nT - nA;
        auto ref = [&](int k) { const int L = F.vcu + (k >> 1) * F.G; return fox_ref(L, k & 1); };
        auto dref = [&](int k) { const int L = F.vcu + (nA + (k >> 2)) * F.G; return dif_ref(L, k & 3); };
        if (nA > 0) {
            att::Seam S; att::BlockRef cur = ref(0);
            att::attn_prime(cur, (char*)lds + RING_OFF, S, F.wave);
            for (int k = 0; k < 2 * nA; ++k) { const att::BlockRef nxt = ref(k + 1 < 2 * nA ? k + 1 : k); att::attn_block<0>(cur, nxt, (char*)lds + RING_OFF, S, F.wave); cur = nxt; }
        }
        att::CvState cv{INP(20), WdnT, 2 * CV_ITEMS * F.vcu, 2 * CV_ITEMS * (F.vcu + 1), 0};
        if (nD > 0) {
            lam = expf(wave_sum(lq1[LANE] * lk1[LANE] + lq1[LANE + 64] * lk1[LANE + 64])) - expf(wave_sum(lq2[LANE] * lk2[LANE] + lq2[LANE + 64] * lk2[LANE + 64])) + 0.2f;
            att::DSeam S; att::BlockRef cur = dref(0);
            att::dattn_prime(cur, (char*)lds + RING_OFF, F.lds + RING_OFF, S, F.wave);
            for (int k = 0; k < 4 * nD; ++k) { const att::BlockRef nxt = dref(k + 1 < 4 * nD ? k + 1 : k); att::dattn_block(cur, nxt, (char*)lds + RING_OFF, F.lds + RING_OFF, S, cv, F.wave); cur = nxt; }
            att::dattn_finish(F.wave);
        }
        __syncthreads();
        att::cv_finish(cv, (char*)lds + RING_OFF, F.lds + RING_OFF, F.wave);
        if (BOTH(3)) GRID_BAR();
    }


    if (IN(5)) {
        WSBASE();
        {   pg8::MapPlainB g{(const char*)XB, (const char*)WoutT, DM, DM, DM}; pg8::StaticOrder S; S.init(TOK, DM, F.G, (int)blockIdx.x);
            pg8::EpiRes<true, true, true, true> E{XB0, HB, DM, PART1, 0};
            pg8::gemm_phase<pg8::MapPlainB, pg8::EpiRes<true, true, true, true>, pg8::StaticOrder, true, true>(F.lds + RING_OFF, g, S, E, F.wave); }
        {   pg8::MapAbsorb g{(const char*)KVM, (const char*)W2, 2 * DM, 2 * DM, 1024}; pg8::StaticOrder S; S.init(8192, DM, F.G, (int)blockIdx.x);
            pg8::EpiBf16 E{C2, DM, 0.03125f, 16};
            pg8::gemm_phase<pg8::MapAbsorb, pg8::EpiBf16, pg8::StaticOrder, true, true>(F.lds + RING_OFF, g, S, E, F.wave); }
        if (BOTH(5)) GRID_BAR();
    }

    if (IN(6)) {
        WSBASE();
        pg8::MapBatchBA g{(const char*)HB, (const char*)C2, DM, DM, DM, (size_t)1024 * DM * 2}; pg8::StaticOrder S; S.init(TOK, 1024, F.G, (int)blockIdx.x);
        pg8::EpiSoftmax E{XB, 1024, PART1, NORM_EPS};
        pg8::gemm_phase<pg8::MapBatchBA, pg8::EpiSoftmax, pg8::StaticOrder, false, true>(F.lds + RING_OFF, g, S, E, F.wave);
        if (BOTH(6)) GRID_BAR();
    }

    if (IN(7)) {
        WSBASE();
        pg8::MapBatchB g{(const char*)XB, (const char*)(C2 + (size_t)4096 * DM), 1024, DM, 1024, (size_t)1024 * 2}; pg8::StaticOrder S; S.init(TOK, DM, F.G, (int)blockIdx.x);
        pg8::EpiRes<true, true, true, true> E{HB, HB, DM, PART2, 0};
        pg8::gemm_phase<pg8::MapBatchB, pg8::EpiRes<true, true, true, true>, pg8::StaticOrder, true, true>(F.lds + RING_OFF, g, S, E, F.wave);
        if (BOTH(7)) GRID_BAR();
    }

    if (IN(8)) {
        WSBASE();
        pg8::MapPlainAB g{(const char*)HB, (const char*)WupT, DM, DM, DM}; pg8::StaticOrder S; S.init(TOK, DFF, F.G, (int)blockIdx.x);
        pg8::Unit u0; int pm0 = -1; if (S.next(0, u0)) pm0 = u0.pm;
        LAS float* rtab = (LAS float*)(F.lds + RTAB_OFF);
        if (pm0 >= 0) pg8::row_rstd_table(rtab, PART2, pm0 * 256, NORM_EPS, TID);
        pg8::EpiRelu2 E{Ub, Ub2, DFF, PART2, 0, NORM_EPS, rtab, pm0};
        pg8::gemm_phase<pg8::MapPlainAB, pg8::EpiRelu2, pg8::StaticOrder, true, true>(F.lds + RING_OFF, g, S, E, F.wave);
        if (BOTH(8)) GRID_BAR();
    }
    if (IN(9)) {
        WSBASE();
        pg8::MapBlkA g{(const char*)Ub, (const char*)Ub2, (const char*)WdnT, DFF, DFF}; pg8::StaticOrder S; S.init(TOK, DM, F.G, (int)blockIdx.x);
        pg8::EpiRes<true, true, true, false> E{HB, XB0, DM, PART3, 0};
        pg8::gemm_phase<pg8::MapBlkA, pg8::EpiRes<true, true, true, false>, pg8::StaticOrder, true, true>(F.lds + RING_OFF, g, S, E, F.wave);
        if (BOTH(9)) GRID_BAR();
    }

    if (IN(10)) {
        WSBASE(); float* const outp = (float*)karg_ptr<8 * 22>(); const float* const g_final = INP(21);
        unsigned bad = 0u;
        if (!MK_PER_PHASE) bad = __hip_atomic_load(F.ctl + CW_BAR + XB_TMO, __ATOMIC_RELAXED, __HIP_MEMORY_SCOPE_AGENT);
        const float poison = bad ? __builtin_nanf("") : 1.0f;
        for (int m = gw; m < TOK; m += NGW) {
            const float ssq = wave_sum(PART3[(size_t)m * 64 + LANE]);
            const float rs = poison / sqrtf(ssq * (1.0f / DM) + NORM_EPS);
            const pg8::u32x4* hr = (const pg8::u32x4*)(XB0 + (size_t)m * DM) + LANE; f32x4* orow = (f32x4*)(outp + (size_t)m * DM) + 2 * LANE;
            pg8::u32x4 w[8];
#pragma unroll
            for (int j = 0; j < 8; ++j) w[j] = __builtin_nontemporal_load(hr + 64 * j);
#pragma unroll
            for (int j = 0; j < 8; ++j) { const f32x4 g0 = *((const f32x4*)g_final + 2 * LANE + 128 * j), g1 = *((const f32x4*)g_final + 2 * LANE + 128 * j + 1);
                const f32x4 a = {__uint_as_float(w[j].x << 16), __uint_as_float(w[j].x & 0xffff0000u), __uint_as_float(w[j].y << 16), __uint_as_float(w[j].y & 0xffff0000u)};
                const f32x4 b = {__uint_as_float(w[j].z << 16), __uint_as_float(w[j].z & 0xffff0000u), __uint_as_float(w[j].w << 16), __uint_as_float(w[j].w & 0xffff0000u)};
                orow[128 * j] = a * rs * g0; orow[128 * j + 1] = b * rs * g1; } }
    }
#undef IN
#undef BOTH
#undef GRID_BAR
}

extern "C" void kernel_launch(void* const* d_in, const int* in_sizes, int n_in, void* d_out, int out_size, void* d_ws, size_t ws_size, hipStream_t stream) {
    static int grid = 0;
    if (grid == 0) {
        if (n_in != 22 || in_sizes[0] != TOK * DM || out_size != TOK * DM || ws_size < WS_END) { fprintf(stderr, "kernel_launch: unexpected shapes / workspace (n_in %d, ws %zu < %zu)\n", n_in, ws_size, (size_t)WS_END); grid = -1; return; }
        int dev = 0, cus = 0, per_cu = 0;
        if (hipGetDevice(&dev) != hipSuccess || hipDeviceGetAttribute(&cus, hipDeviceAttributeMultiprocessorCount, dev) != hipSuccess) { grid = -1; return; }
        if (hipFuncSetAttribute((const void*)fwd_kernel, hipFuncAttributeMaxDynamicSharedMemorySize, LDS_BYTES) != hipSuccess) { fprintf(stderr, "kernel_launch: hipFuncSetAttribute failed\n"); grid = -1; return; }
        if (hipOccupancyMaxActiveBlocksPerMultiprocessor(&per_cu, (const void*)fwd_kernel, NWAVES * 64, LDS_BYTES) != hipSuccess || per_cu < 1) { fprintf(stderr, "kernel_launch: occupancy query reports %d\n", per_cu); }
        (void)hipGetLastError();
        grid = cus;
    }
    if (grid < 0) return;
    if (hipMemsetAsync((char*)d_ws + WS_CTL, 0, CTL_ZERO_BYTES, stream) != hipSuccess) return;
    Args a{};
    for (int i = 0; i < 22; ++i) a.in[i] = (const float*)d_in[i];
    a.out = (float*)d_out; a.ws = (unsigned char*)d_ws;
#if MK_PER_PHASE
    for (int p = 0; p < N_PHASES; ++p) { a.ph_lo = p; a.ph_hi = p + 1; a.li = p; a.pad = 0;
        for (int rep = 0; rep < ((PROBE_DUP_MASK >> p) & 1) + 1; ++rep)
            hipLaunchKernelGGL(fwd_kernel, dim3(grid), dim3(NWAVES * 64), LDS_BYTES, stream, a); }
#else
    a.ph_lo = 0; a.ph_hi = N_PHASES; a.li = 0; a.pad = 0;
    hipLaunchKernelGGL(fwd_kernel, dim3(grid), dim3(NWAVES * 64), LDS_BYTES, stream, a);
#endif
}
```

```cpp
#include <hip/hip_runtime.h>
#include <cstdio>
#include <cstdint>

#ifndef PROBE_DUP_MASK
#define PROBE_DUP_MASK 0
#endif
#ifndef MK_PER_PHASE
#define MK_PER_PHASE 0
#endif

namespace pg8 {
#define PG8_LAS __attribute__((address_space(3)))
typedef unsigned short bf16_t;
typedef short bf16x8 __attribute__((ext_vector_type(8)));
typedef float f32x4 __attribute__((ext_vector_type(4)));
typedef float f32x2 __attribute__((ext_vector_type(2)));
typedef unsigned u32x4 __attribute__((ext_vector_type(4)));
typedef unsigned u32x2 __attribute__((ext_vector_type(2)));
constexpr int BM = 256, BK = 64, HALF = 128, HTB = HALF * BK * 2, STAGE_BYTES = 8 * HTB, NXCD = 8, WGM = 8;

__host__ __device__ __forceinline__ int lds_byte(int r, int c) { const int st = (r >> 4) * 2 + (c >> 5), rr = r & 15, cc = c & 31, ob = rr * 64 + cc * 2; return st * 1024 + (ob ^ (((ob >> 9) & 1) << 5)); }
__host__ __device__ __forceinline__ void stage_rc(int b, int& R, int& C) { const int st = b / 1024, sb = b % 1024, swz = sb ^ (((sb >> 9) & 1) << 5); R = (st >> 1) * 16 + swz / 64; C = (st & 1) * 32 + (swz % 64) / 2; }
__host__ __device__ __forceinline__ int perm32(int rho) { const int n = rho >> 4, i = rho & 15; return 8 * (i >> 2) + 4 * n + (i & 3); }

struct Unit { int pm, pn; };

struct StaticOrder {
    int nM, nN, nwg, G, c, wgm = WGM;
    __host__ __device__ __forceinline__ void init(int M, int N, int G_, int c_) { nM = M / BM; nN = N / BM; nwg = nM * nN; G = G_; c = c_; }
    __host__ __device__ __forceinline__ bool next(int i, Unit& u) const {
        const long L = (long)i * G + c; if (L >= nwg) return false;
        int wgid = (int)L; { const int q = nwg / NXCD, r = nwg % NXCD, xcd = wgid % NXCD, off = wgid / NXCD; wgid = (xcd < r ? xcd * (q + 1) : r * (q + 1) + (xcd - r) * q) + off; }
        const int nig = wgm * nN, gid = wgid / nig, fm = gid * wgm, gsz = (nM - fm) < wgm ? (nM - fm) : wgm;
        u.pm = fm + ((wgid % nig) % gsz); u.pn = (wgid % nig) / gsz; return true;
    }
};

__device__ __forceinline__ unsigned cvt_pk_bf16(float lo, float hi) { unsigned r; asm volatile("v_cvt_pk_bf16_f32 %0, %1, %2" : "=v"(r) : "v"(lo), "v"(hi)); return r; }
__device__ __forceinline__ int hw_lane() { unsigned l; asm volatile("v_mbcnt_lo_u32_b32 %0, -1, 0\n\tv_mbcnt_hi_u32_b32 %0, -1, %0" : "=v"(l)); return (int)(l & 63u); }

template <bool ABLK, bool BBLK> struct MapPlainT {
    const char* A; const char* Bt; int lda, ldb, K;
    __device__ __forceinline__ unsigned blk(int R, int C) const { return (unsigned)(((R >> 4) * (K / 32) + (C >> 5)) * 1024 + ((R & 15) * 32 + (C & 31)) * 2); }
    __device__ __forceinline__ unsigned voffA(int R, int C) const { return ABLK ? blk(R, C) : (unsigned)(R * lda + C) * 2u; }
    __device__ __forceinline__ size_t kstepA() const { return ABLK ? (size_t)2048 : (size_t)(BK * 2); }
    __device__ __forceinline__ size_t hstepA() const { return ABLK ? (size_t)8 * (K / 32) * 1024 : (size_t)HALF * lda * 2; }
    __device__ __forceinline__ unsigned voffB(int R, int C) const { return BBLK ? blk(R, C) : (unsigned)(R * ldb + C) * 2u; }
    __device__ __forceinline__ size_t kstepB() const { return BBLK ? (size_t)2048 : (size_t)(BK * 2); }
    __device__ __forceinline__ size_t hstepB() const { return BBLK ? (size_t)8 * (K / 32) * 1024 : (size_t)HALF * ldb * 2; }
    __device__ __forceinline__ const char* a_base(const Unit& u) const { return A + (ABLK ? (size_t)u.pm * 16 * (K / 32) * 1024 : (size_t)u.pm * 256 * lda * 2); }
    __device__ __forceinline__ const char* b_base(const Unit& u) const { return Bt + (BBLK ? (size_t)u.pn * 16 * (K / 32) * 1024 : (size_t)u.pn * 256 * ldb * 2); }
};
typedef MapPlainT<false, false> MapPlain;
typedef MapPlainT<false, true> MapPlainB;
typedef MapPlainT<true, true> MapPlainAB;
struct MapBlkA {
    const char* A0; const char* A1; const char* Bt; int ldb, K;
    __device__ __forceinline__ const char* a_base(const Unit& u) const { const size_t pstride = (size_t)16 * (K / 32) * 1024; return (u.pm < 32 ? A0 + (size_t)u.pm * pstride : A1 + (size_t)(u.pm - 32) * pstride); }
    __device__ __forceinline__ const char* b_base(const Unit& u) const { return Bt + (size_t)u.pn * 16 * (K / 32) * 1024; }
    __device__ __forceinline__ unsigned voffA(int R, int C) const { return (unsigned)(((R >> 4) * (K / 32) + (C >> 5)) * 1024 + ((R & 15) * 32 + (C & 31)) * 2); }
    __device__ __forceinline__ size_t kstepA() const { return (size_t)2048; }
    __device__ __forceinline__ size_t hstepA() const { return (size_t)8 * (K / 32) * 1024; }
    __device__ __forceinline__ unsigned voffB(int R, int C) const { return voffA(R, C); }
    __device__ __forceinline__ size_t kstepB() const { return (size_t)2048; }
    __device__ __forceinline__ size_t hstepB() const { return hstepA(); }
};
template <bool ABLK> struct MapBatchBT {
    const char* A; const char* Bt; int lda, ldb, K; size_t bstride;
    __device__ __forceinline__ unsigned voffA(int R, int C) const { return ABLK ? (unsigned)(((R >> 4) * (K / 32) + (C >> 5)) * 1024 + ((R & 15) * 32 + (C & 31)) * 2) : (unsigned)(R * lda + C) * 2u; }
    __device__ __forceinline__ size_t kstepA() const { return ABLK ? (size_t)2048 : (size_t)(BK * 2); }
    __device__ __forceinline__ size_t hstepA() const { return ABLK ? (size_t)8 * (K / 32) * 1024 : (size_t)HALF * lda * 2; }
    __device__ __forceinline__ unsigned voffB(int R, int C) const { return (unsigned)(R * ldb + C) * 2u; }
    __device__ __forceinline__ size_t kstepB() const { return (size_t)(BK * 2); }
    __device__ __forceinline__ size_t hstepB() const { return (size_t)HALF * ldb * 2; }
    __device__ __forceinline__ const char* a_base(const Unit& u) const { return A + (ABLK ? (size_t)u.pm * 16 * (K / 32) * 1024 : (size_t)u.pm * 256 * lda * 2); }
    __device__ __forceinline__ const char* b_base(const Unit& u) const { return Bt + (size_t)(u.pm >> 4) * bstride + (size_t)u.pn * 256 * ldb * 2; }
};
typedef MapBatchBT<false> MapBatchB;
typedef MapBatchBT<true> MapBatchBA;
struct MapAbsorb {
    const char* kvm; const char* W2; int lda, ldb, K;
    __device__ __forceinline__ unsigned voffB(int R, int C) const { return (unsigned)(R * ldb + C) * 2u; }
    __device__ __forceinline__ size_t kstepB() const { return (size_t)(BK * 2); }
    __device__ __forceinline__ size_t hstepB() const { return (size_t)HALF * ldb * 2; }
    __device__ __forceinline__ unsigned voffA(int R, int C) const { return (unsigned)(R * lda + C) * 2u; }
    __device__ __forceinline__ size_t kstepA() const { return (size_t)(BK * 2); }
    __device__ __forceinline__ size_t hstepA() const { return (size_t)HALF * lda * 2; }
    __device__ __forceinline__ const char* a_base(const Unit& u) const {
        if (u.pm < 16) return kvm + ((size_t)(u.pm >> 2) * 256 * 8192 + (size_t)(u.pm & 3) * 1024) * 2;
        return W2 + ((size_t)(u.pm - 16) * 256 * 8192 + 4096 + (size_t)(u.pn & 3) * 1024) * 2; }
    __device__ __forceinline__ const char* b_base(const Unit& u) const {
        if (u.pm < 16) return W2 + ((size_t)u.pn * 256 * 8192 + (size_t)(u.pm & 3) * 1024) * 2;
        return kvm + ((size_t)(u.pn >> 2) * 256 * 8192 + 4096 + (size_t)(u.pn & 3) * 1024) * 2; }
};


__device__ __forceinline__ float row_rstd(const float* part, int row, int fq, float eps) {
    const f32x4* p = (const f32x4*)(part + (size_t)row * 64 + fq * 16);
    const f32x4 a = p[0], b = p[1], c = p[2], d = p[3];
    float s = ((a[0] + a[1]) + (a[2] + a[3])) + ((b[0] + b[1]) + (b[2] + b[3])) + ((c[0] + c[1]) + (c[2] + c[3])) + ((d[0] + d[1]) + (d[2] + d[3]));
    s += __shfl_xor(s, 16); s += __shfl_xor(s, 32);
    return __builtin_amdgcn_rsqf(s * (1.0f / 4096.0f) + eps);
}

struct EpiQKV {
    static constexpr bool PERM = true, AFTER_DRAIN = false;
    bf16_t* O; const float* rx; const PG8_LAS float* tab; int tab_pm;
    unsigned* kn;
    __device__ __forceinline__ void operator()(const f32x4 (&acc)[2][2][4][2], const Unit& u, int wr, int wc, int fr, int fq) const {
        const int row0 = u.pm * BM + wr * 64 + fr, d0 = wc * 32 + 8 * fq; const bool tb = (u.pm == tab_pm);
#pragma unroll
        for (int ai = 0; ai < 2; ++ai)
#pragma unroll
            for (int m = 0; m < 4; ++m) { const int row = row0 + ai * HALF + m * 16; const float r = tb ? tab[ai * HALF + wr * 64 + m * 16 + fr] : rx[row]; const int b = row >> 12, s = row & 4095;
#pragma unroll
                for (int bj = 0; bj < 2; ++bj) { const int head = u.pn * 2 + bj;
                    const f32x4 v0 = acc[ai][bj][m][0] * r, v1 = acc[ai][bj][m][1] * r;
                    u32x4 w; w.x = cvt_pk_bf16(v0[0], v0[1]); w.y = cvt_pk_bf16(v0[2], v0[3]); w.z = cvt_pk_bf16(v1[0], v1[1]); w.w = cvt_pk_bf16(v1[2], v1[3]);
                    *(u32x4*)(O + (((size_t)(b * 96 + head) * 4096 + s) * 128 + d0)) = w; } }
        if (u.pn >= 8 && u.pn < 16) {
#pragma unroll
            for (int bj = 0; bj < 2; ++bj) { float mx = 0.f;
#pragma unroll
                for (int ai = 0; ai < 2; ++ai)
#pragma unroll
                    for (int m = 0; m < 4; ++m) { const int row = row0 + ai * HALF + m * 16; const float r = tb ? tab[ai * HALF + wr * 64 + m * 16 + fr] : rx[row];
                        const f32x4 v0 = acc[ai][bj][m][0] * r, v1 = acc[ai][bj][m][1] * r;
                        float q = ((v0[0] * v0[0] + v0[1] * v0[1]) + (v0[2] * v0[2] + v0[3] * v0[3])) + ((v1[0] * v1[0] + v1[1] * v1[1]) + (v1[2] * v1[2] + v1[3] * v1[3]));
                        q += __shfl_xor(q, 16); q += __shfl_xor(q, 32); mx = fmaxf(mx, q); }
                mx = fmaxf(mx, __shfl_xor(mx, 1)); mx = fmaxf(mx, __shfl_xor(mx, 2)); mx = fmaxf(mx, __shfl_xor(mx, 4)); mx = fmaxf(mx, __shfl_xor(mx, 8));
                if (fr == 0 && fq == 0) atomicMax(kn + ((size_t)((u.pm >> 4) * 16 + (u.pn * 2 + bj - 16)) * 4 + wc), __float_as_uint(mx)); } }
    }
};
struct EpiBf16 {
    static constexpr bool PERM = true, AFTER_DRAIN = false;
    bf16_t* O; int ldc; float s0; int pm_split;
    __device__ __forceinline__ void operator()(const f32x4 (&acc)[2][2][4][2], const Unit& u, int wr, int wc, int fr, int fq) const {
        const int row0 = u.pm * BM + wr * 64 + fr, col0 = u.pn * BM + wc * 32 + 8 * fq; const float sc = (u.pm < pm_split) ? s0 : 1.0f;
#pragma unroll
        for (int ai = 0; ai < 2; ++ai)
#pragma unroll
            for (int m = 0; m < 4; ++m) { bf16_t* rowp = O + (size_t)(row0 + ai * HALF + m * 16) * ldc + col0;
#pragma unroll
                for (int bj = 0; bj < 2; ++bj) { const f32x4 v0 = acc[ai][bj][m][0] * sc, v1 = acc[ai][bj][m][1] * sc;
                    u32x4 w; w.x = cvt_pk_bf16(v0[0], v0[1]); w.y = cvt_pk_bf16(v0[2], v0[3]); w.z = cvt_pk_bf16(v1[0], v1[1]); w.w = cvt_pk_bf16(v1[2], v1[3]);
                    *(u32x4*)(rowp + bj * HALF) = w; } }
    }
};
struct EpiRelu2 {
    static constexpr bool PERM = true, AFTER_DRAIN = false;
    bf16_t* O; bf16_t* O1; int ldc; const float* part; int row_off; float eps; const PG8_LAS float* tab; int tab_pm;
    __device__ __forceinline__ void operator()(const f32x4 (&acc)[2][2][4][2], const Unit& u, int wr, int wc, int fr, int fq) const {
        const int row0 = u.pm * BM + wr * 64 + fr, col0 = u.pn * BM + wc * 32 + 8 * fq;
        float rs[2][4];
        if (u.pm == tab_pm) {
#pragma unroll
            for (int ai = 0; ai < 2; ++ai)
#pragma unroll
                for (int m = 0; m < 4; ++m) rs[ai][m] = tab[ai * HALF + wr * 64 + m * 16 + fr];
        } else {
#pragma unroll
            for (int ai = 0; ai < 2; ++ai) {
                f32x4 pp[4][4];
#pragma unroll
                for (int m = 0; m < 4; ++m) { const f32x4* p = (const f32x4*)(part + (size_t)(row_off + row0 + ai * HALF + m * 16) * 64 + fq * 16);
#pragma unroll
                    for (int q = 0; q < 4; ++q) pp[m][q] = p[q]; }
#pragma unroll
                for (int m = 0; m < 4; ++m) { float s = 0.f;
#pragma unroll
                    for (int q = 0; q < 4; ++q) s += (pp[m][q][0] + pp[m][q][1]) + (pp[m][q][2] + pp[m][q][3]);
                    s += __shfl_xor(s, 16); s += __shfl_xor(s, 32); rs[ai][m] = __builtin_amdgcn_rsqf(s * (1.0f / 4096.0f) + eps); }
                asm volatile("" ::: "memory"); } }
#pragma unroll
        for (int ai = 0; ai < 2; ++ai)
#pragma unroll
            for (int m = 0; m < 4; ++m) { const int row = row0 + ai * HALF + m * 16; const float r = rs[ai][m];
                const int rb = (u.pm & 31) * 16 + ai * 8 + wr * 4 + m, cb = u.pn * 8 + wc;
                bf16_t* rowp = (u.pm < 32 ? O : O1) + ((size_t)rb * (ldc / 32) + cb) * 512 + fr * 32 + 8 * fq;
#pragma unroll
                for (int bj = 0; bj < 2; ++bj) { f32x4 v0 = acc[ai][bj][m][0] * r, v1 = acc[ai][bj][m][1] * r;
#pragma unroll
                    for (int j = 0; j < 4; ++j) { v0[j] = fmaxf(v0[j], 0.f); v0[j] *= v0[j]; v1[j] = fmaxf(v1[j], 0.f); v1[j] *= v1[j]; }
                    u32x4 w; w.x = cvt_pk_bf16(v0[0], v0[1]); w.y = cvt_pk_bf16(v0[2], v0[3]); w.z = cvt_pk_bf16(v1[0], v1[1]); w.w = cvt_pk_bf16(v1[2], v1[3]);
                    *(u32x4*)(rowp + bj * 4 * 512) = w; } }
    }
};
__device__ __forceinline__ void row_rstd_table(PG8_LAS float* tab, const float* part, int grow0, float eps, int tid) {
    const int row = tid >> 1, hf = tid & 1; const f32x4* p = (const f32x4*)(part + (size_t)(grow0 + row) * 64 + hf * 32); float s = 0.f;
#pragma unroll
    for (int i = 0; i < 8; ++i) { const f32x4 a = p[i]; s += (a[0] + a[1]) + (a[2] + a[3]); }
    s += __shfl_xor(s, 1);
    if (hf == 0) tab[row] = __builtin_amdgcn_rsqf(s * (1.0f / 4096.0f) + eps);
    __syncthreads();
}
template <bool BASE_BF16, bool OUT_BF16, bool BASE_BLK = false, bool OUT_BLK = false> struct EpiRes {
    static constexpr bool PERM = true, AFTER_DRAIN = false;
    const void* base; void* out; int ldc; float* part; int row_off;
    __device__ __forceinline__ void operator()(const f32x4 (&acc)[2][2][4][2], const Unit& u, int wr, int wc, int fr, int fq) const {
        const int row0 = row_off + u.pm * BM + wr * 64 + fr, col0 = u.pn * BM + wc * 32 + 8 * fq;
        const int rb0 = (row_off >> 4) + u.pm * 16 + wr * 4, cb0 = u.pn * 8 + wc;
#pragma unroll
        for (int ai = 0; ai < 2; ++ai) {
            f32x4 b0[4][2], b1[4][2];
#pragma unroll
            for (int m = 0; m < 4; ++m)
#pragma unroll
                for (int bj = 0; bj < 2; ++bj) { const size_t off = BASE_BLK ? ((size_t)(rb0 + ai * 8 + m) * (ldc / 32) + cb0 + bj * 4) * 512 + fr * 32 + 8 * fq : (size_t)(row0 + ai * HALF + m * 16) * ldc + col0 + bj * HALF;
                    if constexpr (BASE_BF16) { const u32x4 w = *(const u32x4*)((const bf16_t*)base + off);
                        b0[m][bj] = (f32x4){__uint_as_float(w.x << 16), __uint_as_float(w.x & 0xffff0000u), __uint_as_float(w.y << 16), __uint_as_float(w.y & 0xffff0000u)};
                        b1[m][bj] = (f32x4){__uint_as_float(w.z << 16), __uint_as_float(w.z & 0xffff0000u), __uint_as_float(w.w << 16), __uint_as_float(w.w & 0xffff0000u)}; }
                    else { b0[m][bj] = *(const f32x4*)((const float*)base + off); b1[m][bj] = *(const f32x4*)((const float*)base + off + 4); } }
#pragma unroll
            for (int m = 0; m < 4; ++m) { const int row = row0 + ai * HALF + m * 16; float ss = 0.f;
#pragma unroll
                for (int bj = 0; bj < 2; ++bj) { const size_t off = OUT_BLK ? ((size_t)(rb0 + ai * 8 + m) * (ldc / 32) + cb0 + bj * 4) * 512 + fr * 32 + 8 * fq : (size_t)row * ldc + col0 + bj * HALF;
                    const f32x4 o0 = b0[m][bj] + acc[ai][bj][m][0], o1 = b1[m][bj] + acc[ai][bj][m][1];
                    ss += ((o0[0] * o0[0] + o0[1] * o0[1]) + (o0[2] * o0[2] + o0[3] * o0[3])) + ((o1[0] * o1[0] + o1[1] * o1[1]) + (o1[2] * o1[2] + o1[3] * o1[3]));
                    if constexpr (OUT_BF16) { u32x4 w; w.x = cvt_pk_bf16(o0[0], o0[1]); w.y = cvt_pk_bf16(o0[2], o0[3]); w.z = cvt_pk_bf16(o1[0], o1[1]); w.w = cvt_pk_bf16(o1[2], o1[3]);
                        *(u32x4*)((bf16_t*)out + off) = w; }
                    else { *(f32x4*)((float*)out + off) = o0; *(f32x4*)((float*)out + off + 4) = o1; } }
                ss += __shfl_xor(ss, 16); ss += __shfl_xor(ss, 32);
                if (fq == 0) part[(size_t)row * 64 + u.pn * 4 + wc] = ss; }
            asm volatile("" ::: "memory"); }
    }
};
struct EpiSoftmax {
    static constexpr bool PERM = true, AFTER_DRAIN = true;
    bf16_t* O; int ldc; const float* part; float eps;
    __device__ __forceinline__ void fused(f32x4 (&acc)[2][2][4][2], const Unit& u, int wr, int wc, int fr, int fq, PG8_LAS unsigned char* lds, int wid, int lane) const {
        PG8_LAS float* R = (PG8_LAS float*)lds;
        PG8_LAS f32x2* X = (PG8_LAS f32x2*)(lds + 1024);
        const int tid = wid * 64 + lane;
        {   const int row = tid >> 1, hf = tid & 1; const f32x4* p = (const f32x4*)(part + (size_t)(u.pm * BM + row) * 64 + hf * 32); float s = 0.f;
#pragma unroll
            for (int i = 0; i < 8; ++i) { const f32x4 a = p[i]; s += (a[0] + a[1]) + (a[2] + a[3]); }
            s += __shfl_xor(s, 1);
            if (hf == 0) R[row] = __builtin_amdgcn_rsqf(s * (1.0f / 4096.0f) + eps) * 1.4426950408889634f; }
        asm volatile("s_waitcnt lgkmcnt(0)" ::: "memory"); __builtin_amdgcn_s_barrier(); asm volatile("" ::: "memory");
        float mw[2][4];
#pragma unroll
        for (int ai = 0; ai < 2; ++ai)
#pragma unroll
            for (int m = 0; m < 4; ++m) { const int r = ai * HALF + wr * 64 + m * 16 + fr; const float rs = R[r]; float mx = -3.0e38f;
#pragma unroll
                for (int bj = 0; bj < 2; ++bj)
#pragma unroll
                    for (int n = 0; n < 2; ++n) { acc[ai][bj][m][n] = acc[ai][bj][m][n] * rs; const f32x4 x = acc[ai][bj][m][n]; mx = fmaxf(mx, fmaxf(fmaxf(x[0], x[1]), fmaxf(x[2], x[3]))); }
                mx = fmaxf(mx, __shfl_xor(mx, 16)); mx = fmaxf(mx, __shfl_xor(mx, 32)); mw[ai][m] = mx; float s = 0.f;
#pragma unroll
                for (int bj = 0; bj < 2; ++bj)
#pragma unroll
                    for (int n = 0; n < 2; ++n) { f32x4 x = acc[ai][bj][m][n];
#pragma unroll
                        for (int j = 0; j < 4; ++j) { x[j] = __builtin_amdgcn_exp2f(x[j] - mx); s += x[j]; }
                        acc[ai][bj][m][n] = x; }
                s += __shfl_xor(s, 16); s += __shfl_xor(s, 32);
                if (fq == 0) X[r * 4 + wc] = (f32x2){mx, s}; }
        asm volatile("s_waitcnt lgkmcnt(0)" ::: "memory"); __builtin_amdgcn_s_barrier(); asm volatile("" ::: "memory");
        const int row0 = u.pm * BM + wr * 64 + fr, col0 = u.pn * BM + wc * 32 + 8 * fq;
#pragma unroll
        for (int ai = 0; ai < 2; ++ai)
#pragma unroll
            for (int m = 0; m < 4; ++m) { const int r = ai * HALF + wr * 64 + m * 16 + fr;
                const f32x2 a = X[r * 4 + 0], b = X[r * 4 + 1], c = X[r * 4 + 2], d = X[r * 4 + 3];
                const float M = fmaxf(fmaxf(a.x, b.x), fmaxf(c.x, d.x));
                const float S = a.y * __builtin_amdgcn_exp2f(a.x - M) + b.y * __builtin_amdgcn_exp2f(b.x - M) + c.y * __builtin_amdgcn_exp2f(c.x - M) + d.y * __builtin_amdgcn_exp2f(d.x - M);
                const float f = __builtin_amdgcn_exp2f(mw[ai][m] - M) / S;
                bf16_t* rowp = O + (size_t)(row0 + ai * HALF + m * 16) * ldc + col0;
#pragma unroll
                for (int bj = 0; bj < 2; ++bj) { const f32x4 v0 = acc[ai][bj][m][0] * f, v1 = acc[ai][bj][m][1] * f;
                    u32x4 w; w.x = cvt_pk_bf16(v0[0], v0[1]); w.y = cvt_pk_bf16(v0[2], v0[3]); w.z = cvt_pk_bf16(v1[0], v1[1]); w.w = cvt_pk_bf16(v1[2], v1[3]);
                    *(u32x4*)(rowp + bj * HALF) = w; } }
    }
};

template <class Map, class Epi, class Sched, bool ALIGN_EPI = false, bool SP2 = false>
__device__ __forceinline__ void gemm_phase(PG8_LAS unsigned char* lds, const Map G, const Sched& S, const Epi& E, const int wid_) {
    const int wid = wid_ & 7, lane = hw_lane(), tid = wid * 64 + lane, wr = wid >> 2, wc = wid & 3, fr = lane & 15, fq = lane >> 4;
    const int nt = G.K / BK;
    unsigned voffA[2], voffB[2];
#pragma unroll
    for (int i = 0; i < 2; ++i) { int R, C; stage_rc(tid * 16 + i * 8192, R, C); const int Rb = Epi::PERM ? ((R & ~31) + perm32(R & 31)) : R;
        voffA[i] = G.voffA(R, C); voffB[i] = G.voffB(Rb, C); }
    const size_t kstepA = G.kstepA(), kstepB = G.kstepB();
    const size_t hstepA = G.hstepA(), hstepB = G.hstepB();
    const unsigned ldsw = (unsigned)wid * 1024u;
    const int aoff = lds_byte(wr * 64 + fr, fq * 8), boff = lds_byte(wc * 32 + fr, fq * 8);
#define PG8_SA(b, h) (((b) * 2 + (h)) * HTB)
#define PG8_SB(b, h) ((4 + (b) * 2 + (h)) * HTB)
#define PG8_STAGE(bufoff, gbase, voff) do { _Pragma("unroll") for (int _i = 0; _i < 2; ++_i) \
        __builtin_amdgcn_global_load_lds((const unsigned*)((const char*)(gbase) + (voff)[_i]), (PG8_LAS unsigned*)(lds + (bufoff) + ldsw + _i * 8192), 16, 0, 0); } while (0)
#define PG8_LDA(dst, b, h) do { _Pragma("unroll") for (int m = 0; m < 4; ++m) _Pragma("unroll") for (int k = 0; k < 2; ++k) dst[m][k] = *(const PG8_LAS bf16x8*)(lds + PG8_SA(b, h) + aoff + m * 2048 + k * 1024); } while (0)
#define PG8_LDB(dst, b, h) do { _Pragma("unroll") for (int n = 0; n < 2; ++n) _Pragma("unroll") for (int k = 0; k < 2; ++k) dst[n][k] = *(const PG8_LAS bf16x8*)(lds + PG8_SB(b, h) + boff + n * 2048 + k * 1024); } while (0)
#define PG8_MMA(ai, bj, At, Bt) do { __builtin_amdgcn_s_setprio(1); _Pragma("unroll") for (int m = 0; m < 4; ++m) _Pragma("unroll") for (int n = 0; n < 2; ++n) _Pragma("unroll") for (int k = 0; k < 2; ++k) \
        acc[ai][bj][m][n] = __builtin_amdgcn_mfma_f32_16x16x32_bf16(Bt[n][k], At[m][k], acc[ai][bj][m][n], 0, 0, 0); __builtin_amdgcn_s_setprio(0); } while (0)
#define PG8_WAIT_V(n) asm volatile("s_waitcnt vmcnt(" #n ")" ::: "memory")
#define PG8_WAIT_L(n) asm volatile("s_waitcnt lgkmcnt(" #n ")" ::: "memory")
#define PG8_BAR __builtin_amdgcn_s_barrier()
#define PG8_SCHED __builtin_amdgcn_sched_barrier(0)
    Unit cur, nxt; int ui = 0;
    if (!S.next(0, cur)) return;
    f32x4 acc[2][2][4][2];
#pragma unroll
    for (int a = 0; a < 2; ++a)
#pragma unroll
        for (int b = 0; b < 2; ++b)
#pragma unroll
            for (int m = 0; m < 4; ++m)
#pragma unroll
                for (int n = 0; n < 2; ++n) acc[a][b][m][n] = (f32x4){0.f, 0.f, 0.f, 0.f};
    bf16x8 At[4][2], B0[2][2], B1[2][2];
    const char* cA = G.a_base(cur); const char* cB = G.b_base(cur);
    if constexpr (SP2) {
        PG8_STAGE(PG8_SB(0, 0), cB, voffB); PG8_STAGE(PG8_SB(0, 1), cB + hstepB, voffB); PG8_STAGE(PG8_SA(0, 0), cA, voffA); PG8_STAGE(PG8_SA(0, 1), cA + hstepA, voffA);
        if (wr == 1) PG8_BAR;
        PG8_WAIT_V(2); PG8_BAR;
        PG8_STAGE(PG8_SB(1, 0), cB + kstepB, voffB); PG8_STAGE(PG8_SA(1, 0), cA + kstepA, voffA); PG8_STAGE(PG8_SB(1, 1), cB + hstepB + kstepB, voffB);
        PG8_WAIT_V(6); PG8_BAR;
    } else {
        PG8_STAGE(PG8_SB(0, 0), cB, voffB); PG8_STAGE(PG8_SA(0, 0), cA, voffA); PG8_STAGE(PG8_SB(0, 1), cB + hstepB, voffB); PG8_STAGE(PG8_SA(0, 1), cA + hstepA, voffA);
        if (wr == 1) PG8_BAR;
        PG8_WAIT_V(4); PG8_BAR;
        PG8_STAGE(PG8_SB(1, 0), cB + kstepB, voffB); PG8_STAGE(PG8_SA(1, 0), cA + kstepA, voffA); PG8_STAGE(PG8_SB(1, 1), cB + hstepB + kstepB, voffB);
        PG8_WAIT_V(6); PG8_BAR;
    }
    for (;;) {
        const bool has_next = S.next(ui + 1, nxt);
        const char* nA = has_next ? G.a_base(nxt) : cA; const char* nB = has_next ? G.b_base(nxt) : cB;
        for (int t = 0; t < nt; t += 2) {
            const bool last = (t == nt - 2);
            const char* a1 = cA + (size_t)(t + 1) * kstepA;
            const char* a2 = last ? nA : cA + (size_t)(t + 2) * kstepA; const char* b2 = last ? nB : cB + (size_t)(t + 2) * kstepB;
            const char* a3 = a2 + kstepA; const char* b3 = b2 + kstepB;
            if constexpr (SP2) {
            PG8_LDB(B0, 0, 0); PG8_LDB(B1, 0, 1); PG8_SCHED; PG8_LDA(At, 0, 0); PG8_STAGE(PG8_SA(1, 1), a1 + hstepA, voffA);
            PG8_WAIT_V(8); PG8_WAIT_L(0); PG8_BAR; PG8_MMA(0, 0, At, B0); PG8_MMA(0, 1, At, B1); PG8_BAR; PG8_SCHED;
            PG8_LDA(At, 0, 1); PG8_STAGE(PG8_SB(0, 0), b2, voffB); PG8_STAGE(PG8_SB(0, 1), b2 + hstepB, voffB); PG8_STAGE(PG8_SA(0, 0), a2, voffA);
            PG8_WAIT_V(8); PG8_WAIT_L(0); PG8_BAR; PG8_MMA(1, 0, At, B0); PG8_MMA(1, 1, At, B1); PG8_BAR; PG8_SCHED;
            PG8_LDB(B0, 1, 0); PG8_LDB(B1, 1, 1); PG8_SCHED; PG8_LDA(At, 1, 0); PG8_STAGE(PG8_SA(0, 1), a2 + hstepA, voffA);
            PG8_WAIT_V(8); PG8_WAIT_L(0); PG8_BAR; PG8_MMA(0, 0, At, B0); PG8_MMA(0, 1, At, B1); PG8_BAR; PG8_SCHED;
            PG8_LDA(At, 1, 1); PG8_STAGE(PG8_SB(1, 0), b3, voffB); PG8_STAGE(PG8_SB(1, 1), b3 + hstepB, voffB); PG8_STAGE(PG8_SA(1, 0), a3, voffA);
            PG8_WAIT_V(8); PG8_WAIT_L(0); PG8_BAR; PG8_MMA(1, 0, At, B0); PG8_MMA(1, 1, At, B1); PG8_BAR; PG8_SCHED;
            } else {
            PG8_LDB(B0, 0, 0); PG8_SCHED; PG8_LDA(At, 0, 0); PG8_STAGE(PG8_SA(1, 1), a1 + hstepA, voffA);
            PG8_WAIT_L(8); PG8_BAR; PG8_WAIT_L(0); PG8_MMA(0, 0, At, B0); PG8_BAR; PG8_SCHED;
            PG8_LDB(B1, 0, 1); PG8_STAGE(PG8_SB(0, 0), b2, voffB);
            PG8_BAR; PG8_WAIT_L(0); PG8_MMA(0, 1, At, B1); PG8_BAR;
            PG8_LDA(At, 0, 1); PG8_STAGE(PG8_SA(0, 0), a2, voffA);
            PG8_BAR; PG8_WAIT_L(0); PG8_MMA(1, 0, At, B0); PG8_BAR; PG8_SCHED;
            PG8_STAGE(PG8_SB(0, 1), b2 + hstepB, voffB);
            PG8_WAIT_V(6); PG8_BAR; PG8_MMA(1, 1, At, B1); PG8_BAR;
            PG8_LDB(B0, 1, 0); PG8_SCHED; PG8_LDA(At, 1, 0); PG8_STAGE(PG8_SA(0, 1), a2 + hstepA, voffA);
            PG8_WAIT_L(8); PG8_BAR; PG8_WAIT_L(0); PG8_MMA(0, 0, At, B0); PG8_BAR; PG8_SCHED;
            PG8_LDB(B1, 1, 1); PG8_STAGE(PG8_SB(1, 0), b3, voffB);
            PG8_BAR; PG8_WAIT_L(0); PG8_MMA(0, 1, At, B1); PG8_BAR;
            PG8_LDA(At, 1, 1); PG8_STAGE(PG8_SA(1, 0), a3, voffA);
            PG8_BAR; PG8_WAIT_L(0); PG8_MMA(1, 0, At, B0); PG8_BAR; PG8_SCHED;
            PG8_STAGE(PG8_SB(1, 1), b3 + hstepB, voffB);
            PG8_WAIT_V(6); PG8_BAR; PG8_MMA(1, 1, At, B1); PG8_BAR;
            }
        }
        if constexpr (ALIGN_EPI) { if (wr == 0) PG8_BAR; }
        if constexpr (!Epi::AFTER_DRAIN) { E(acc, cur, wr, wc, fr, fq); }
        if (!has_next) break;
#pragma unroll
        for (int a = 0; a < 2; ++a)
#pragma unroll
            for (int b = 0; b < 2; ++b)
#pragma unroll
                for (int m = 0; m < 4; ++m)
#pragma unroll
                    for (int n = 0; n < 2; ++n) acc[a][b][m][n] = (f32x4){0.f, 0.f, 0.f, 0.f};
        cur = nxt; cA = nA; cB = nB; ++ui;
        if constexpr (ALIGN_EPI) { if (wr == 1) PG8_BAR; }
    }
    PG8_WAIT_V(0);
    if constexpr (!ALIGN_EPI) { if (wr == 0) PG8_BAR; }
    PG8_BAR;
    if constexpr (Epi::AFTER_DRAIN) { E.fused(acc, cur, wr, wc, fr, fq, lds, wid, lane); }
#undef PG8_SA
#undef PG8_SB
#undef PG8_STAGE
#undef PG8_LDA
#undef PG8_LDB
#undef PG8_MMA
#undef PG8_WAIT_V
#undef PG8_WAIT_L
#undef PG8_BAR
#undef PG8_SCHED
}
}

namespace att {
typedef unsigned short bf16;
typedef short bf16x8 __attribute__((ext_vector_type(8)));
typedef short s16x4 __attribute__((ext_vector_type(4)));
typedef float f32x16 __attribute__((ext_vector_type(16)));
typedef float f32x4 __attribute__((ext_vector_type(4)));
typedef unsigned u32x4 __attribute__((ext_vector_type(4)));
constexpr int D = 128, NW = 8, QBLK = 32, KVBLK = 64, QB = NW * QBLK;
constexpr float SCALE = 0.08838834764831845f;
constexpr float THR = 8.f;
constexpr int SHM_V = KVBLK * D * 2, SHM_K = KVBLK * D * 2;
constexpr int OFF_SCR = 2 * SHM_V + 2 * SHM_K, OFF_TAB = OFF_SCR + NW * 64 * 4, OFF_Q = OFF_TAB + 2 * 16384, LDS_BYTES = OFF_Q + NW * 4096;

#define KSWZ(row, colB) ((row) * 256 + ((colB) ^ (((row) & 7) << 4)))
#define SBAR() __builtin_amdgcn_sched_barrier(0)
__device__ __forceinline__ int v_st(int k, int c) { const int kk = (k & ~0xC) | ((k & 4) << 1) | ((k & 8) >> 1); return ((kk >> 3) * 4 + (c >> 5)) * 512 + ((kk & 7) * 32 + (c & 31)) * 2; }
__device__ __forceinline__ int v_rd_base(int lane) { return ((lane & 3) << 3) | (((lane >> 2) & 3) << 6) | (((lane >> 4) & 1) << 5) | (((lane >> 5) & 1) << 8); }
constexpr int v_rd_off(int d0, int ks, int half) { return d0 * 512 + ks * 4096 + half * 2048; }
__device__ __forceinline__ int crow(int r, int hi) { return (r & 3) + 8 * (r >> 2) + 4 * hi; }
__device__ __forceinline__ unsigned cvtpk(float lo, float hi) { unsigned r; asm volatile("v_cvt_pk_bf16_f32 %0, %1, %2" : "=v"(r) : "v"(lo), "v"(hi)); return r; }
__device__ __forceinline__ bf16x8 ld8(const bf16* p) { return *reinterpret_cast<const bf16x8*>(p); }

__device__ __forceinline__ void mask_tile(f32x16& p0, f32x16& p1, int dq) {
    const float NEG = -__builtin_inff();
#pragma unroll
    for (int r = 0; r < 16; ++r) {
        const int c = (r & 3) + 8 * (r >> 2);
        if (dq - c < 0) p0[r] = NEG;
        if (dq - c - 32 < 0) p1[r] = NEG;
    }
}
__device__ __forceinline__ void diff_bias(f32x16& p0, f32x16& p1, const float* tl, int kb) {
    const float* t = tl + kb;
#pragma unroll
    for (int g = 0; g < 4; ++g) {
#pragma unroll
        for (int j = 0; j < 4; ++j) { const int c = j + 8 * g; p0[4 * g + j] += t[c]; p1[4 * g + j] += t[c + 32]; }
        asm volatile("" ::: "memory"); }
}
__device__ __forceinline__ void partialSM(f32x16& p0, f32x16& p1, float& m_reg, float& mn, float& alpha) {
    float pmax = fmaxf(p0[0], p1[0]);
#pragma unroll
    for (int r = 1; r < 16; ++r) pmax = __builtin_fmaxf(__builtin_fmaxf(pmax, p0[r]), p1[r]);
    { auto rr = __builtin_amdgcn_permlane32_swap(__float_as_uint(pmax), __float_as_uint(pmax), false, false);
      pmax = fmaxf(__uint_as_float(rr[0]), __uint_as_float(rr[1])); }
    constexpr float C2 = 1.4426950408889634f * SCALE;
    if (__builtin_expect(__all((pmax - m_reg) * SCALE <= THR), 1)) { mn = m_reg; alpha = 1.f; }
    else { mn = fmaxf(m_reg, pmax); alpha = __builtin_amdgcn_exp2f((m_reg - mn) * C2); m_reg = mn; }
    const float mnL = -mn * C2;
    for (int r = 0; r < 16; ++r) p0[r] = fmaf(p0[r], C2, mnL); for (int r = 0; r < 16; ++r) p1[r] = fmaf(p1[r], C2, mnL);
    for (int r = 0; r < 16; ++r) p0[r] = __builtin_amdgcn_exp2f(p0[r]);
}
__device__ __forceinline__ void finishSM(f32x16& p0, f32x16& p1, float alpha, float& l_reg, bf16x8& pa0, bf16x8& pa1, bf16x8& pa2, bf16x8& pa3) {
    for (int r = 0; r < 16; ++r) p1[r] = __builtin_amdgcn_exp2f(p1[r]);
    float ps = 0; for (int r = 0; r < 16; ++r) ps += p0[r]; for (int r = 0; r < 16; ++r) ps += p1[r];
    { auto rr = __builtin_amdgcn_permlane32_swap(__float_as_uint(ps), __float_as_uint(ps), false, false);
      ps = __uint_as_float(rr[0]) + __uint_as_float(rr[1]); }
    l_reg = l_reg * alpha + ps;
#define PK4(P, B_, OUT) do { unsigned a0 = cvtpk(P[B_+0], P[B_+1]), a1 = cvtpk(P[B_+2], P[B_+3]);                          \
        unsigned b0 = cvtpk(P[B_+4], P[B_+5]), b1 = cvtpk(P[B_+6], P[B_+7]);                                             \
        auto r0 = __builtin_amdgcn_permlane32_swap(a0, b0, false, false); auto r1 = __builtin_amdgcn_permlane32_swap(a1, b1, false, false); \
        u32x4 w = {r0[0], r1[0], r0[1], r1[1]}; OUT = *reinterpret_cast<bf16x8*>(&w); } while (0)
    PK4(p0, 0, pa0); PK4(p0, 8, pa1); PK4(p1, 0, pa2); PK4(p1, 8, pa3);
#undef PK4
}
template <int KB, int MODE, int QR = 4>
__device__ __forceinline__ void qkt(f32x16& p0, f32x16& p1, const char* K_lds, int r32, int hi, const bf16x8* qr, const char* qsl, const float* tabk) {
    p0 = f32x16{}; p1 = f32x16{};
    float x0 = 0.f, x1 = 0.f;
    if (MODE == 0) { x0 = tabk[0]; x1 = tabk[32]; }
    const char* kb[4];
#pragma unroll
    for (int dd = 0; dd < 4; ++dd) kb[dd] = K_lds + KB * SHM_K + KSWZ(r32, (dd * 16 + hi * 8) * 2);
#pragma unroll
    for (int d0 = 0; d0 < 8; ++d0) { const char* a = kb[d0 & 3] + (d0 >> 2) * 128;
        bf16x8 b0 = *reinterpret_cast<const bf16x8*>(a);
        bf16x8 b1 = *reinterpret_cast<const bf16x8*>(a + 32 * 256);
        const bf16x8 qv = (d0 < QR) ? qr[d0 < QR ? d0 : 0] : *reinterpret_cast<const bf16x8*>(qsl + (d0 - QR) * 1024);
        p0 = __builtin_amdgcn_mfma_f32_32x32x16_bf16(b0, qv, p0, 0, 0, 0);
        p1 = __builtin_amdgcn_mfma_f32_32x32x16_bf16(b1, qv, p1, 0, 0, 0); }
    if (MODE == 0) {
        const unsigned ua = __float_as_uint(x0), a1 = ua & 0xffff0000u; const float ra = x0 - __uint_as_float(a1); const unsigned a2 = __float_as_uint(ra) & 0xffff0000u; const float rb = ra - __uint_as_float(a2);
        const unsigned ub = __float_as_uint(x1), b1 = ub & 0xffff0000u; const float rc = x1 - __uint_as_float(b1); const unsigned b2 = __float_as_uint(rc) & 0xffff0000u; const float rd = rc - __uint_as_float(b2);
        u32x4 ka = {hi ? 0u : ((a1 >> 16) | a2), hi ? 0u : (__float_as_uint(rb) >> 16), 0u, 0u};
        u32x4 kb2 = {hi ? 0u : ((b1 >> 16) | b2), hi ? 0u : (__float_as_uint(rd) >> 16), 0u, 0u};
        const u32x4 qx = {0x3f803f80u, 0x00003f80u, 0u, 0u};
        p0 = __builtin_amdgcn_mfma_f32_32x32x16_bf16(*reinterpret_cast<bf16x8*>(&ka), *reinterpret_cast<const bf16x8*>(&qx), p0, 0, 0, 0);
        p1 = __builtin_amdgcn_mfma_f32_32x32x16_bf16(*reinterpret_cast<bf16x8*>(&kb2), *reinterpret_cast<const bf16x8*>(&qx), p1, 0, 0, 0);
    }
}
template <int VB>
__device__ __forceinline__ void pv_tile(f32x16* o, int vb0, bf16x8 pa0, bf16x8 pa1, bf16x8 pa2, bf16x8 pa3) {
#define TRRD(dst, off) asm volatile("ds_read_b64_tr_b16 %0, %1 offset:%2" : "=&v"(dst) : "v"(vb0), "i"(off) : "memory")
#define PV_D0(d0) do { s16x4 l0, l1, l2, l3, h0, h1, h2, h3; constexpr int b_ = VB * SHM_V + v_rd_off(d0, 0, 0); \
        TRRD(l0, b_); TRRD(h0, b_ + 2048); TRRD(l1, b_ + 4096); TRRD(h1, b_ + 6144); TRRD(l2, b_ + 8192); TRRD(h2, b_ + 10240); TRRD(l3, b_ + 12288); TRRD(h3, b_ + 14336); \
        asm volatile("s_waitcnt lgkmcnt(0)" ::: "memory"); SBAR();   \
        o[d0] = __builtin_amdgcn_mfma_f32_32x32x16_bf16(pa0, (bf16x8){l0[0], l0[1], l0[2], l0[3], h0[0], h0[1], h0[2], h0[3]}, o[d0], 0, 0, 0);   \
        o[d0] = __builtin_amdgcn_mfma_f32_32x32x16_bf16(pa1, (bf16x8){l1[0], l1[1], l1[2], l1[3], h1[0], h1[1], h1[2], h1[3]}, o[d0], 0, 0, 0);   \
        o[d0] = __builtin_amdgcn_mfma_f32_32x32x16_bf16(pa2, (bf16x8){l2[0], l2[1], l2[2], l2[3], h2[0], h2[1], h2[2], h2[3]}, o[d0], 0, 0, 0);   \
        o[d0] = __builtin_amdgcn_mfma_f32_32x32x16_bf16(pa3, (bf16x8){l3[0], l3[1], l3[2], l3[3], h3[0], h3[1], h3[2], h3[3]}, o[d0], 0, 0, 0); } while (0)
    PV_D0(0); PV_D0(1); PV_D0(2); PV_D0(3);
#undef PV_D0
#undef TRRD
}

struct BlockRef { const bf16* Q; const bf16* K; const bf16* V; void* O; const float* tab; int P0; int kb0; float kmax2; int tabn; int c; float lam; const float* gs; float* scr; };
struct Seam { bf16x8 qr[8]; bf16x8 st_v0, st_v1, st_k0, st_k1; int tb; };
#define ROW(p, k0, rr) ((p) + (size_t)((k0) + (rr)) * D + sc)
#define VMW() asm volatile("s_waitcnt vmcnt(0)" ::: "memory")
#define VMWN(n) asm volatile("s_waitcnt vmcnt(%0)" :: "i"(n) : "memory")
#define SLOAD_H(Kp, Vp, k0) do { S.st_v0 = ld8(ROW(Vp, k0, sr)); S.st_v1 = ld8(ROW(Vp, k0, 32 + sr));              \
                         S.st_k0 = ld8(ROW(Kp, k0, sr)); S.st_k1 = ld8(ROW(Kp, k0, 32 + sr)); } while (0)
#define SWRITE_HK(bf) do { *(bf16x8*)(K_lds + (bf) * SHM_K + kws) = S.st_k0; *(bf16x8*)(K_lds + (bf) * SHM_K + kws + 32 * 256) = S.st_k1; } while (0)
#define SWRITE_HV(bf) do { *(bf16x8*)(V_lds + (bf) * SHM_V + vst0) = S.st_v0; *(bf16x8*)(V_lds + (bf) * SHM_V + vst1) = S.st_v1; } while (0)
#define SWRITE_H(bf) do { SWRITE_HV(bf); SWRITE_HK(bf); } while (0)
__device__ __forceinline__ void attn_prime(const BlockRef& cur, char* lds, Seam& S, const int wid_) {
    const int wid = wid_ & 7, lane = pg8::hw_lane(), tid = wid * 64 + lane, r32 = lane & 31, hi = lane >> 5;
    const int sr = tid >> 4, sc = (tid & 15) * 8, kws = KSWZ(sr, sc * 2); char* K_lds = lds + 2 * SHM_V;
#pragma unroll
    for (int d0 = 0; d0 < 8; ++d0) S.qr[d0] = ld8(cur.Q + (size_t)(wid * QBLK + r32) * D + d0 * 16 + hi * 8);
    SLOAD_H(cur.K, cur.V, cur.kb0); VMW(); SWRITE_HK(0);
    S.tb = 0; { float* tabL = (float*)(lds + OFF_TAB); for (int i = tid * 4; i < cur.tabn; i += 2048) *(f32x4*)(tabL + i) = *(const f32x4*)(cur.tab + i); }
    __syncthreads();
}
template <int MODE>
__device__ __forceinline__ void attn_block(const BlockRef& cur, const BlockRef& nxt, char* lds, Seam& S, const int wid_) {
    const int wid = wid_ & 7, lane = pg8::hw_lane(), tid = wid * 64 + lane, r32 = lane & 31, hi = lane >> 5;
    constexpr int ldo = MODE ? 2048 : 4096;
    int NT = cur.P0 / KVBLK + 4;
    const int jtop = NT - 1;
    const int qlo = cur.P0 + wid * QBLK, row = qlo + r32;
    const int qlo_m = MODE ? (qlo | 63) : qlo;
    const int qm = (MODE ? (row | 63) : row) - 4 * hi;
    char* V_lds = lds; char* K_lds = lds + 2 * SHM_V;
    float* ws = (float*)(lds + OFF_SCR) + wid * 64; float* li_l = ws, * al_l = ws + 32;
    float* tabL = (float*)(lds + OFF_TAB + S.tb * 16384);
    float qn2 = 0.f;
    if (MODE == 0) {
#pragma unroll
        for (int d0 = 0; d0 < 8; ++d0)
#pragma unroll
            for (int e = 0; e < 8; ++e) { const float f = __uint_as_float((unsigned)(unsigned short)S.qr[d0][e] << 16); qn2 += f * f; }
        auto rr = __builtin_amdgcn_permlane32_swap(__float_as_uint(qn2), __float_as_uint(qn2), false, false); qn2 = __uint_as_float(rr[0]) + __uint_as_float(rr[1]); }
    char* qsl = lds + OFF_Q + wid * 4096 + lane * 16;
#pragma unroll
    for (int j = 0; j < 4; ++j) *(bf16x8*)(qsl + j * 1024) = S.qr[4 + j];
    if (MODE == 0) {
        const float X = 2.0f * sqrtf(qn2 * cur.kmax2) - tabL[row];
        float xm = X;
#pragma unroll
        for (int o_ = 1; o_ < 64; o_ <<= 1) xm = fmaxf(xm, __shfl_xor(xm, o_));
        if (lane == 0) li_l[0] = xm;
        __syncthreads();
        float xb = -3.0e38f;
#pragma unroll
        for (int w = 0; w < NW; ++w) xb = fmaxf(xb, ((float*)(lds + OFF_SCR))[w * 64]);
        const float thr = -164.0f / (1.4426950408889634f * SCALE) - xb;
        int lo = 0, hi_ = jtop;
        while (lo < hi_) { const int mid = (lo + hi_) >> 1; if (tabL[64 * mid + 63] < thr) lo = mid + 1; else hi_ = mid; }
        NT = jtop - lo + 1;
        __syncthreads();
    }
    const float* tl = MODE ? (tabL + (192 + 4 * hi - row)) : (tabL + r32);
    float m_reg = -1e30f, l_reg = 0; f32x16 o[4] = {};
    const int sr = tid >> 4, sc = (tid & 15) * 8, vst0 = v_st(sr, sc), vst1 = v_st(32 + sr, sc), kws = KSWZ(sr, sc * 2);
    const int vb0 = (int)(uintptr_t)V_lds + v_rd_base(lane);
    const bf16* Kh = cur.K; const bf16* Vh = cur.V;
#define RESC(a) do { if (__any((a) < 1.f)) { if (hi == 0) al_l[r32] = (a); asm volatile("s_waitcnt lgkmcnt(0)" ::: "memory");              \
                     for (int d_ = 0; d_ < 4; ++d_) for (int r = 0; r < 16; ++r) o[d_][r] *= al_l[crow(r, hi)]; } } while (0)
#define KBASE(t) (MODE == 0 ? (jtop - (t)) * KVBLK : (t) * KVBLK)
#define MASKT(P0_, P1_, t) do { const int kb_ = KBASE(t);                                                                    \
        if (MODE == 1) { if (kb_ >= qlo - 153 && kb_ <= qlo_m) diff_bias(P0_, P1_, tl, kb_); }                              \
        if (kb_ + KVBLK - 1 > qlo_m) mask_tile(P0_, P1_, qm - kb_); } while (0)
    constexpr int NQL = 8;
#define SEAM_K0() do { VMWN(NQL); SWRITE_HK(0); SBAR(); } while (0)
    f32x16 pA0, pA1, pB0, pB1; float mnA, mnB, alA, alB; bf16x8 pa0, pa1, pa2, pa3;
    SWRITE_HV(0); SBAR();
    if (NT > 1) { SLOAD_H(Kh, Vh, KBASE(1)); }
    SBAR(); qkt<0, MODE>(pA0, pA1, K_lds, r32, hi, S.qr, qsl, tl + KBASE(0));
    MASKT(pA0, pA1, 0); partialSM(pA0, pA1, m_reg, mnA, alA);
    if (NT > 1) { VMW(); SWRITE_HK(1); }
    __syncthreads();
#define HALF_STEP(PX0, PX1, mnX, alX, PY0, PY1, alY, t, KB, VB, SB) do {                                                      \
        SWRITE_HV(KB);                                                                                                        \
        if ((t) + 1 < NT) { SLOAD_H(Kh, Vh, KBASE((t) + 1)); }                                                                \
        SBAR(); qkt<KB, MODE>(PX0, PX1, K_lds, r32, hi, S.qr, qsl, tl + KBASE(t));                                           \
        finishSM(PY0, PY1, alY, l_reg, pa0, pa1, pa2, pa3); SBAR();                                                           \
        pv_tile<VB>(o, vb0, pa0, pa1, pa2, pa3); MASKT(PX0, PX1, (t)); partialSM(PX0, PX1, m_reg, mnX, alX);                  \
        if ((t) + 1 < NT) { VMW(); SWRITE_HK(SB); }                                                                           \
        RESC(alX); __syncthreads(); } while (0)
    for (int t = 1; t + 1 < NT; t += 2) {
        HALF_STEP(pB0, pB1, mnB, alB, pA0, pA1, alA, t, 1, 0, 0);
        HALF_STEP(pA0, pA1, mnA, alA, pB0, pB1, alB, t + 1, 0, 1, 1);
    }
    const bool even = (NT & 1) == 0;
    if (even) { SWRITE_HV(1); SBAR(); qkt<1, MODE>(pB0, pB1, K_lds, r32, hi, S.qr, qsl, tl + KBASE(NT - 1)); SBAR(); }
    SLOAD_H(nxt.K, nxt.V, nxt.kb0); SBAR();
#pragma unroll
    for (int d0 = 0; d0 < 4; ++d0) S.qr[d0] = ld8(nxt.Q + (size_t)(wid * QBLK + r32) * D + d0 * 16 + hi * 8);
    SBAR();
    finishSM(pA0, pA1, alA, l_reg, pa0, pa1, pa2, pa3); SBAR();
    pv_tile<0>(o, vb0, pa0, pa1, pa2, pa3);
    if (even) { MASKT(pB0, pB1, NT - 1); partialSM(pB0, pB1, m_reg, mnB, alB); __syncthreads(); RESC(alB);
        finishSM(pB0, pB1, alB, l_reg, pa0, pa1, pa2, pa3); SBAR(); pv_tile<1>(o, vb0, pa0, pa1, pa2, pa3); }
    SBAR();
#pragma unroll
    for (int d0 = 4; d0 < 8; ++d0) S.qr[d0] = ld8(nxt.Q + (size_t)(wid * QBLK + r32) * D + d0 * 16 + hi * 8);
    SBAR(); SEAM_K0();
    f32x4 tn0 = {0.f, 0.f, 0.f, 0.f}, tn1 = {0.f, 0.f, 0.f, 0.f};
    if (tid * 4 < nxt.tabn) tn0 = *(const f32x4*)(nxt.tab + tid * 4);
    if (tid * 4 + 2048 < nxt.tabn) tn1 = *(const f32x4*)(nxt.tab + tid * 4 + 2048);
    SBAR();
    if (hi == 0) li_l[r32] = l_reg; asm volatile("s_waitcnt lgkmcnt(0)" ::: "memory");
    float rli[16];
#pragma unroll
    for (int r = 0; r < 16; ++r) rli[r] = __builtin_amdgcn_rcpf(li_l[crow(r, hi)]);
    if (MODE == 0) { bf16* Ow = (bf16*)cur.O + (size_t)(wid * QBLK) * ldo;
#pragma unroll
        for (int r = 0; r < 16; ++r) { const int orow = crow(r, hi);
#pragma unroll
            for (int d0 = 0; d0 < 4; ++d0) { const float v = o[d0][r] * rli[r]; const float vn = __shfl_xor(v, 1);
                if ((r32 & 1) == 0) *(unsigned*)(Ow + (size_t)orow * ldo + d0 * 32 + r32) = cvtpk(v, vn); } } }
    else { bf16* Ow = (bf16*)cur.O + (size_t)(wid * QBLK) * ldo;
#pragma unroll
        for (int r = 0; r < 16; ++r) { const int orow = crow(r, hi);
#pragma unroll
            for (int d0 = 0; d0 < 4; ++d0) { const float v = o[d0][r] * rli[r]; const float vn = __shfl_xor(v, 1);
                if ((r32 & 1) == 0) *(unsigned*)(Ow + (size_t)orow * ldo + d0 * 32 + r32) = cvtpk(v, vn); } } }
    { float* tabN = (float*)(lds + OFF_TAB + (S.tb ^ 1) * 16384);
      if (tid * 4 < nxt.tabn) *(f32x4*)(tabN + tid * 4) = tn0;
      if (tid * 4 + 2048 < nxt.tabn) *(f32x4*)(tabN + tid * 4 + 2048) = tn1; }
    S.tb ^= 1;
    __syncthreads();
#undef RESC
#undef KBASE
#undef MASKT
#undef SEAM_K0
#undef HALF_STEP
}

constexpr int DQR = 4;
constexpr int D_OFF_V1 = OFF_TAB + 2048, D_OFF_Q = D_OFF_V1 + 2 * SHM_V, D_LDS_BYTES = D_OFF_Q + NW * (8 - DQR) * 1024;
constexpr int VHALF_B = 4096 * 128 * 2;
struct DSeam { bf16x8 qr[DQR]; int tb; };
#define DMA16(g, l) __builtin_amdgcn_global_load_lds((const unsigned*)(g), (PG8_LAS unsigned*)(l), 16, 0, 0)
#define D_LANE_OFFS()                                                                                                                  \
    const int grp = wid >> 2, wa_ = wid & 3;                    \
    const int krow_ = 4 * wa_ + (lane >> 4);                                                                                           \
    const unsigned koff = (unsigned)(krow_ * 256 + (((lane & 15) ^ (krow_ & 7)) << 4));                                                \
    const int vs_ = 2 * wa_ + (lane >> 5), vkk_ = (vs_ >> 2) * 8 + ((lane >> 2) & 7), vk_ = (vkk_ & ~0xC) | ((vkk_ & 4) << 1) | ((vkk_ & 8) >> 1); \
    const unsigned voff = (unsigned)(vk_ * 256 + ((vs_ & 3) * 32 + (lane & 3) * 8) * 2);                                               \
    PG8_LAS unsigned char* const kdst = ldsL + 2 * SHM_V + wa_ * 1024; PG8_LAS unsigned char* const vdst0 = ldsL + wa_ * 1024; PG8_LAS unsigned char* const vdst1 = ldsL + D_OFF_V1 + wa_ * 1024
#define DMA_K(Kp, key0, KB_) do { const char* g_ = (const char*)(Kp) + (size_t)(key0) * 256;                                           \
        _Pragma("unroll") for (int j_ = 0; j_ < 4; ++j_) DMA16(g_ + j_ * 4096 + koff, kdst + (KB_) * SHM_K + j_ * 4096); } while (0)
#define DMA_V(Vp, key0, VB_) do { const char* g_ = (const char*)(Vp) + (size_t)(key0) * 256;                                           \
        _Pragma("unroll") for (int j_ = 0; j_ < 4; ++j_) DMA16(g_ + j_ * 4096 + voff, vdst0 + (VB_) * SHM_V + j_ * 4096);                 \
        _Pragma("unroll") for (int j_ = 0; j_ < 4; ++j_) DMA16(g_ + (VHALF_B + j_ * 4096) + voff, vdst1 + (VB_) * SHM_V + j_ * 4096); } while (0)
__device__ __forceinline__ float dpp_xor1(float v) { return __int_as_float(__builtin_amdgcn_mov_dpp(__float_as_int(v), 0xB1, 0xF, 0xF, true)); }
__device__ __forceinline__ float half_sum32(float v) {
    v += __int_as_float(__builtin_amdgcn_mov_dpp(__float_as_int(v), 0xB1, 0xF, 0xF, true));
    v += __int_as_float(__builtin_amdgcn_mov_dpp(__float_as_int(v), 0x4E, 0xF, 0xF, true));
    v += __int_as_float(__builtin_amdgcn_mov_dpp(__float_as_int(v), 0x141, 0xF, 0xF, true));
    v += __int_as_float(__builtin_amdgcn_mov_dpp(__float_as_int(v), 0x140, 0xF, 0xF, true));
    { auto rr = __builtin_amdgcn_permlane16_swap(__float_as_uint(v), __float_as_uint(v), false, false); v = __uint_as_float(rr[0]) + __uint_as_float(rr[1]); }
    return v;
}
__device__ __forceinline__ void dattn_prime(const BlockRef& cur, char* lds, PG8_LAS unsigned char* ldsL, DSeam& S, const int wid_) {
    const int wid = wid_ & 7, lane = pg8::hw_lane(), tid = wid * 64 + lane, r32 = lane & 31, hi = lane >> 5;
    D_LANE_OFFS(); (void)voff; (void)vdst0; (void)vdst1;
    char* qsl = lds + D_OFF_Q + wid * ((8 - DQR) * 1024) + lane * 16;
#pragma unroll
    for (int d0 = 0; d0 < DQR; ++d0) S.qr[d0] = ld8(cur.Q + (size_t)(wid * QBLK + r32) * D + d0 * 16 + hi * 8);
#pragma unroll
    for (int d0 = DQR; d0 < 8; ++d0) { const bf16x8 t = ld8(cur.Q + (size_t)(wid * QBLK + r32) * D + d0 * 16 + hi * 8); *(bf16x8*)(qsl + (d0 - DQR) * 1024) = t; }
    if (grp == 0) DMA_K(cur.K, cur.kb0, 0);
    S.tb = 0; if (tid < 64) *(f32x4*)((float*)(lds + OFF_TAB) + tid * 4) = *(const f32x4*)(cur.tab + tid * 4);
    VMW(); __syncthreads();
    if (grp == 1) __syncthreads();
}
__device__ __forceinline__ void dattn_finish(const int wid_) { if (((wid_ & 7) >> 2) == 0) __syncthreads(); }
#define KRD(dst, a, off) asm volatile("ds_read_b128 %0, %1 offset:%2" : "=v"(dst) : "v"(a), "i"(off) : "memory")
#define TRD(dst, a, off) asm volatile("ds_read_b64_tr_b16 %0, %1 offset:%2" : "=v"(dst) : "v"(a), "i"(off) : "memory")
#define LGKW1(n, x) asm volatile("s_waitcnt lgkmcnt(%1)" : "+v"(x) : "i"(n) : "memory")
#define LGKW2(n, x, y) asm volatile("s_waitcnt lgkmcnt(%2)" : "+v"(x), "+v"(y) : "i"(n) : "memory")
#define MFMA(a, b, c) __builtin_amdgcn_mfma_f32_32x32x16_bf16(a, b, c, 0, 0, 0)
#define VCAT(l, h) ((bf16x8){l[0], l[1], l[2], l[3], h[0], h[1], h[2], h[3]})
#define ZERO16 ((f32x16){0.f, 0.f, 0.f, 0.f, 0.f, 0.f, 0.f, 0.f, 0.f, 0.f, 0.f, 0.f, 0.f, 0.f, 0.f, 0.f})
#define DM_QKPV(KB_, VB_) do { \
        KRD(ks0, ka0, (KB_) * SHM_K + 0); \
        KRD(ks1, ka0, (KB_) * SHM_K + 8192); \
        KRD(ks2, ka1, (KB_) * SHM_K + 0); \
        KRD(ks3, ka1, (KB_) * SHM_K + 8192); \
        KRD(ks4, ka2, (KB_) * SHM_K + 0); \
        KRD(ks5, ka2, (KB_) * SHM_K + 8192); \
        KRD(qs0, qa, 0); \
        KRD(qs1, qa, 1024); \
        LGKW1(7, ks0); pX0 = MFMA(ks0, S.qr[0], ZERO16); SBAR(); \
        KRD(ks0, ka3, (KB_) * SHM_K + 0); \
        LGKW1(7, ks1); pX1 = MFMA(ks1, S.qr[0], ZERO16); SBAR(); \
        KRD(ks1, ka3, (KB_) * SHM_K + 8192); \
        LGKW1(7, ks2); pX0 = MFMA(ks2, S.qr[1], pX0); SBAR(); \
        KRD(ks2, ka0, (KB_) * SHM_K + 128); \
        LGKW1(7, ks3); pX1 = MFMA(ks3, S.qr[1], pX1); SBAR(); \
        KRD(ks3, ka0, (KB_) * SHM_K + 8320); \
        LGKW1(7, ks4); pX0 = MFMA(ks4, S.qr[2], pX0); SBAR(); \
        KRD(ks4, ka1, (KB_) * SHM_K + 128); \
        LGKW1(7, ks5); pX1 = MFMA(ks5, S.qr[2], pX1); SBAR(); \
        KRD(ks5, ka1, (KB_) * SHM_K + 8320); \
        LGKW1(5, ks0); pX0 = MFMA(ks0, S.qr[3], pX0); SBAR(); \
        KRD(ks0, ka2, (KB_) * SHM_K + 128); \
        LGKW1(5, ks1); pX1 = MFMA(ks1, S.qr[3], pX1); SBAR(); \
        KRD(ks1, ka2, (KB_) * SHM_K + 8320); \
        LGKW2(5, ks2, qs0); pX0 = MFMA(ks2, qs0, pX0); SBAR(); \
        KRD(ks2, ka3, (KB_) * SHM_K + 128); \
        LGKW2(5, ks3, qs0); pX1 = MFMA(ks3, qs0, pX1); SBAR(); \
        KRD(ks3, ka3, (KB_) * SHM_K + 8320); \
        KRD(qs0, qa, 2048); \
        LGKW2(6, ks4, qs1); pX0 = MFMA(ks4, qs1, pX0); SBAR(); \
        TRD(vl4, vb0, (VB_) * SHM_V + 0); TRD(vh4, vb0, (VB_) * SHM_V + 2048); \
        LGKW2(7, ks5, qs1); pX1 = MFMA(ks5, qs1, pX1); SBAR(); \
        TRD(vl5, vb0, (VB_) * SHM_V + 4096); TRD(vh5, vb0, (VB_) * SHM_V + 6144); \
        KRD(qs1, qa, 3072); \
        LGKW2(5, ks0, qs0); pX0 = MFMA(ks0, qs0, pX0); SBAR(); \
        TRD(vl0, vb0, (VB_) * SHM_V + 8192); TRD(vh0, vb0, (VB_) * SHM_V + 10240); \
        LGKW2(7, ks1, qs0); pX1 = MFMA(ks1, qs0, pX1); SBAR(); \
        TRD(vl1, vb0, (VB_) * SHM_V + 12288); TRD(vh1, vb0, (VB_) * SHM_V + 14336); \
        LGKW2(4, ks2, qs1); pX0 = MFMA(ks2, qs1, pX0); SBAR(); \
        TRD(vl2, vb0, (VB_) * SHM_V + 512); TRD(vh2, vb0, (VB_) * SHM_V + 2560); \
        LGKW2(6, ks3, qs1); pX1 = MFMA(ks3, qs1, pX1); SBAR(); \
        TRD(vl3, vb0, (VB_) * SHM_V + 4608); TRD(vh3, vb0, (VB_) * SHM_V + 6656); \
        LGKW2(11, vl4, vh4); o[0] = MFMA(pa0, VCAT(vl4, vh4), o[0]); SBAR(); \
        TRD(vl4, vb0, (VB_) * SHM_V + 8704); TRD(vh4, vb0, (VB_) * SHM_V + 10752); \
        LGKW2(11, vl5, vh5); o[0] = MFMA(pa1, VCAT(vl5, vh5), o[0]); SBAR(); \
        TRD(vl5, vb0, (VB_) * SHM_V + 12800); TRD(vh5, vb0, (VB_) * SHM_V + 14848); \
        LGKW2(10, vl0, vh0); o[0] = MFMA(pa2, VCAT(vl0, vh0), o[0]); SBAR(); \
        TRD(vl0, vb0, (VB_) * SHM_V + 1024); TRD(vh0, vb0, (VB_) * SHM_V + 3072); \
        LGKW2(10, vl1, vh1); o[0] = MFMA(pa3, VCAT(vl1, vh1), o[0]); SBAR(); \
        TRD(vl1, vb0, (VB_) * SHM_V + 5120); TRD(vh1, vb0, (VB_) * SHM_V + 7168); \
        LGKW2(10, vl2, vh2); o[1] = MFMA(pa0, VCAT(vl2, vh2), o[1]); SBAR(); \
        TRD(vl2, vb0, (VB_) * SHM_V + 9216); TRD(vh2, vb0, (VB_) * SHM_V + 11264); \
        LGKW2(10, vl3, vh3); o[1] = MFMA(pa1, VCAT(vl3, vh3), o[1]); SBAR(); \
        TRD(vl3, vb0, (VB_) * SHM_V + 13312); TRD(vh3, vb0, (VB_) * SHM_V + 15360); \
        LGKW2(10, vl4, vh4); o[1] = MFMA(pa2, VCAT(vl4, vh4), o[1]); SBAR(); \
        TRD(vl4, vb0, (VB_) * SHM_V + 1536); TRD(vh4, vb0, (VB_) * SHM_V + 3584); \
        LGKW2(10, vl5, vh5); o[1] = MFMA(pa3, VCAT(vl5, vh5), o[1]); SBAR(); \
        TRD(vl5, vb0, (VB_) * SHM_V + 5632); TRD(vh5, vb0, (VB_) * SHM_V + 7680); \
        LGKW2(10, vl0, vh0); o[2] = MFMA(pa0, VCAT(vl0, vh0), o[2]); SBAR(); \
        TRD(vl0, vb0, (VB_) * SHM_V + 9728); TRD(vh0, vb0, (VB_) * SHM_V + 11776); \
        LGKW2(10, vl1, vh1); o[2] = MFMA(pa1, VCAT(vl1, vh1), o[2]); SBAR(); \
        TRD(vl1, vb0, (VB_) * SHM_V + 13824); TRD(vh1, vb0, (VB_) * SHM_V + 15872); \
        LGKW2(10, vl2, vh2); o[2] = MFMA(pa2, VCAT(vl2, vh2), o[2]); SBAR(); \
        TRD(vl2, vb1, (VB_) * SHM_V + 0); TRD(vh2, vb1, (VB_) * SHM_V + 2048); \
        LGKW2(10, vl3, vh3); o[2] = MFMA(pa3, VCAT(vl3, vh3), o[2]); SBAR(); \
        TRD(vl3, vb1, (VB_) * SHM_V + 4096); TRD(vh3, vb1, (VB_) * SHM_V + 6144); \
        LGKW2(10, vl4, vh4); o[3] = MFMA(pa0, VCAT(vl4, vh4), o[3]); SBAR(); \
        TRD(vl4, vb1, (VB_) * SHM_V + 8192); TRD(vh4, vb1, (VB_) * SHM_V + 10240); \
        LGKW2(10, vl5, vh5); o[3] = MFMA(pa1, VCAT(vl5, vh5), o[3]); SBAR(); \
        TRD(vl5, vb1, (VB_) * SHM_V + 12288); TRD(vh5, vb1, (VB_) * SHM_V + 14336); \
        LGKW2(10, vl0, vh0); o[3] = MFMA(pa2, VCAT(vl0, vh0), o[3]); SBAR(); \
        TRD(vl0, vb1, (VB_) * SHM_V + 512); TRD(vh0, vb1, (VB_) * SHM_V + 2560); \
        LGKW2(10, vl1, vh1); o[3] = MFMA(pa3, VCAT(vl1, vh1), o[3]); SBAR(); \
        TRD(vl1, vb1, (VB_) * SHM_V + 4608); TRD(vh1, vb1, (VB_) * SHM_V + 6656); \
        LGKW2(10, vl2, vh2); o[4] = MFMA(pa0, VCAT(vl2, vh2), o[4]); SBAR(); \
        TRD(vl2, vb1, (VB_) * SHM_V + 8704); TRD(vh2, vb1, (VB_) * SHM_V + 10752); \
        LGKW2(10, vl3, vh3); o[4] = MFMA(pa1, VCAT(vl3, vh3), o[4]); SBAR(); \
        TRD(vl3, vb1, (VB_) * SHM_V + 12800); TRD(vh3, vb1, (VB_) * SHM_V + 14848); \
        LGKW2(10, vl4, vh4); o[4] = MFMA(pa2, VCAT(vl4, vh4), o[4]); SBAR(); \
        TRD(vl4, vb1, (VB_) * SHM_V + 1024); TRD(vh4, vb1, (VB_) * SHM_V + 3072); \
        LGKW2(10, vl5, vh5); o[4] = MFMA(pa3, VCAT(vl5, vh5), o[4]); SBAR(); \
        TRD(vl5, vb1, (VB_) * SHM_V + 5120); TRD(vh5, vb1, (VB_) * SHM_V + 7168); \
        LGKW2(10, vl0, vh0); o[5] = MFMA(pa0, VCAT(vl0, vh0), o[5]); SBAR(); \
        TRD(vl0, vb1, (VB_) * SHM_V + 9216); TRD(vh0, vb1, (VB_) * SHM_V + 11264); \
        LGKW2(10, vl1, vh1); o[5] = MFMA(pa1, VCAT(vl1, vh1), o[5]); SBAR(); \
        TRD(vl1, vb1, (VB_) * SHM_V + 13312); TRD(vh1, vb1, (VB_) * SHM_V + 15360); \
        LGKW2(10, vl2, vh2); o[5] = MFMA(pa2, VCAT(vl2, vh2), o[5]); SBAR(); \
        TRD(vl2, vb1, (VB_) * SHM_V + 1536); TRD(vh2, vb1, (VB_) * SHM_V + 3584); \
        LGKW2(10, vl3, vh3); o[5] = MFMA(pa3, VCAT(vl3, vh3), o[5]); SBAR(); \
        TRD(vl3, vb1, (VB_) * SHM_V + 5632); TRD(vh3, vb1, (VB_) * SHM_V + 7680); \
        LGKW2(10, vl4, vh4); o[6] = MFMA(pa0, VCAT(vl4, vh4), o[6]); SBAR(); \
        TRD(vl4, vb1, (VB_) * SHM_V + 9728); TRD(vh4, vb1, (VB_) * SHM_V + 11776); \
        LGKW2(10, vl5, vh5); o[6] = MFMA(pa1, VCAT(vl5, vh5), o[6]); SBAR(); \
        TRD(vl5, vb1, (VB_) * SHM_V + 13824); TRD(vh5, vb1, (VB_) * SHM_V + 15872); \
        LGKW2(10, vl0, vh0); o[6] = MFMA(pa2, VCAT(vl0, vh0), o[6]); SBAR(); \
        LGKW2(8, vl1, vh1); o[6] = MFMA(pa3, VCAT(vl1, vh1), o[6]); SBAR(); \
        LGKW2(6, vl2, vh2); o[7] = MFMA(pa0, VCAT(vl2, vh2), o[7]); SBAR(); \
        LGKW2(4, vl3, vh3); o[7] = MFMA(pa1, VCAT(vl3, vh3), o[7]); SBAR(); \
        LGKW2(2, vl4, vh4); o[7] = MFMA(pa2, VCAT(vl4, vh4), o[7]); SBAR(); \
        LGKW2(0, vl5, vh5); o[7] = MFMA(pa3, VCAT(vl5, vh5), o[7]); SBAR(); } while (0)
#define DM_QK(KB_) do { \
        KRD(ks0, ka0, (KB_) * SHM_K + 0); \
        KRD(ks1, ka0, (KB_) * SHM_K + 8192); \
        KRD(ks2, ka1, (KB_) * SHM_K + 0); \
        KRD(ks3, ka1, (KB_) * SHM_K + 8192); \
        KRD(ks4, ka2, (KB_) * SHM_K + 0); \
        KRD(ks5, ka2, (KB_) * SHM_K + 8192); \
        KRD(qs0, qa, 0); \
        KRD(qs1, qa, 1024); \
        LGKW1(7, ks0); pX0 = MFMA(ks0, S.qr[0], ZERO16); SBAR(); \
        KRD(ks0, ka3, (KB_) * SHM_K + 0); \
        LGKW1(7, ks1); pX1 = MFMA(ks1, S.qr[0], ZERO16); SBAR(); \
        KRD(ks1, ka3, (KB_) * SHM_K + 8192); \
        LGKW1(7, ks2); pX0 = MFMA(ks2, S.qr[1], pX0); SBAR(); \
        KRD(ks2, ka0, (KB_) * SHM_K + 128); \
        LGKW1(7, ks3); pX1 = MFMA(ks3, S.qr[1], pX1); SBAR(); \
        KRD(ks3, ka0, (KB_) * SHM_K + 8320); \
        LGKW1(7, ks4); pX0 = MFMA(ks4, S.qr[2], pX0); SBAR(); \
        KRD(ks4, ka1, (KB_) * SHM_K + 128); \
        LGKW1(7, ks5); pX1 = MFMA(ks5, S.qr[2], pX1); SBAR(); \
        KRD(ks5, ka1, (KB_) * SHM_K + 8320); \
        LGKW1(5, ks0); pX0 = MFMA(ks0, S.qr[3], pX0); SBAR(); \
        KRD(ks0, ka2, (KB_) * SHM_K + 128); \
        LGKW1(5, ks1); pX1 = MFMA(ks1, S.qr[3], pX1); SBAR(); \
        KRD(ks1, ka2, (KB_) * SHM_K + 8320); \
        LGKW2(5, ks2, qs0); pX0 = MFMA(ks2, qs0, pX0); SBAR(); \
        KRD(ks2, ka3, (KB_) * SHM_K + 128); \
        LGKW2(5, ks3, qs0); pX1 = MFMA(ks3, qs0, pX1); SBAR(); \
        KRD(ks3, ka3, (KB_) * SHM_K + 8320); \
        KRD(qs0, qa, 2048); \
        LGKW2(6, ks4, qs1); pX0 = MFMA(ks4, qs1, pX0); SBAR(); \
        LGKW2(5, ks5, qs1); pX1 = MFMA(ks5, qs1, pX1); SBAR(); \
        KRD(qs1, qa, 3072); \
        LGKW2(1, ks0, qs0); pX0 = MFMA(ks0, qs0, pX0); SBAR(); \
        LGKW2(1, ks1, qs0); pX1 = MFMA(ks1, qs0, pX1); SBAR(); \
        LGKW2(0, ks2, qs1); pX0 = MFMA(ks2, qs1, pX0); SBAR(); \
        LGKW2(0, ks3, qs1); pX1 = MFMA(ks3, qs1, pX1); SBAR(); } while (0)
#define DM_PV(VB_) do { \
        TRD(vl0, vb0, (VB_) * SHM_V + 0); TRD(vh0, vb0, (VB_) * SHM_V + 2048); \
        TRD(vl1, vb0, (VB_) * SHM_V + 4096); TRD(vh1, vb0, (VB_) * SHM_V + 6144); \
        TRD(vl2, vb0, (VB_) * SHM_V + 8192); TRD(vh2, vb0, (VB_) * SHM_V + 10240); \
        TRD(vl3, vb0, (VB_) * SHM_V + 12288); TRD(vh3, vb0, (VB_) * SHM_V + 14336); \
        TRD(vl4, vb0, (VB_) * SHM_V + 512); TRD(vh4, vb0, (VB_) * SHM_V + 2560); \
        TRD(vl5, vb0, (VB_) * SHM_V + 4608); TRD(vh5, vb0, (VB_) * SHM_V + 6656); \
        LGKW2(10, vl0, vh0); o[0] = MFMA(pa0, VCAT(vl0, vh0), o[0]); SBAR(); \
        TRD(vl0, vb0, (VB_) * SHM_V + 8704); TRD(vh0, vb0, (VB_) * SHM_V + 10752); \
        LGKW2(10, vl1, vh1); o[0] = MFMA(pa1, VCAT(vl1, vh1), o[0]); SBAR(); \
        TRD(vl1, vb0, (VB_) * SHM_V + 12800); TRD(vh1, vb0, (VB_) * SHM_V + 14848); \
        LGKW2(10, vl2, vh2); o[0] = MFMA(pa2, VCAT(vl2, vh2), o[0]); SBAR(); \
        TRD(vl2, vb0, (VB_) * SHM_V + 1024); TRD(vh2, vb0, (VB_) * SHM_V + 3072); \
        LGKW2(10, vl3, vh3); o[0] = MFMA(pa3, VCAT(vl3, vh3), o[0]); SBAR(); \
        TRD(vl3, vb0, (VB_) * SHM_V + 5120); TRD(vh3, vb0, (VB_) * SHM_V + 7168); \
        LGKW2(10, vl4, vh4); o[1] = MFMA(pa0, VCAT(vl4, vh4), o[1]); SBAR(); \
        TRD(vl4, vb0, (VB_) * SHM_V + 9216); TRD(vh4, vb0, (VB_) * SHM_V + 11264); \
        LGKW2(10, vl5, vh5); o[1] = MFMA(pa1, VCAT(vl5, vh5), o[1]); SBAR(); \
        TRD(vl5, vb0, (VB_) * SHM_V + 13312); TRD(vh5, vb0, (VB_) * SHM_V + 15360); \
        LGKW2(10, vl0, vh0); o[1] = MFMA(pa2, VCAT(vl0, vh0), o[1]); SBAR(); \
        TRD(vl0, vb0, (VB_) * SHM_V + 1536); TRD(vh0, vb0, (VB_) * SHM_V + 3584); \
        LGKW2(10, vl1, vh1); o[1] = MFMA(pa3, VCAT(vl1, vh1), o[1]); SBAR(); \
        TRD(vl1, vb0, (VB_) * SHM_V + 5632); TRD(vh1, vb0, (VB_) * SHM_V + 7680); \
        LGKW2(10, vl2, vh2); o[2] = MFMA(pa0, VCAT(vl2, vh2), o[2]); SBAR(); \
        TRD(vl2, vb0, (VB_) * SHM_V + 9728); TRD(vh2, vb0, (VB_) * SHM_V + 11776); \
        LGKW2(10, vl3, vh3); o[2] = MFMA(pa1, VCAT(vl3, vh3), o[2]); SBAR(); \
        TRD(vl3, vb0, (VB_) * SHM_V + 13824); TRD(vh3, vb0, (VB_) * SHM_V + 15872); \
        LGKW2(10, vl4, vh4); o[2] = MFMA(pa2, VCAT(vl4, vh4), o[2]); SBAR(); \
        TRD(vl4, vb1, (VB_) * SHM_V + 0); TRD(vh4, vb1, (VB_) * SHM_V + 2048); \
        LGKW2(10, vl5, vh5); o[2] = MFMA(pa3, VCAT(vl5, vh5), o[2]); SBAR(); \
        TRD(vl5, vb1, (VB_) * SHM_V + 4096); TRD(vh5, vb1, (VB_) * SHM_V + 6144); \
        LGKW2(10, vl0, vh0); o[3] = MFMA(pa0, VCAT(vl0, vh0), o[3]); SBAR(); \
        TRD(vl0, vb1, (VB_) * SHM_V + 8192); TRD(vh0, vb1, (VB_) * SHM_V + 10240); \
        LGKW2(10, vl1, vh1); o[3] = MFMA(pa1, VCAT(vl1, vh1), o[3]); SBAR(); \
        TRD(vl1, vb1, (VB_) * SHM_V + 12288); TRD(vh1, vb1, (VB_) * SHM_V + 14336); \
        LGKW2(10, vl2, vh2); o[3] = MFMA(pa2, VCAT(vl2, vh2), o[3]); SBAR(); \
        TRD(vl2, vb1, (VB_) * SHM_V + 512); TRD(vh2, vb1, (VB_) * SHM_V + 2560); \
        LGKW2(10, vl3, vh3); o[3] = MFMA(pa3, VCAT(vl3, vh3), o[3]); SBAR(); \
        TRD(vl3, vb1, (VB_) * SHM_V + 4608); TRD(vh3, vb1, (VB_) * SHM_V + 6656); \
        LGKW2(10, vl4, vh4); o[4] = MFMA(pa0, VCAT(vl4, vh4), o[4]); SBAR(); \
        TRD(vl4, vb1, (VB_) * SHM_V + 8704); TRD(vh4, vb1, (VB_) * SHM_V + 10752); \
        LGKW2(10, vl5, vh5); o[4] = MFMA(pa1, VCAT(vl5, vh5), o[4]); SBAR(); \
        TRD(vl5, vb1, (VB_) * SHM_V + 12800); TRD(vh5, vb1, (VB_) * SHM_V + 14848); \
        LGKW2(10, vl0, vh0); o[4] = MFMA(pa2, VCAT(vl0, vh0), o[4]); SBAR(); \
        TRD(vl0, vb1, (VB_) * SHM_V + 1024); TRD(vh0, vb1, (VB_) * SHM_V + 3072); \
        LGKW2(10, vl1, vh1); o[4] = MFMA(pa3, VCAT(vl1, vh1), o[4]); SBAR(); \
        TRD(vl1, vb1, (VB_) * SHM_V + 5120); TRD(vh1, vb1, (VB_) * SHM_V + 7168); \
        LGKW2(10, vl2, vh2); o[5] = MFMA(pa0, VCAT(vl2, vh2), o[5]); SBAR(); \
        TRD(vl2, vb1, (VB_) * SHM_V + 9216); TRD(vh2, vb1, (VB_) * SHM_V + 11264); \
        LGKW2(10, vl3, vh3); o[5] = MFMA(pa1, VCAT(vl3, vh3), o[5]); SBAR(); \
        TRD(vl3, vb1, (VB_) * SHM_V + 13312); TRD(vh3, vb1, (VB_) * SHM_V + 15360); \
        LGKW2(10, vl4, vh4); o[5] = MFMA(pa2, VCAT(vl4, vh4), o[5]); SBAR(); \
        TRD(vl4, vb1, (VB_) * SHM_V + 1536); TRD(vh4, vb1, (VB_) * SHM_V + 3584); \
        LGKW2(10, vl5, vh5); o[5] = MFMA(pa3, VCAT(vl5, vh5), o[5]); SBAR(); \
        TRD(vl5, vb1, (VB_) * SHM_V + 5632); TRD(vh5, vb1, (VB_) * SHM_V + 7680); \
        LGKW2(10, vl0, vh0); o[6] = MFMA(pa0, VCAT(vl0, vh0), o[6]); SBAR(); \
        TRD(vl0, vb1, (VB_) * SHM_V + 9728); TRD(vh0, vb1, (VB_) * SHM_V + 11776); \
        LGKW2(10, vl1, vh1); o[6] = MFMA(pa1, VCAT(vl1, vh1), o[6]); SBAR(); \
        TRD(vl1, vb1, (VB_) * SHM_V + 13824); TRD(vh1, vb1, (VB_) * SHM_V + 15872); \
        LGKW2(10, vl2, vh2); o[6] = MFMA(pa2, VCAT(vl2, vh2), o[6]); SBAR(); \
        LGKW2(8, vl3, vh3); o[6] = MFMA(pa3, VCAT(vl3, vh3), o[6]); SBAR(); \
        LGKW2(6, vl4, vh4); o[7] = MFMA(pa0, VCAT(vl4, vh4), o[7]); SBAR(); \
        LGKW2(4, vl5, vh5); o[7] = MFMA(pa1, VCAT(vl5, vh5), o[7]); SBAR(); \
        LGKW2(2, vl0, vh0); o[7] = MFMA(pa2, VCAT(vl0, vh0), o[7]); SBAR(); \
        LGKW2(0, vl1, vh1); o[7] = MFMA(pa3, VCAT(vl1, vh1), o[7]); SBAR(); } while (0)
__device__ __forceinline__ void dattn_block(const BlockRef& cur, const BlockRef& nxt, char* lds, PG8_LAS unsigned char* ldsL, DSeam& S, const int wid_) {
    const int wid = wid_ & 7, lane = pg8::hw_lane(), tid = wid * 64 + lane, r32 = lane & 31, hi = lane >> 5;
    constexpr int ldo = 2048;
    const int NT = cur.P0 / KVBLK + 4;
    const int qlo = cur.P0 + wid * QBLK, row = qlo + r32, qlo_m = qlo | 63, qm = (row | 63) - 4 * hi;
    char* K_lds = lds + 2 * SHM_V;
    float* ws = (float*)(lds + OFF_SCR) + wid * 64; float* li_l = ws, * al_l = ws + 32;
    const float* tl = (const float*)(lds + OFF_TAB + S.tb * 1024) + (192 + 4 * hi - row);
    const char* qsl = lds + D_OFF_Q + wid * ((8 - DQR) * 1024) + lane * 16;
    D_LANE_OFFS();
    float m_reg = -1e30f, l_reg = 0; f32x16 o[8] = {};
    const int vb0 = (int)(uintptr_t)lds + v_rd_base(lane), vb1 = vb0 + D_OFF_V1;
    const bf16* Kh = cur.K; const bf16* Vh = cur.V;
    f32x16 pX0, pX1; bf16x8 pa0, pa1, pa2, pa3;
    bf16x8 ks0, ks1, ks2, ks3, ks4, ks5, qs0, qs1; s16x4 vl0, vl1, vl2, vl3, vl4, vl5, vh0, vh1, vh2, vh3, vh4, vh5;
    const int ka0 = (int)(uintptr_t)K_lds + KSWZ(r32, (0 * 16 + hi * 8) * 2), ka1 = (int)(uintptr_t)K_lds + KSWZ(r32, (1 * 16 + hi * 8) * 2), ka2 = (int)(uintptr_t)K_lds + KSWZ(r32, (2 * 16 + hi * 8) * 2), ka3 = (int)(uintptr_t)K_lds + KSWZ(r32, (3 * 16 + hi * 8) * 2);
    const int qa = (int)(uintptr_t)qsl;
#define RESC(a) do { if (__any((a) < 1.f)) { if (hi == 0) al_l[r32] = (a); asm volatile("s_waitcnt lgkmcnt(0)" ::: "memory");              \
                     for (int d_ = 0; d_ < 8; ++d_) for (int r = 0; r < 16; ++r) o[d_][r] *= al_l[crow(r, hi)]; } } while (0)
#define DSOFT(t) do { const int kb_ = (t) * KVBLK;                                                                           \
        if (kb_ >= qlo - 153 && kb_ <= qlo_m) diff_bias(pX0, pX1, tl, kb_);                                                  \
        if (kb_ + KVBLK - 1 > qlo_m) mask_tile(pX0, pX1, qm - kb_);                                                          \
        float mn_, al_; partialSM(pX0, pX1, m_reg, mn_, al_); RESC(al_); finishSM(pX0, pX1, al_, l_reg, pa0, pa1, pa2, pa3); } while (0)
#define DSTEP(t, KB) do {                                                                                                     \
        if (grp == 0) { if ((t) + 1 < NT) DMA_K(Kh, ((t) + 1) * KVBLK, (KB) ^ 1);                                             \
                        DMA_V(Vh, (t) * KVBLK, KB); }                                                                         \
        SBAR(); DM_QKPV(KB, (KB) ^ 1);                                                                                        \
        SBAR(); asm volatile("s_waitcnt lgkmcnt(0)" ::: "memory"); __builtin_amdgcn_s_barrier(); SBAR();                      \
        DSOFT(t);                                                                                                             \
        if (grp == 0) VMW();                                                                                                  \
        __syncthreads(); } while (0)
    if (grp == 0) { DMA_K(Kh, KVBLK, 1); DMA_V(Vh, 0, 0); }
    SBAR(); DM_QK(0);
    SBAR(); asm volatile("s_waitcnt lgkmcnt(0)" ::: "memory"); __builtin_amdgcn_s_barrier(); SBAR();
    DSOFT(0);
    if (grp == 0) VMW();
    __syncthreads();
    for (int t = 1; t < NT; t += 2) {
        DSTEP(t, 1);
        if (t + 1 < NT) DSTEP(t + 1, 0);
    }
    if (grp == 0) DMA_K(nxt.K, nxt.kb0, 0);
    { const char* qg_ = (const char*)(nxt.Q + (size_t)(wid * QBLK + r32) * D + hi * 8);
      PG8_LAS unsigned char* const qd_ = ldsL + D_OFF_Q + wid * ((8 - DQR) * 1024);
#pragma unroll
      for (int d0 = DQR; d0 < 8; ++d0) DMA16(qg_ + d0 * 32, qd_ + (d0 - DQR) * 1024); }
    f32x4 tn0 = {0.f, 0.f, 0.f, 0.f}; if (wid == 0) tn0 = *(const f32x4*)(nxt.tab + lane * 4);
    SBAR();
    DM_PV(1);
    SBAR();
    if (hi == 0) li_l[r32] = l_reg; asm volatile("s_waitcnt lgkmcnt(0)" ::: "memory");
    { unsigned* sw = (unsigned*)cur.scr + (size_t)wid * 4096 + lane * 4;
      float rl[16];
#pragma unroll
      for (int r = 0; r < 16; ++r) rl[r] = __builtin_amdgcn_rcpf(li_l[crow(r, hi)]);
      if (cur.c == 0) {
#pragma unroll
        for (int d0 = 0; d0 < 8; ++d0) {
#pragma unroll
            for (int h = 0; h < 2; ++h) { u32x4 w;
#pragma unroll
                for (int j = 0; j < 4; ++j) w[j] = cvtpk(o[d0][8 * h + 2 * j] * rl[8 * h + 2 * j], o[d0][8 * h + 2 * j + 1] * rl[8 * h + 2 * j + 1]);
                *(u32x4*)(sw + (d0 * 2 + h) * 256) = w; }
            asm volatile("" ::: "memory"); }
      } else {
        float ssq[16];
#pragma unroll
        for (int r = 0; r < 16; ++r) ssq[r] = 0.f;
        const float lam = cur.lam;
#define O0V(w_, j_) (((j_) & 1) ? __uint_as_float((w_)[(j_) >> 1] & 0xffff0000u) : __uint_as_float((w_)[(j_) >> 1] << 16))
#pragma unroll
        for (int d0 = 0; d0 < 8; d0 += 4) {
            u32x4 a[8];
#pragma unroll
            for (int i = 0; i < 8; ++i) a[i] = *(const u32x4*)(sw + (d0 * 2 + i) * 256);
#pragma unroll
            for (int i = 0; i < 8; ++i)
#pragma unroll
                for (int j = 0; j < 8; ++j) { const int r = 8 * (i & 1) + j; const float d = O0V(a[i], j) - lam * (o[d0 + (i >> 1)][r] * rl[r]); ssq[r] += d * d; }
            asm volatile("" ::: "memory"); }
#pragma unroll
        for (int r = 0; r < 16; ++r) ssq[r] = 0.8f * __builtin_amdgcn_rsqf(half_sum32(ssq[r]) * (1.0f / 256.0f) + 1e-5f);
        bf16* Ow = (bf16*)cur.O + (size_t)(wid * QBLK) * 4096 + r32;
        float gg[8];
#pragma unroll
        for (int d0 = 0; d0 < 8; ++d0) gg[d0] = cur.gs[d0 * 32 + r32];
#pragma unroll
        for (int h = 0; h < 2; ++h) {
            u32x4 a[8];
#pragma unroll
            for (int d0 = 0; d0 < 8; ++d0) a[d0] = *(const u32x4*)(sw + (d0 * 2 + h) * 256);
#pragma unroll
            for (int j = 0; j < 8; ++j) { const int r = 8 * h + j;
#pragma unroll
                for (int d0 = 0; d0 < 8; ++d0) { const float v = (O0V(a[d0], j) - lam * (o[d0][r] * rl[r])) * (ssq[r] * gg[d0]); const float vn = dpp_xor1(v);
                    if ((r32 & 1) == 0) *(unsigned*)(Ow + (size_t)crow(r, hi) * 4096 + d0 * 32) = cvtpk(v, vn); } }
            asm volatile("" ::: "memory"); }
#undef O0V
      } }
    if (wid == 0) { const int l2_ = pg8::hw_lane(); *(f32x4*)((float*)(lds + OFF_TAB + (S.tb ^ 1) * 1024) + l2_ * 4) = tn0; }
    S.tb ^= 1;
#pragma unroll
    for (int d0 = 0; d0 < DQR; ++d0) S.qr[d0] = ld8(nxt.Q + (size_t)(wid * QBLK + r32) * D + d0 * 16 + hi * 8);
    VMW(); __syncthreads();
#undef RESC
#undef DSOFT
#undef DSTEP
}
#undef DM_QKPV
#undef DM_QK
#undef DM_PV
#undef KRD
#undef TRD
#undef LGKW1
#undef LGKW2
#undef MFMA
#undef VCAT
#undef ZERO16
#undef DMA16
#undef D_LANE_OFFS
#undef DMA_K
#undef DMA_V
#undef ROW
#undef VMW
#undef VMWN
#undef SLOAD_H
#undef SWRITE_HK
#undef SWRITE_HV
#undef SWRITE_H
}

constexpr int NWAVES = 8;
constexpr int BATCH = 4, SEQ = 4096, DM = 4096, TOK = BATCH * SEQ;
constexpr int NQKV = 12288, INW = 12304, FOFF = 6144;
constexpr int NMEM = 256, MROWS = BATCH * NMEM, DFF = 16384;
constexpr int MHALF = TOK / 2;
constexpr float NORM_EPS = 1e-6f, SUBLN_EPS = 1e-5f;
constexpr int N_PHASES = 11;

constexpr size_t MiB = 1u << 20;
constexpr size_t WS_CTL = 0, CTL_ZERO_BYTES = 1 * MiB;
constexpr size_t WS_WUP = 1 * MiB;
constexpr size_t WS_WDN = WS_WUP + (size_t)DFF * DM * 2;
constexpr size_t WS_WIN = WS_WDN + (size_t)DM * DFF * 2;
constexpr size_t WS_WOUT = WS_WIN + (size_t)NQKV * DM * 2;
constexpr size_t WS_WKV = WS_WOUT + (size_t)DM * DM * 2;
constexpr size_t WS_W2 = WS_WKV + (size_t)2 * DM * DM * 2;
constexpr size_t WS_U = WS_WIN;
constexpr size_t WS_XB = WS_W2 + (size_t)DM * 2 * DM * 2;
constexpr size_t WS_QKV = WS_XB + (size_t)TOK * DM * 2;
constexpr size_t WS_HB = WS_QKV;
constexpr size_t WS_U2 = WS_HB + (size_t)TOK * DM * 2;
constexpr size_t WS_MB = WS_QKV + (size_t)TOK * NQKV * 2;
constexpr size_t WS_KVM = WS_MB + (size_t)MROWS * DM * 2;
constexpr size_t WS_C2 = WS_KVM + (size_t)MROWS * 2 * DM * 2;
constexpr size_t WS_RX = WS_C2 + (size_t)8192 * DM * 2;
constexpr size_t WS_LOGF = WS_RX + (size_t)TOK * 4;
constexpr size_t WS_NCS = WS_LOGF + (size_t)TOK * 16 * 4;
constexpr size_t WS_DTAB = WS_NCS + (size_t)64 * 4096 * 4;
constexpr size_t WS_PART1 = WS_DTAB + 8192;
constexpr size_t WS_PART2 = WS_PART1 + (size_t)TOK * 64 * 4;
constexpr size_t WS_PART3 = WS_PART2 + (size_t)TOK * 64 * 4;
constexpr size_t WS_XB0 = WS_PART3 + (size_t)TOK * 64 * 4;
constexpr size_t WS_END = WS_XB0 + (size_t)TOK * DM * 2;
static_assert(WS_U + (size_t)MHALF * DFF * 2 <= WS_XB, "U half overlays the dead weight copies");
static_assert(WS_U2 + (size_t)MHALF * DFF * 2 <= WS_MB, "h and the second U half overlay QKV");
constexpr int CW_BAR = 4096;
constexpr int CW_KN = 16384;

constexpr int RING_OFF = 0, RING_BYTES = 131072, TSCR_BYTES = 64 * 65 * 4;
constexpr int LDS_BYTES = 147456;
constexpr int LDSCTL_OFF = LDS_BYTES - 2048, MISC_OFF = LDSCTL_OFF + 320, RTAB_OFF = LDSCTL_OFF + 1024;
static_assert(att::LDS_BYTES <= LDSCTL_OFF && att::D_LDS_BYTES <= LDSCTL_OFF, "attention scratch below the LDS control words");

#define GAS __attribute__((address_space(1)))
#define LAS __attribute__((address_space(3)))
typedef unsigned short bf16;
typedef unsigned v4u __attribute__((ext_vector_type(4)));
typedef unsigned v2u __attribute__((ext_vector_type(2)));
typedef float f32x4 __attribute__((ext_vector_type(4)));
#define LDS_WAIT() asm volatile("s_waitcnt lgkmcnt(0)" ::: "memory")
#define VM_WAIT() asm volatile("s_waitcnt vmcnt(0)" ::: "memory")
__device__ __forceinline__ unsigned f2bf(float f) { unsigned u = __builtin_bit_cast(unsigned, f); return (u + 0x7fffu + ((u >> 16) & 1u)) >> 16; }
__device__ __forceinline__ unsigned pk2(float lo, float hi) { return f2bf(lo) | (f2bf(hi) << 16); }

#define XB_TMO      128
#define XB_XCNT(j)  (256  + 64 * (j))
#define XB_XSUB(j)  (1280 + 64 * (j))
#define XB_XGEN(j)  (2304 + 64 * (j))
#define XB_TOP      3328
#define XB_TOPGEN   3392
#define XCD_BAR_WORDS 3456
#define XB_SPIN_CAP (1u << 18)
__device__ __forceinline__ unsigned xb_ld(unsigned* p)              { return __hip_atomic_load(p, __ATOMIC_RELAXED, __HIP_MEMORY_SCOPE_AGENT); }
__device__ __forceinline__ unsigned xb_add(unsigned* p, unsigned v) { return __hip_atomic_fetch_add(p, v, __ATOMIC_RELAXED, __HIP_MEMORY_SCOPE_AGENT); }
__device__ __forceinline__ unsigned xb_xcc_id() { return (unsigned)__builtin_amdgcn_s_getreg((3 << 11) | 20) & 0xFu; }
#define XB_SPIN(cond, bar) do { unsigned _sp = 0; while (cond) { __builtin_amdgcn_s_sleep(1); \
    if ((++_sp & 255u) == 0u) { if (xb_ld(&(bar)[XB_TMO])) break; if (_sp > XB_SPIN_CAP) { atomicAdd(&(bar)[XB_TMO], 1u); break; } } } } while (0)
struct XcdBarrier { unsigned* bar; unsigned x; volatile LAS unsigned* st; };
__device__ __forceinline__ XcdBarrier xcd_barrier_post(unsigned* bar, volatile LAS unsigned* st, const int tid) {
    XcdBarrier b; b.bar = bar; b.x = xb_xcc_id(); b.st = st;
    if (tid == 0) (void)xb_add(&bar[XB_XCNT(b.x)], 1u);
    return b;
}
__device__ __forceinline__ void xcd_barrier_complete(unsigned* bar, unsigned x, unsigned& nloc, unsigned& nx) {
    const unsigned G = gridDim.x * gridDim.y * gridDim.z;
    unsigned sum, cnt, mine, sp = 0u;
    for (;;) {
        sum = 0u; cnt = 0u; mine = 0u;
#pragma unroll
        for (unsigned j = 0; j < 16; ++j) { const unsigned c = xb_ld(&bar[XB_XCNT(j)]); sum += c; cnt += (c > 0u) ? 1u : 0u; mine = (j == x) ? c : mine; }
        if (sum == G) break;
        __builtin_amdgcn_s_sleep(1);
        if ((++sp & 255u) == 0u) { if (xb_ld(&bar[XB_TMO])) break; if (sp > XB_SPIN_CAP) { atomicAdd(&bar[XB_TMO], 1u); break; } }
    }
    nloc = mine > 0u ? mine : 1u; nx = cnt > 0u ? cnt : 1u;
}
__device__ __forceinline__ void xcd_barrier(const XcdBarrier& b, const int tid) {
    asm volatile("s_waitcnt vmcnt(0)" ::: "memory");
    __syncthreads();
    if (tid == 0) {
        unsigned* bar = b.bar;
        __builtin_amdgcn_s_waitcnt(0);
        unsigned nloc = b.st[0], nx = b.st[1];
        if (nloc == 0u) { xcd_barrier_complete(bar, b.x, nloc, nx); b.st[0] = nloc; b.st[1] = nx; }
        const unsigned old = xb_add(&bar[XB_XSUB(b.x)], 1u);
        const unsigned gen = old / nloc;
        if (old + 1u == (gen + 1u) * nloc) {
            __builtin_amdgcn_fence(__ATOMIC_RELEASE, "agent");
            asm volatile("s_waitcnt vmcnt(0)" ::: "memory");
            const unsigned og = xb_add(&bar[XB_TOP], 1u);
            const unsigned tg = og / nx;
            if (og + 1u == (tg + 1u) * nx) xb_add(&bar[XB_TOPGEN], 1u);
            else XB_SPIN(xb_ld(&bar[XB_TOPGEN]) == tg, bar);
            __builtin_amdgcn_fence(__ATOMIC_ACQUIRE, "agent");
            xb_add(&bar[XB_XGEN(b.x)], 1u);
            asm volatile("s_waitcnt vmcnt(0)" ::: "memory");
        } else {
            XB_SPIN(xb_ld(&bar[XB_XGEN(b.x)]) == gen, bar);
            __builtin_amdgcn_fence(__ATOMIC_ACQUIRE, "agent");
            asm volatile("s_waitcnt vmcnt(0)" ::: "memory");
        }
    }
    __syncthreads();
}

struct Frame {
    LAS unsigned char* lds;
    volatile LAS unsigned* MISC;
    unsigned* ctl;
    int wave;
    int vcu, G;
};
__device__ __forceinline__ float wave_sum(float v) {
#pragma unroll
    for (int o = 1; o < 64; o <<= 1) v += __shfl_xor(v, o);
    return v;
}
__device__ __forceinline__ void transpose_item(const float* W, int ldw, int k0, int n_src0, bf16* WT, int ldo, int n_dst0, LAS float* scr, int lane, const float* kscale = nullptr) {
    f32x4 v[8];
#pragma unroll
    for (int i = 0; i < 8; ++i) v[i] = *(const f32x4*)(W + (size_t)(k0 + 8 * i + (lane >> 3)) * ldw + n_src0 + 4 * (lane & 7));
    if (kscale) {
#pragma unroll
        for (int i = 0; i < 8; ++i) v[i] = v[i] * kscale[k0 + 8 * i + (lane >> 3)]; }
#pragma unroll
    for (int i = 0; i < 8; ++i) { LAS float* d = scr + (8 * i + (lane >> 3)) * 33 + 4 * (lane & 7); d[0] = v[i][0]; d[1] = v[i][1]; d[2] = v[i][2]; d[3] = v[i][3]; }
    LDS_WAIT(); asm volatile("" ::: "memory");
    const int c = lane & 7;
#pragma unroll
    for (int j = 0; j < 4; ++j) { const int n = (lane >> 3) + 8 * j; const LAS float* s = scr + (8 * c) * 33 + n;
        v4u o; o.x = pk2(s[0 * 33], s[1 * 33]); o.y = pk2(s[2 * 33], s[3 * 33]); o.z = pk2(s[4 * 33], s[5 * 33]); o.w = pk2(s[6 * 33], s[7 * 33]);
        *(GAS v4u*)(WT + (size_t)(n_dst0 + n) * ldo + k0 + 8 * c) = o; }
    LDS_WAIT(); asm volatile("" ::: "memory");
}
struct TItem { const float* src; bf16* dst; const float* ks; int ldw, ldo, kblk; };
__device__ __forceinline__ void titem_load(const TItem& t, f32x4 (&v)[16], float (&kv)[16], int lane) {
#pragma unroll
    for (int i = 0; i < 16; ++i) v[i] = __builtin_nontemporal_load((const f32x4*)(t.src + (size_t)(4 * i + (lane >> 4)) * t.ldw + 4 * (lane & 15)));
#pragma unroll
    for (int i = 0; i < 16; ++i) kv[i] = t.ks ? t.ks[4 * i + (lane >> 4)] : 1.0f;
}
__device__ __forceinline__ void titem_store(const TItem& t, const f32x4 (&v)[16], const float (&kv)[16], LAS float* scr, int lane) {
#pragma unroll
    for (int i = 0; i < 16; ++i) { LAS float* d = scr + (4 * i + (lane >> 4)) * 65 + 4 * (lane & 15); d[0] = v[i][0] * kv[i]; d[1] = v[i][1] * kv[i]; d[2] = v[i][2] * kv[i]; d[3] = v[i][3] * kv[i]; }
    LDS_WAIT(); asm volatile("" ::: "memory");
    const int c = lane & 7;
#pragma unroll
    for (int j = 0; j < 8; ++j) { const int n = (lane >> 3) + 8 * j; const LAS float* s = scr + (8 * c) * 65 + n;
        v4u o; o.x = pk2(s[0 * 65], s[1 * 65]); o.y = pk2(s[2 * 65], s[3 * 65]); o.z = pk2(s[4 * 65], s[5 * 65]); o.w = pk2(s[6 * 65], s[7 * 65]);
        if (t.kblk) *(GAS v4u*)(t.dst + ((size_t)(n >> 4) * t.kblk + (c >> 2)) * 512 + (n & 15) * 32 + 8 * (c & 3)) = o;
        else *(GAS v4u*)(t.dst + (size_t)n * t.ldo + 8 * c) = o; }
    LDS_WAIT(); asm volatile("" ::: "memory");
}
__device__ __forceinline__ TItem titem_mat(const float* W, int N, bf16* WT, int ldo, int coff, int item, const float* kscale) {
    const int nblk = N / 64, kb = item / nblk, nb = item % nblk; TItem t;
    t.src = W + (size_t)(64 * kb) * N + 64 * nb; t.dst = WT + coff + (size_t)(64 * nb) * ldo + 64 * kb; t.ks = kscale ? kscale + 64 * kb : nullptr; t.ldw = N; t.ldo = ldo; t.kblk = 0; return t;
}
__device__ __forceinline__ TItem titem_blk(const float* W, int K, int N, bf16* WT, int item, const float* kscale) {
    const int nblk = N / 64, kb = item / nblk, nb = item % nblk; TItem t;
    t.src = W + (size_t)(64 * kb) * N + 64 * nb; t.dst = WT + ((size_t)(4 * nb) * (K / 32) + 2 * kb) * 512; t.ks = kscale ? kscale + 64 * kb : nullptr; t.ldw = N; t.ldo = 0; t.kblk = K / 32; return t;
}
#define TITEM_LOOP(first, count, stride, DECODE) do { int it_ = (first); if (it_ < (count)) { TItem cur_; { const int r = it_; DECODE(cur_, r); } f32x4 v_[16]; float kv_[16]; titem_load(cur_, v_, kv_, LANE);   \
        for (;;) { const int nx_ = it_ + (stride); const bool hn_ = nx_ < (count); TItem nxt_ = cur_; f32x4 vn_[16]; float kvn_[16];                                                  \
            if (hn_) { { const int r = nx_; DECODE(nxt_, r); } titem_load(nxt_, vn_, kvn_, LANE); }                                                                             \
            titem_store(cur_, v_, kv_, scr, LANE); if (!hn_) break; cur_ = nxt_; it_ = nx_; _Pragma("unroll") for (int q_ = 0; q_ < 16; ++q_) { v_[q_] = vn_[q_]; kv_[q_] = kvn_[q_]; } } } } while (0)
__device__ __forceinline__ void transpose_mat_item(const float* W, int K, int N, bf16* WT, int ldo, int coff, LAS float* scr, int item, int lane, const float* kscale = nullptr) {
    const int nblk = N / 32, kb = item / nblk, nb = item % nblk;
    transpose_item(W, N, 64 * kb, 32 * nb, WT + coff, ldo, 32 * nb, scr, lane, kscale);
}

struct Args { const float* in[22]; float* out; unsigned char* ws; int ph_lo, ph_hi, li, pad; };
template <int OFF> __device__ __forceinline__ void* karg_ptr() {
    __attribute__((address_space(1))) void* p; asm volatile("s_load_dwordx2 %0, %1, %2\n\ts_waitcnt lgkmcnt(0)" : "=s"(p) : "s"(__builtin_amdgcn_kernarg_segment_ptr()), "n"(OFF)); return (void*)p;
}

__global__ void __launch_bounds__(NWAVES * 64, 2) fwd_kernel(Args args) {
    extern __shared__ __attribute__((aligned(16))) unsigned char lds[];
    Frame F;
    F.lds = (LAS unsigned char*)lds;
    F.MISC = (volatile LAS unsigned*)(F.lds + MISC_OFF);
    F.wave = __builtin_amdgcn_readfirstlane((int)threadIdx.x >> 6);
#define LANE lane_
#define TID tid_
    const int lane0_ = pg8::hw_lane(), tid0_ = F.wave * 64 + lane0_;
    F.G = gridDim.x; { const int bx = blockIdx.x; F.vcu = (F.G % 8 == 0) ? (bx % 8) * (F.G / 8) + bx / 8 : bx; }
    F.ctl = (unsigned*)((unsigned char*)karg_ptr<8 * 23>() + WS_CTL);
    for (int u = tid0_; u < (LDS_BYTES - LDSCTL_OFF) / 4; u += NWAVES * 64) ((LAS unsigned*)(F.lds + LDSCTL_OFF))[u] = 0u;
    __syncthreads();
    XcdBarrier bar; bar.bar = F.ctl + CW_BAR; bar.x = 0; bar.st = nullptr;
    if (!MK_PER_PHASE) bar = xcd_barrier_post(F.ctl + CW_BAR, F.MISC + 8, tid0_);
#define GRID_BAR() do { if (!MK_PER_PHASE) xcd_barrier(bar, F.wave * 64 + pg8::hw_lane()); } while (0)
    const int lo = args.ph_lo, hi = args.ph_hi;
#define IN(k) (lo <= (k) && (k) < hi)
#define BOTH(k) (IN(k) && IN((k) + 1))
    const int gw = F.vcu * NWAVES + F.wave, NGW = F.G * NWAVES;

#define INP(i) ((const float*)karg_ptr<8 * (i)>())
#define WSP(T, off) ((T*)(wsb + (off)))
#define WSBASE() unsigned char* const wsb = (unsigned char*)karg_ptr<8 * 23>(); const int lane_ = pg8::hw_lane(); const int tid_ = F.wave * 64 + lane_; (void)tid_
#define WupT  WSP(bf16, WS_WUP)
#define WdnT  WSP(bf16, WS_WDN)
#define WinT  WSP(bf16, WS_WIN)
#define WoutT WSP(bf16, WS_WOUT)
#define WkvT  WSP(bf16, WS_WKV)
#define W2    WSP(bf16, WS_W2)
#define Ub    WSP(bf16, WS_U)
#define Ub2   WSP(bf16, WS_U2)
#define XB    WSP(bf16, WS_XB)
#define XB0   WSP(bf16, WS_XB0)
#define QKV   WSP(bf16, WS_QKV)
#define HB    WSP(bf16, WS_HB)
#define MB    WSP(bf16, WS_MB)
#define KVM   WSP(bf16, WS_KVM)
#define C2    WSP(bf16, WS_C2)
#define RX    WSP(float, WS_RX)
#define LOGF  WSP(float, WS_LOGF)
#define NCS   WSP(float, WS_NCS)
#define DTAB  WSP(float, WS_DTAB)
#define PART1 WSP(float, WS_PART1)
#define PART2 WSP(float, WS_PART2)
#define PART3 WSP(float, WS_PART3)
#define OD    ((bf16*)outp)

    if (IN(0)) {
        WSBASE(); const float* const xin = INP(0); const float* const mem = INP(1); const float* const g_mix = INP(2); const float* const w_in = INP(3); const float* const b_forget = INP(4);
        const float* const g_mem = INP(13); const float* const wk_mem = INP(15); const float* const wv_mem = INP(16);
        LAS float* scr = (LAS float*)(F.lds + RING_OFF + F.wave * TSCR_BYTES);
        constexpr int I_IN = (DM / 64) * (NQKV / 64), I_SQ = (DM / 64) * (DM / 64);
        constexpr int NITEMS = I_IN + 2 * I_SQ;
#define P0_DECODE(T, r0) do { int r_ = (r0);                                                                                           \
            if (r_ < I_IN) { const int nblk = NQKV / 64, kb = r_ / nblk, nb = r_ % nblk, nd = 64 * nb, nsrc = nd < FOFF ? nd : nd + 16;        \
                (T).src = w_in + (size_t)(64 * kb) * INW + nsrc; (T).dst = WinT + ((size_t)(nd / 16) * (DM / 32) + 2 * kb) * 512; (T).ks = g_mix + 64 * kb; (T).ldw = INW; (T).ldo = 0; (T).kblk = DM / 32; } \
            else if (r_ < I_IN + I_SQ) (T) = titem_mat(wk_mem, DM, WkvT, DM, 0, r_ - I_IN, nullptr);                                          \
            else (T) = titem_mat(wv_mem, DM, WkvT + (size_t)DM * DM, DM, 0, r_ - I_IN - I_SQ, nullptr); } while (0)
        TITEM_LOOP(gw, NITEMS, NGW, P0_DECODE);
#undef P0_DECODE
        for (int m = gw; m < MROWS; m += NGW) { const f32x4* xr = (const f32x4*)(mem + (size_t)m * DM) + LANE; f32x4 v[16]; float s = 0.f;
#pragma unroll
            for (int j = 0; j < 16; ++j) { v[j] = xr[64 * j]; s += (v[j][0] * v[j][0] + v[j][1] * v[j][1]) + (v[j][2] * v[j][2] + v[j][3] * v[j][3]); }
            const float rs = 1.0f / sqrtf(wave_sum(s) * (1.0f / DM) + NORM_EPS);
            unsigned long long* o8 = (unsigned long long*)(MB + (size_t)m * DM) + LANE;
#pragma unroll
            for (int j = 0; j < 16; ++j) { const f32x4 g = *((const f32x4*)g_mem + LANE + 64 * j);
                o8[64 * j] = (unsigned long long)pk2(v[j][0] * rs * g[0], v[j][1] * rs * g[1]) | ((unsigned long long)pk2(v[j][2] * rs * g[2], v[j][3] * rs * g[3]) << 32); } }
        __syncthreads();
        {   constexpr int WFP = DM + 8; constexpr int XCH_OFF = ((16 * WFP * 2 + 255) / 256) * 256;
            static_assert(XCH_OFF + 4 * 288 * 4 <= LDSCTL_OFF, "forget-gate table + exchange fit below the LDS control words");
            LAS bf16* wfT = (LAS bf16*)(F.lds + RING_OFF);
#pragma unroll
            for (int k = TID; k < DM; k += NWAVES * 64) { const float g = g_mix[k]; const f32x4* wp = (const f32x4*)(w_in + (size_t)k * INW + FOFF);
#pragma unroll
                for (int q = 0; q < 4; ++q) { const f32x4 w = wp[q];
#pragma unroll
                    for (int c = 0; c < 4; ++c) wfT[(4 * q + c) * WFP + k] = (bf16)f2bf(w[c] * g); } }
            __syncthreads();
            const int kh = F.wave & 1, lrow = LANE & 15, q = LANE >> 4;
            LAS float* xch = (LAS float*)(F.lds + RING_OFF + XCH_OFF) + (F.wave >> 1) * 288;
            for (int rg = F.vcu * 4 + (F.wave >> 1); rg < TOK / 16; rg += F.G * 4) { const int r0 = rg * 16;
                const float* xr = xin + (size_t)(r0 + lrow) * DM + kh * (DM / 2) + 8 * q;
                bf16* xo = XB0 + ((size_t)rg * (DM / 32) + kh * (DM / 64)) * 512 + lrow * 32 + 8 * q;
                const LAS bf16* wl = wfT + lrow * WFP + kh * (DM / 2) + 8 * q;
                f32x4 acc = {0.f, 0.f, 0.f, 0.f}; float ss = 0.f;
#pragma unroll 8
                for (int ks = 0; ks < DM / 64; ++ks) {
                    const f32x4 a = __builtin_nontemporal_load((const f32x4*)(xr + 32 * ks)), b = __builtin_nontemporal_load((const f32x4*)(xr + 32 * ks + 4));
                    ss += ((a[0] * a[0] + a[1] * a[1]) + (a[2] * a[2] + a[3] * a[3])) + ((b[0] * b[0] + b[1] * b[1]) + (b[2] * b[2] + b[3] * b[3]));
                    v4u w; w.x = pk2(a[0], a[1]); w.y = pk2(a[2], a[3]); w.z = pk2(b[0], b[1]); w.w = pk2(b[2], b[3]);
                    *(GAS v4u*)(xo + 512 * ks) = w;
                    const pg8::bf16x8 wf = *(const LAS pg8::bf16x8*)(wl + 32 * ks);
                    acc = __builtin_amdgcn_mfma_f32_16x16x32_bf16(*reinterpret_cast<const pg8::bf16x8*>(&w), wf, acc, 0, 0, 0); }
                ss += __shfl_xor(ss, 16); ss += __shfl_xor(ss, 32);
                if (kh == 1) {
#pragma unroll
                    for (int i = 0; i < 4; ++i) xch[LANE * 4 + i] = acc[i];
                    if (q == 0) xch[256 + lrow] = ss; }
                __syncthreads();
                if (kh == 0) {
#pragma unroll
                    for (int i = 0; i < 4; ++i) acc[i] += xch[LANE * 4 + i];
                    ss += xch[256 + lrow];
                    const float rs = 1.0f / sqrtf(ss * (1.0f / DM) + NORM_EPS);
                    if (q == 0) { RX[r0 + lrow] = rs; xch[272 + lrow] = rs; }
                    LDS_WAIT(); asm volatile("" ::: "memory");
                    const float bf_ = b_forget[lrow];
#pragma unroll
                    for (int i = 0; i < 4; ++i) { const float z = acc[i] * xch[272 + 4 * q + i] + bf_; LOGF[(size_t)(r0 + 4 * q + i) * 16 + lrow] = fminf(z, 0.f) - log1pf(expf(-fabsf(z))); } }
                __syncthreads(); }
        }
        if (BOTH(0)) GRID_BAR();
    }

    if (IN(1)) {
        WSBASE();
        pg8::MapPlainAB g{(const char*)XB0, (const char*)WinT, DM, DM, DM}; pg8::StaticOrder S; S.init(TOK, NQKV, F.G, (int)blockIdx.x);
        pg8::Unit u0; int pm0 = -1; if (S.next(0, u0)) pm0 = u0.pm;
        LAS float* rtab = (LAS float*)(F.lds + RTAB_OFF);
        if (pm0 >= 0 && TID < 256) rtab[TID] = RX[pm0 * 256 + TID];
        __syncthreads();
        pg8::EpiQKV E{QKV, RX, rtab, pm0, F.ctl + CW_KN};
        pg8::gemm_phase<pg8::MapPlainAB, pg8::EpiQKV, pg8::StaticOrder, true, true>(F.lds + RING_OFF, g, S, E, F.wave);
    }

    if (IN(2)) {
        WSBASE(); const float* const rel_bias = INP(10);
        {   pg8::MapPlain g{(const char*)MB, (const char*)WkvT, DM, DM, DM}; pg8::StaticOrder S; S.init(MROWS, 2 * DM, F.G, (int)blockIdx.x);
            pg8::EpiBf16 E{KVM, 2 * DM, 1.0f, 0};
            pg8::gemm_phase<pg8::MapPlain, pg8::EpiBf16, pg8::StaticOrder, true, true>(F.lds + RING_OFF, g, S, E, F.wave); }
        {
            const float* const w_out = INP(11); const float* const wq_mem = INP(14); const float* const wo_mem = INP(17); const float* const w_up = INP(19); const float* const w_down = INP(20);
            const float* const g_cross = INP(12); const float* const g_mlp = INP(18);
            const bool big = F.G > 128, late = big && (int)blockIdx.x < 128;
            const int nconv = big ? (late ? 128 : F.G - 128) : F.G, myc = big ? (late ? (int)blockIdx.x : (int)blockIdx.x - 128) : (int)blockIdx.x;
            {
                LAS float* scr = (LAS float*)(F.lds + RING_OFF + F.wave * TSCR_BYTES);
                constexpr int I_SQ = (DM / 64) * (DM / 64), I_UP = (DM / 64) * (DFF / 64), I_DN = (DFF / 64) * (DM / 64), I_WQ = DM * DM / 512;
                constexpr int NITEMS = 2 * I_SQ + I_UP + I_DN;
                const int it_lo = !big ? 0 : (late ? (NITEMS / 3) * 2 : 0), it_hi = !big ? NITEMS : (late ? NITEMS : (NITEMS / 3) * 2);
                const int wq_lo = !big ? 0 : (late ? (I_WQ / 3) * 2 : 0), wq_hi = !big ? I_WQ : (late ? I_WQ : (I_WQ / 3) * 2);
#define P2_DECODE(T, r0) do { int r_ = (r0);                                                                                           \
            if (r_ < I_SQ) (T) = titem_blk(w_out, DM, DM, WoutT, r_, nullptr);                                                             \
            else if (r_ < 2 * I_SQ) (T) = titem_mat(wo_mem, DM, W2, 2 * DM, DM, r_ - I_SQ, nullptr);                                          \
            else if (r_ < 2 * I_SQ + I_UP) (T) = titem_blk(w_up, DM, DFF, WupT, r_ - 2 * I_SQ, g_mlp);                                     \
            else (T) = titem_blk(w_down, DFF, DM, WdnT, r_ - 2 * I_SQ - I_UP, nullptr); } while (0)
                TITEM_LOOP(it_lo + myc * NWAVES + F.wave, it_hi, nconv * NWAVES, P2_DECODE);
#undef P2_DECODE
                {
                    const int st_ = nconv * NWAVES;
                    for (int r0 = wq_lo + myc * NWAVES + F.wave; r0 < wq_hi; r0 += 4 * st_) {
                        f32x4 a[4], b[4]; float gc[4];
#pragma unroll
                        for (int u = 0; u < 4; ++u) { const int r = r0 + u * st_; if (r < wq_hi) { const int e = r * 512 + LANE * 8;
                            a[u] = __builtin_nontemporal_load((const f32x4*)(wq_mem + e)); b[u] = __builtin_nontemporal_load((const f32x4*)(wq_mem + e + 4)); gc[u] = g_cross[e >> 12]; } }
#pragma unroll
                        for (int u = 0; u < 4; ++u) { const int r = r0 + u * st_; if (r < wq_hi) { const int e = r * 512 + LANE * 8, d = e >> 12, c = e & 4095;
                            const f32x4 x0 = a[u] * gc[u], x1 = b[u] * gc[u];
                            v4u o; o.x = pk2(x0[0], x0[1]); o.y = pk2(x0[2], x0[3]); o.z = pk2(x1[0], x1[1]); o.w = pk2(x1[2], x1[3]);
                            *(GAS v4u*)(W2 + (size_t)d * 8192 + c) = o; } } } }
                __syncthreads();
            }
        }
        for (int job = F.G - 1 - (int)blockIdx.x; job < 65; job += F.G) {
            if (job < 64) {
                const int b = job >> 4, h = job & 15; LAS float* wt = (LAS float*)(F.lds + RING_OFF);
                float v[8]; const int s0 = TID * 8;
#pragma unroll
                for (int i = 0; i < 8; ++i) v[i] = LOGF[(size_t)(b * SEQ + s0 + i) * 16 + h];
#pragma unroll
                for (int i = 1; i < 8; ++i) v[i] += v[i - 1];
                float tot = v[7], inc = tot;
#pragma unroll
                for (int o = 1; o < 64; o <<= 1) { const float t = __shfl_up(inc, o); if (LANE >= o) inc += t; }
                __syncthreads();
                if (LANE == 63) wt[F.wave] = inc;
                __syncthreads();
                float base = inc - tot;
                for (int w = 0; w < F.wave; ++w) base += wt[w];
#pragma unroll
                for (int i = 0; i < 8; ++i) NCS[(size_t)job * SEQ + s0 + i] = -(base + v[i]) * (1.0f / att::SCALE);
                __syncthreads();
            } else {
                for (int idx = TID; idx < 8 * 256; idx += NWAVES * 64) { const int hd = idx >> 8, rel = (idx & 255) - 192; const int n = rel < 0 ? -rel : rel;
                    int bk = rel > 0 ? 16 : 0;
                    if (n < 8) bk += n; else { int lg = 31 - __clz((n * n) >> 6); lg = lg > 7 ? 7 : lg; bk += 8 + lg; }
                    DTAB[idx] = (rel_bias[bk * 8 + hd] - rel_bias[15 * 8 + hd]) * (1.0f / att::SCALE); }
            }
        }
        if (BOTH(2)) GRID_BAR();
    }

    if (IN(3)) {
        WSBASE(); float* const outp = (float*)karg_ptr<8 * 22>();
        auto fox_ref = [&](int L, int pass) { const int hu = L >> 3, xx = (L < 256) ? (L & 7) : 7 - (L & 7), b = hu >> 4, h = hu & 15, qb = pass ? 15 - xx : xx; att::BlockRef r;
            const float* knp = (const float*)(F.ctl + CW_KN) + hu * 4; r.kmax2 = 1.05f * ((knp[0] + knp[1]) + (knp[2] + knp[3]));
            r.Q = QKV + ((size_t)(b * 96 + h) * SEQ + (size_t)qb * 256) * 128; r.K = QKV + (size_t)(b * 96 + 16 + h) * SEQ * 128; r.V = QKV + (size_t)(b * 96 + 32 + h) * SEQ * 128;
            r.O = XB + ((size_t)(b * SEQ + qb * 256)) * DM + h * 128; r.tab = NCS + (size_t)hu * SEQ; r.P0 = qb * 256; r.kb0 = qb * 256 + 192; r.tabn = qb * 256 + 256; return r; };
        const float* const lq1 = INP(5); const float* const lk1 = INP(6); const float* const lq2 = INP(7); const float* const lk2 = INP(8); const float* const g_subln = INP(9);
        float lam = 0.f;
        auto dif_ref = [&](int L, int k) { const int hu = (L - 512) >> 3, xx = L & 7, b = hu >> 3, hd = hu & 7, c = k & 1, qb = (k >> 1) ? 15 - xx : xx; att::BlockRef r;
            r.Q = QKV + ((size_t)(b * 96 + 48 + hd * 2 + c) * SEQ + (size_t)qb * 256) * 128; r.K = QKV + (size_t)(b * 96 + 64 + hd * 2 + c) * SEQ * 128; r.V = QKV + (size_t)(b * 96 + 80 + hd * 2) * SEQ * 128;
            r.O = XB + ((size_t)(b * SEQ + qb * 256)) * DM + 2048 + hd * 256; r.tab = DTAB + hd * 256; r.P0 = qb * 256; r.kb0 = 0; r.kmax2 = 0.f; r.tabn = 256;
            r.c = c; r.lam = lam; r.gs = g_subln; r.scr = outp + (size_t)F.vcu * 65536; return r; };
        int nA = 0, nT = 0; for (int L = F.vcu; L < 768; L += F.G) { ++nT; if (L < 512) ++nA; }
        const int nD = nT - nA;
        auto ref = [&](int k) { const int L = F.vcu + (k >> 1) * F.G; return fox_ref(L, k & 1); };
        auto dref = [&](int k) { const int L = F.vcu + (nA + (k >> 2)) * F.G; return dif_ref(L, k & 3); };
        if (nA > 0) {
            att::Seam S; att::BlockRef cur = ref(0);
            att::attn_prime(cur, (char*)lds + RING_OFF, S, F.wave);
            for (int k = 0; k < 2 * nA; ++k) { const att::BlockRef nxt = ref(k + 1 < 2 * nA ? k + 1 : k); att::attn_block<0>(cur, nxt, (char*)lds + RING_OFF, S, F.wave); cur = nxt; }
        }
        if (nD > 0) {
            lam = expf(wave_sum(lq1[LANE] * lk1[LANE] + lq1[LANE + 64] * lk1[LANE + 64])) - expf(wave_sum(lq2[LANE] * lk2[LANE] + lq2[LANE + 64] * lk2[LANE + 64])) + 0.2f;
            att::DSeam S; att::BlockRef cur = dref(0);
            att::dattn_prime(cur, (char*)lds + RING_OFF, F.lds + RING_OFF, S, F.wave);
            for (int k = 0; k < 4 * nD; ++k) { const att::BlockRef nxt = dref(k + 1 < 4 * nD ? k + 1 : k); att::dattn_block(cur, nxt, (char*)lds + RING_OFF, F.lds + RING_OFF, S, F.wave); cur = nxt; }
            att::dattn_finish(F.wave);
        }
        if (BOTH(3)) GRID_BAR();
    }


    if (IN(5)) {
        WSBASE();
        {   pg8::MapPlainB g{(const char*)XB, (const char*)WoutT, DM, DM, DM}; pg8::StaticOrder S; S.init(TOK, DM, F.G, (int)blockIdx.x);
            pg8::EpiRes<true, true, true, true> E{XB0, HB, DM, PART1, 0};
            pg8::gemm_phase<pg8::MapPlainB, pg8::EpiRes<true, true, true, true>, pg8::StaticOrder, true, true>(F.lds + RING_OFF, g, S, E, F.wave); }
        {   pg8::MapAbsorb g{(const char*)KVM, (const char*)W2, 2 * DM, 2 * DM, 1024}; pg8::StaticOrder S; S.init(8192, DM, F.G, (int)blockIdx.x);
            pg8::EpiBf16 E{C2, DM, 0.03125f, 16};
            pg8::gemm_phase<pg8::MapAbsorb, pg8::EpiBf16, pg8::StaticOrder, true, true>(F.lds + RING_OFF, g, S, E, F.wave); }
        if (BOTH(5)) GRID_BAR();
    }

    if (IN(6)) {
        WSBASE();
        pg8::MapBatchBA g{(const char*)HB, (const char*)C2, DM, DM, DM, (size_t)1024 * DM * 2}; pg8::StaticOrder S; S.init(TOK, 1024, F.G, (int)blockIdx.x);
        pg8::EpiSoftmax E{XB, 1024, PART1, NORM_EPS};
        pg8::gemm_phase<pg8::MapBatchBA, pg8::EpiSoftmax, pg8::StaticOrder, false, true>(F.lds + RING_OFF, g, S, E, F.wave);
        if (BOTH(6)) GRID_BAR();
    }

    if (IN(7)) {
        WSBASE();
        pg8::MapBatchB g{(const char*)XB, (const char*)(C2 + (size_t)4096 * DM), 1024, DM, 1024, (size_t)1024 * 2}; pg8::StaticOrder S; S.init(TOK, DM, F.G, (int)blockIdx.x);
        pg8::EpiRes<true, true, true, true> E{HB, HB, DM, PART2, 0};
        pg8::gemm_phase<pg8::MapBatchB, pg8::EpiRes<true, true, true, true>, pg8::StaticOrder, true, true>(F.lds + RING_OFF, g, S, E, F.wave);
        if (BOTH(7)) GRID_BAR();
    }

    if (IN(8)) {
        WSBASE();
        pg8::MapPlainAB g{(const char*)HB, (const char*)WupT, DM, DM, DM}; pg8::StaticOrder S; S.init(TOK, DFF, F.G, (int)blockIdx.x);
        pg8::Unit u0; int pm0 = -1; if (S.next(0, u0)) pm0 = u0.pm;
        LAS float* rtab = (LAS float*)(F.lds + RTAB_OFF);
        if (pm0 >= 0) pg8::row_rstd_table(rtab, PART2, pm0 * 256, NORM_EPS, TID);
        pg8::EpiRelu2 E{Ub, Ub2, DFF, PART2, 0, NORM_EPS, rtab, pm0};
        pg8::gemm_phase<pg8::MapPlainAB, pg8::EpiRelu2, pg8::StaticOrder, true, true>(F.lds + RING_OFF, g, S, E, F.wave);
        if (BOTH(8)) GRID_BAR();
    }
    if (IN(9)) {
        WSBASE();
        pg8::MapBlkA g{(const char*)Ub, (const char*)Ub2, (const char*)WdnT, DFF, DFF}; pg8::StaticOrder S; S.init(TOK, DM, F.G, (int)blockIdx.x); S.wgm = 4;
        pg8::EpiRes<true, true, true, false> E{HB, XB0, DM, PART3, 0};
        pg8::gemm_phase<pg8::MapBlkA, pg8::EpiRes<true, true, true, false>, pg8::StaticOrder, true, true>(F.lds + RING_OFF, g, S, E, F.wave);
        if (BOTH(9)) GRID_BAR();
    }

    if (IN(10)) {
        WSBASE(); float* const outp = (float*)karg_ptr<8 * 22>(); const float* const g_final = INP(21);
        unsigned bad = 0u;
        if (!MK_PER_PHASE) bad = __hip_atomic_load(F.ctl + CW_BAR + XB_TMO, __ATOMIC_RELAXED, __HIP_MEMORY_SCOPE_AGENT);
        const float poison = bad ? __builtin_nanf("") : 1.0f;
        for (int m = gw; m < TOK; m += NGW) {
            const float ssq = wave_sum(PART3[(size_t)m * 64 + LANE]);
            const float rs = poison / sqrtf(ssq * (1.0f / DM) + NORM_EPS);
            const pg8::u32x4* hr = (const pg8::u32x4*)(XB0 + (size_t)m * DM) + LANE; f32x4* orow = (f32x4*)(outp + (size_t)m * DM) + 2 * LANE;
            pg8::u32x4 w[8];
#pragma unroll
            for (int j = 0; j < 8; ++j) w[j] = __builtin_nontemporal_load(hr + 64 * j);
#pragma unroll
            for (int j = 0; j < 8; ++j) { const f32x4 g0 = *((const f32x4*)g_final + 2 * LANE + 128 * j), g1 = *((const f32x4*)g_final + 2 * LANE + 128 * j + 1);
                const f32x4 a = {__uint_as_float(w[j].x << 16), __uint_as_float(w[j].x & 0xffff0000u), __uint_as_float(w[j].y << 16), __uint_as_float(w[j].y & 0xffff0000u)};
                const f32x4 b = {__uint_as_float(w[j].z << 16), __uint_as_float(w[j].z & 0xffff0000u), __uint_as_float(w[j].w << 16), __uint_as_float(w[j].w & 0xffff0000u)};
                orow[128 * j] = a * rs * g0; orow[128 * j + 1] = b * rs * g1; } }
    }
#undef IN
#undef BOTH
#undef GRID_BAR
}

extern "C" void kernel_launch(void* const* d_in, const int* in_sizes, int n_in, void* d_out, int out_size, void* d_ws, size_t ws_size, hipStream_t stream) {
    static int grid = 0;
    if (grid == 0) {
        if (n_in != 22 || in_sizes[0] != TOK * DM || out_size != TOK * DM || ws_size < WS_END) { fprintf(stderr, "kernel_launch: unexpected shapes / workspace (n_in %d, ws %zu < %zu)\n", n_in, ws_size, (size_t)WS_END); grid = -1; return; }
        int dev = 0, cus = 0, per_cu = 0;
        if (hipGetDevice(&dev) != hipSuccess || hipDeviceGetAttribute(&cus, hipDeviceAttributeMultiprocessorCount, dev) != hipSuccess) { grid = -1; return; }
        if (hipFuncSetAttribute((const void*)fwd_kernel, hipFuncAttributeMaxDynamicSharedMemorySize, LDS_BYTES) != hipSuccess) { fprintf(stderr, "kernel_launch: hipFuncSetAttribute failed\n"); grid = -1; return; }
        if (hipOccupancyMaxActiveBlocksPerMultiprocessor(&per_cu, (const void*)fwd_kernel, NWAVES * 64, LDS_BYTES) != hipSuccess || per_cu < 1) { fprintf(stderr, "kernel_launch: occupancy query reports %d\n", per_cu); }
        (void)hipGetLastError();
        grid = cus;
    }
    if (grid < 0) return;
    if (hipMemsetAsync((char*)d_ws + WS_CTL, 0, CTL_ZERO_BYTES, stream) != hipSuccess) return;
    Args a{};
    for (int i = 0; i < 22; ++i) a.in[i] = (const float*)d_in[i];
    a.out = (float*)d_out; a.ws = (unsigned char*)d_ws;
#if MK_PER_PHASE
    for (int p = 0; p < N_PHASES; ++p) { a.ph_lo = p; a.ph_hi = p + 1; a.li = p; a.pad = 0;
        for (int rep = 0; rep < ((PROBE_DUP_MASK >> p) & 1) + 1; ++rep)
            hipLaunchKernelGGL(fwd_kernel, dim3(grid), dim3(NWAVES * 64), LDS_BYTES, stream, a); }
#else
    a.ph_lo = 0; a.ph_hi = N_PHASES; a.li = 0; a.pad = 0;
    hipLaunchKernelGGL(fwd_kernel, dim3(grid), dim3(NWAVES * 64), LDS_BYTES, stream, a);
#endif
}
```
